# Optimizing an MI355X kernel written in HIP

```python
import math
import jax, jax.numpy as jnp
from jax import lax
import numpy as np

D_MODEL = 1024
BATCH = 8
SEQ = 2048
DEPTH = 1

CHUNK = 64
Q_BLOCK = 128
MEM_LEN = 256
SB_HEADS = 8
SB_HEAD_DIM = 64
SB_W = SB_HEADS * SB_HEAD_DIM
RET_HEADS = 8
RET_QK_DIM = 64
RET_V_DIM = 128
RET_QK_W = RET_HEADS * RET_QK_DIM
RET_V_W = RET_HEADS * RET_V_DIM
ROPE_BASE = 10000.0
IN_SPLITS = (SB_W, SB_W, SB_W, RET_QK_W, RET_QK_W, RET_V_W, RET_V_W, D_MODEL, D_MODEL)
IN_W = sum(IN_SPLITS)
X_HEADS = 4
X_HEAD_DIM = D_MODEL // X_HEADS
N_EXPERTS = 32
TOP_K = 4
D_FF = D_MODEL
SWIGLU_LIMIT = 7.0
SWIGLU_ALPHA = 1.702
EXPERT_BLOCK = 128
NORM_EPS = 1e-5

kernel_name = "hybrid_stickbreak_retention_xattn_moe"


def rmsnorm(x, g):
    xf = x.astype(jnp.float32)
    y = xf * lax.rsqrt(jnp.mean(xf * xf, axis=-1, keepdims=True) + NORM_EPS)
    return (y * g.astype(jnp.float32)).astype(x.dtype)


def rotary(x):
    S, d = x.shape[1], x.shape[3]
    inv = ROPE_BASE ** (-jnp.arange(0, d, 2, dtype=jnp.float32) / d)
    ang = jnp.arange(S, dtype=jnp.float32)[:, None] * inv[None, :]
    cos = jnp.cos(ang)[None, :, None, :]
    sin = jnp.sin(ang)[None, :, None, :]
    xf = x.astype(jnp.float32)
    x1, x2 = xf[..., : d // 2], xf[..., d // 2 :]
    return jnp.concatenate([x1 * cos - x2 * sin, x1 * sin + x2 * cos], axis=-1).astype(x.dtype)


def stick_breaking_attention(q, k, v):
    S, d = q.shape[1], q.shape[3]
    scale = d ** -0.5
    outs = []
    for i in range(S // Q_BLOCK):
        start, end = i * Q_BLOCK, (i + 1) * Q_BLOCK
        z = jnp.einsum('bqhd,bkhd->bhqk', q[:, start:end], k[:, :end]).astype(jnp.float32) * scale
        t_pos = jnp.arange(start, end)[:, None]
        s_pos = jnp.arange(end)[None, :]
        mask = s_pos < t_pos
        log_1m = jnp.where(mask, jax.nn.log_sigmoid(-z), 0.0)
        between = lax.cumsum(log_1m, axis=3, reverse=True) - log_1m
        w = jnp.where(mask, jnp.exp(jax.nn.log_sigmoid(z) + between), 0.0)
        outs.append(jnp.einsum('bhqk,bkhd->bqhd', w.astype(v.dtype), v[:, :end]))
    return jnp.concatenate(outs, axis=1)


def retention(q, k, v):
    B, S, H, dk = q.shape
    dv = v.shape[3]
    N = S // CHUNK
    log_g = jnp.log1p(-jnp.exp2(-5.0 - jnp.arange(H, dtype=jnp.float32)))
    qf = q.astype(jnp.float32).reshape(B, N, CHUNK, H, dk)
    kf = (k.astype(jnp.float32) * dk ** -0.5).reshape(B, N, CHUNK, H, dk)
    vf = v.astype(jnp.float32).reshape(B, N, CHUNK, H, dv)
    pos = jnp.arange(CHUNK, dtype=jnp.float32)
    diff = pos[:, None] - pos[None, :]
    decay = jnp.where(diff >= 0, jnp.exp(log_g[:, None, None] * jnp.maximum(diff, 0.0)), 0.0)
    scores = jnp.einsum('bnchd,bnshd->bnhcs', qf, kf) * decay
    o_intra = jnp.einsum('bnhcs,bnshe->bnche', scores, vf)
    k_dec = jnp.exp(log_g[:, None] * (CHUNK - 1 - pos)[None, :])
    kv = jnp.einsum('bnshd,hs,bnshe->nbhde', kf, k_dec, vf)
    chunk_dec = jnp.exp(log_g * CHUNK)[None, :, None, None]

    def step(state, kv_n):
        return state * chunk_dec + kv_n, state

    _, s_prev = lax.scan(step, jnp.zeros((B, H, dk, dv), jnp.float32), kv)
    q_dec = jnp.exp(log_g[:, None] * (pos + 1.0)[None, :])
    o_cross = jnp.einsum('bnchd,hc,nbhde->bnche', qf, q_dec, s_prev)
    return (o_intra + o_cross).reshape(B, S, H, dv)


def head_groupnorm(y):
    mu = jnp.mean(y, axis=-1, keepdims=True)
    var = jnp.mean(jnp.square(y - mu), axis=-1, keepdims=True)
    return (y - mu) * lax.rsqrt(var + NORM_EPS)


def token_mixer(h, w_in, w_sb_o, w_ret_o, w_mix_out):
    B, S, _ = h.shape
    proj = h @ w_in
    idx = list(np.cumsum(IN_SPLITS)[:-1])
    sb_q, sb_k, sb_v, r_q, r_k, r_v, r_g, g_sb, g_ret = jnp.split(proj, idx, axis=-1)
    y_sb = stick_breaking_attention(sb_q.reshape(B, S, SB_HEADS, SB_HEAD_DIM),
                                    sb_k.reshape(B, S, SB_HEADS, SB_HEAD_DIM),
                                    sb_v.reshape(B, S, SB_HEADS, SB_HEAD_DIM)).reshape(B, S, SB_W)
    y_sb = y_sb @ w_sb_o
    rq = rotary(r_q.reshape(B, S, RET_HEADS, RET_QK_DIM))
    rk = rotary(r_k.reshape(B, S, RET_HEADS, RET_QK_DIM))
    y_ret = head_groupnorm(retention(rq, rk, r_v.reshape(B, S, RET_HEADS, RET_V_DIM))).reshape(B, S, RET_V_W)
    y_ret = (jax.nn.silu(r_g.astype(jnp.float32)) * y_ret).astype(h.dtype) @ w_ret_o
    merged = jax.nn.sigmoid(g_sb) * y_sb + jax.nn.sigmoid(g_ret) * y_ret
    return merged @ w_mix_out


def memory_cross_attention(h, m, w_cq, w_ckv, w_co):
    B, S, D = h.shape
    q = (h @ w_cq).reshape(B, S, X_HEADS, X_HEAD_DIM)
    kv = m @ w_ckv
    k = kv[..., :D].reshape(B, -1, X_HEADS, X_HEAD_DIM)
    v = kv[..., D:].reshape(B, -1, X_HEADS, X_HEAD_DIM)
    s = jnp.einsum('bqhd,bmhd->bhqm', q, k).astype(jnp.float32) * X_HEAD_DIM ** -0.5
    p = jax.nn.softmax(s, axis=-1).astype(v.dtype)
    o = jnp.einsum('bhqm,bmhd->bqhd', p, v).reshape(B, S, D)
    return o @ w_co


def moe_ffn(h, w_router, b_router, w1, b1, w2, b2):
    B, S, D = h.shape
    T = B * S
    A = T * TOP_K
    ht = h.reshape(T, D)
    logits = ht.astype(jnp.float32) @ w_router.astype(jnp.float32) + b_router.astype(jnp.float32)
    top_val, top_idx = lax.top_k(logits, TOP_K)
    gate = jax.nn.softmax(top_val, axis=-1)
    flat_e = top_idx.reshape(A)
    flat_tok = jnp.arange(A, dtype=jnp.int32) // TOP_K
    order = jnp.argsort(flat_e)
    sorted_e = flat_e[order]
    sorted_tok = flat_tok[order]
    sorted_gate = gate.reshape(A)[order]
    counts = jnp.bincount(flat_e, length=N_EXPERTS)
    padded = ((counts + EXPERT_BLOCK - 1) // EXPERT_BLOCK) * EXPERT_BLOCK
    pad_end = jnp.cumsum(padded)
    pad_start = pad_end - padded
    cnt_start = jnp.cumsum(counts) - counts
    row = pad_start[sorted_e] + (jnp.arange(A) - cnt_start[sorted_e])
    n_blocks = (A + N_EXPERTS * (EXPERT_BLOCK - 1) + EXPERT_BLOCK - 1) // EXPERT_BLOCK
    P = n_blocks * EXPERT_BLOCK
    row_tok = jnp.zeros((P,), jnp.int32).at[row].set(sorted_tok)
    block_e = jnp.minimum(jnp.searchsorted(pad_end, jnp.arange(n_blocks) * EXPERT_BLOCK, side='right'),
                          N_EXPERTS - 1)
    xin = ht[row_tok].reshape(n_blocks, EXPERT_BLOCK, D)

    def expert_block(args):
        xb, e = args
        hc = xb @ w1[e] + b1[e]
        glu = jnp.minimum(hc[..., :D_FF], SWIGLU_LIMIT)
        lin = jnp.clip(hc[..., D_FF:], -SWIGLU_LIMIT, SWIGLU_LIMIT)
        act = glu * jax.nn.sigmoid(SWIGLU_ALPHA * glu) * (lin + 1.0)
        return act @ w2[e] + b2[e]

    yrows = lax.map(expert_block, (xin, block_e)).reshape(P, D)
    y_assign = yrows[row] * sorted_gate[:, None].astype(yrows.dtype)
    out = jax.ops.segment_sum(y_assign, sorted_tok, num_segments=T)
    return out.reshape(B, S, D)


def setup_inputs(seed: int = 0) -> dict:
    key = jax.random.key(seed)
    ks = jax.random.split(key, 20)
    f32 = jnp.float32

    def w(k, shape, fan_in):
        return jax.random.normal(k, shape, f32) * fan_in ** -0.5

    def gain(k, shape):
        return 1.0 + 0.02 * jax.random.normal(k, shape, f32)

    L = DEPTH
    return {
        "x": jax.random.normal(ks[0], (BATCH, SEQ, D_MODEL), f32),
        "mem": jax.random.normal(ks[1], (BATCH, MEM_LEN, D_MODEL), f32),
        "g_mix": gain(ks[2], (L, D_MODEL)),
        "w_in": w(ks[3], (L, D_MODEL, IN_W), D_MODEL),
        "w_sb_o": w(ks[4], (L, SB_W, D_MODEL), SB_W),
        "w_ret_o": w(ks[5], (L, RET_V_W, D_MODEL), RET_V_W),
        "w_mix_out": w(ks[6], (L, D_MODEL, D_MODEL), D_MODEL),
        "g_xattn": gain(ks[7], (L, D_MODEL)),
        "g_mem": gain(ks[8], (L, D_MODEL)),
        "w_cq": w(ks[9], (L, D_MODEL, D_MODEL), D_MODEL),
        "w_ckv": w(ks[10], (L, D_MODEL, 2 * D_MODEL), D_MODEL),
        "w_co": w(ks[11], (L, D_MODEL, D_MODEL), D_MODEL),
        "g_moe": gain(ks[12], (L, D_MODEL)),
        "w_router": w(ks[13], (L, D_MODEL, N_EXPERTS), D_MODEL),
        "b_router": 0.01 * jax.random.normal(ks[14], (L, N_EXPERTS), f32),
        "w_exp_in": w(ks[15], (L, N_EXPERTS, D_MODEL, 2 * D_FF), D_MODEL),
        "b_exp_in": 0.01 * jax.random.normal(ks[16], (L, N_EXPERTS, 2 * D_FF), f32),
        "w_exp_out": w(ks[17], (L, N_EXPERTS, D_FF, D_MODEL), D_FF),
        "b_exp_out": 0.01 * jax.random.normal(ks[18], (L, N_EXPERTS, D_MODEL), f32),
        "g_final": gain(ks[19], (D_MODEL,)),
    }


def reference(x, mem, g_mix, w_in, w_sb_o, w_ret_o, w_mix_out, g_xattn, g_mem, w_cq, w_ckv, w_co,
              g_moe, w_router, b_router, w_exp_in, b_exp_in, w_exp_out, b_exp_out, g_final):
    for l in range(DEPTH):
        x = x + token_mixer(rmsnorm(x, g_mix[l]), w_in[l], w_sb_o[l], w_ret_o[l], w_mix_out[l])
        x = x + memory_cross_attention(rmsnorm(x, g_xattn[l]), rmsnorm(mem, g_mem[l]),
                                       w_cq[l], w_ckv[l], w_co[l])
        x = x + moe_ffn(rmsnorm(x, g_moe[l]), w_router[l], b_router[l],
                        w_exp_in[l], b_exp_in[l], w_exp_out[l], b_exp_out[l])
    return rmsnorm(x, g_final)
```

```cpp
#include <hip/hip_runtime.h>
#include <cstdio>
#include <cstdint>

#ifndef MK_DEBUG
#define MK_DEBUG 0
#endif

#define LAS __attribute__((address_space(3)))
#define GAS __attribute__((address_space(1)))
typedef unsigned short bf16;
typedef short bf16x8 __attribute__((ext_vector_type(8)));
typedef short s16x4 __attribute__((ext_vector_type(4)));
typedef short v4i16_t __attribute__((ext_vector_type(4)));
typedef float f32x2 __attribute__((ext_vector_type(2)));
typedef float f32x4 __attribute__((ext_vector_type(4)));
typedef float f32x16 __attribute__((ext_vector_type(16)));
typedef unsigned u32x2 __attribute__((ext_vector_type(2)));
typedef unsigned u32x4 __attribute__((ext_vector_type(4)));
typedef __bf16 bf16x2_t __attribute__((ext_vector_type(2)));
typedef GAS unsigned gu32;
#define RLX_AGENT __ATOMIC_RELAXED, __HIP_MEMORY_SCOPE_AGENT
#define LDS_WAIT() asm volatile("s_waitcnt lgkmcnt(0)" ::: "memory")
#define VM_WAIT() asm volatile("s_waitcnt vmcnt(0)" ::: "memory")
#define DI __device__ __forceinline__

DI unsigned cvtpk(float lo, float hi) { f32x2 v = {lo, hi}; bf16x2_t b = __builtin_convertvector(v, bf16x2_t); return __builtin_bit_cast(unsigned, b); }
DI float bflo(unsigned w) { return __uint_as_float(w << 16); }
DI float bfhi(unsigned w) { return __uint_as_float(w & 0xffff0000u); }
DI float bf2f(bf16 u) { return __uint_as_float((unsigned)u << 16); }
DI float fexp2(float x) { return __builtin_amdgcn_exp2f(x); }
DI float flog2(float x) { return __builtin_amdgcn_logf(x); }
DI float frcp(float x) { return __builtin_amdgcn_rcpf(x); }
DI float sigmoidf_(float x) { return frcp(1.0f + fexp2(-1.4426950408889634f * x)); }
DI int crow(int r, int hi) { return (r & 3) + 8 * (r >> 2) + 4 * hi; }
DI s16x4 vtr(const LAS char* p) { return __builtin_bit_cast(s16x4, __builtin_amdgcn_ds_read_tr16_b64_v4i16((LAS v4i16_t*)p)); }
#define MFMA32(a, b, c) __builtin_amdgcn_mfma_f32_32x32x16_bf16((a), (b), (c), 0, 0, 0)

constexpr int BATCH = 8, SEQ = 2048, DM = 1024, T = BATCH * SEQ, NPROJ = 6656, MEML = 256;
constexpr int C_SBQ = 0, C_SBK = 512, C_SBV = 1024, C_RQ = 1536, C_RK = 2048, C_RV = 2560, C_RG = 3584, C_GSB = 4608, C_GRET = 5632;
constexpr int NEXP = 32, TOPK = 4, DFF = 1024;
constexpr int MAXBLK = 288, PROWS = MAXBLK * 256;
constexpr float NORM_EPS = 1e-5f;
constexpr float LOG2E = 1.4426950408889634f;
constexpr float SBQ_SCALE = 0.125f * LOG2E;
constexpr float XQ_SCALE = 0.0625f * LOG2E;
constexpr float SB_THR = 150.0f;

namespace pg8 {
constexpr int BM = 256, BK = 64, HALF = 128, HTB = HALF * BK * 2, STAGE_BYTES = 8 * HTB, NXCD = 8, WGM = 8;
__host__ __device__ __forceinline__ int lds_byte(int r, int c) { const int st = (r >> 4) * 2 + (c >> 5), rr = r & 15, cc = c & 31, ob = rr * 64 + cc * 2; return st * 1024 + (ob ^ (((ob >> 9) & 1) << 5)); }
__host__ __device__ __forceinline__ void stage_rc(int b, int& R, int& C) { const int st = b / 1024, sb = b % 1024, swz = sb ^ (((sb >> 9) & 1) << 5); R = (st >> 1) * 16 + swz / 64; C = (st & 1) * 32 + (swz % 64) / 2; }
__host__ __device__ __forceinline__ int perm32(int rho) { const int n = rho >> 4, i = rho & 15; return 8 * (i >> 2) + 4 * n + (i & 3); }

typedef int v8i_t __attribute__((ext_vector_type(8)));
typedef int v4i_t __attribute__((ext_vector_type(4)));
DI v8i_t cat8(bf16x8 a, bf16x8 b) { const v4i_t x = __builtin_bit_cast(v4i_t, a), y = __builtin_bit_cast(v4i_t, b); return __builtin_shufflevector(x, y, 0, 1, 2, 3, 4, 5, 6, 7); }
DI bf16x8 lo8(v8i_t v) { return __builtin_bit_cast(bf16x8, (v4i_t)__builtin_shufflevector(v, v, 0, 1, 2, 3)); }
DI bf16x8 hi8(v8i_t v) { return __builtin_bit_cast(bf16x8, (v4i_t)__builtin_shufflevector(v, v, 4, 5, 6, 7)); }
struct Unit { int pm, pn; const char* A; const char* B; int tag, e; };

DI void map_unit(int L, int nwg, int nM, int nN, int& pm, int& pn) {
    int wgid = L; { const int q = nwg / NXCD, r = nwg % NXCD, xcd = wgid % NXCD, off = wgid / NXCD; wgid = (xcd < r ? xcd * (q + 1) : r * (q + 1) + (xcd - r) * q) + off; }
    const int nig = WGM * nN, gid = wgid / nig, fm = gid * WGM, gsz = (nM - fm) < WGM ? (nM - fm) : WGM;
    pm = fm + ((wgid % nig) % gsz); pn = (wgid % nig) / gsz;
}
struct Sched2 {
    const bf16* A0; const bf16* B0; int nM0, nN0; const bf16* A1; const bf16* B1; int nM1, nN1; int G, c, K;
    DI bool next(int i, Unit& u) const {
        const int n0 = nM0 * nN0, n1 = nM1 * nN1; const long L = (long)i * G + c; if (L >= n0 + n1) return false;
        const bool first = L < n0; int pm, pn; map_unit(first ? (int)L : (int)L - n0, first ? n0 : n1, first ? nM0 : nM1, first ? nN0 : nN1, pm, pn);
        u.pm = pm; u.pn = pn; u.tag = first ? 0 : 1; u.e = 0;
        u.A = (const char*)(first ? A0 : A1) + (size_t)pm * BM * K * 2; u.B = (const char*)(first ? B0 : B1) + (size_t)pn * BM * K * 2; return true;
    }
};
struct SchedMoE {
    const unsigned char* A; const unsigned char* Wt; const int* blk_e; int nblk, nN, G, c, K; size_t estride;
    DI bool next(int i, Unit& u) const {
        const int nwg = nblk * nN; const long L = (long)i * G + c; if (L >= nwg) return false;
        int pm, pn; map_unit((int)L, nwg, nblk, nN, pm, pn);
        const int e = __builtin_amdgcn_readfirstlane(__hip_atomic_load(blk_e + pm, RLX_AGENT));
        u.pm = pm; u.pn = pn; u.tag = 0; u.e = e;
        u.A = (const char*)A + (size_t)pm * BM * K; u.B = (const char*)Wt + ((size_t)e * estride + (size_t)pn * BM * K); return true;
    }
};

template <class Epi, class Sched>
DI void gemm_phase(LAS unsigned char* lds, const int K, const Sched& S, const Epi& E) {
    const int tid = threadIdx.x, wid = __builtin_amdgcn_readfirstlane(tid >> 6), lane = tid & 63, wr = wid >> 2, wc = wid & 3, fr = lane & 15, fq = lane >> 4;
    constexpr int ESZ = Epi::FP8 ? 1 : 2;
    int nt = K * ESZ / 128; asm volatile("" : "+s"(nt));
    unsigned voffA[2], voffB[2];
#pragma unroll
    for (int i = 0; i < 2; ++i) { int R, C; stage_rc(tid * 16 + i * 8192, R, C); const int Rb = Epi::PERM ? ((R & ~31) + perm32(R & 31)) : R;
        voffA[i] = (unsigned)(R * K * ESZ + 2 * C); voffB[i] = (unsigned)(Rb * K * ESZ + 2 * C); }
    const size_t kstep = (size_t)(BK * 2);
    const size_t hstep = (size_t)HALF * K * ESZ;
    const unsigned ldsw = (unsigned)wid * 1024u;
    const int aoff = lds_byte(wr * 64 + fr, fq * 8), boff = lds_byte(wc * 32 + fr, fq * 8);
#define PG8_SA(b, h) (((b) * 2 + (h)) * HTB)
#define PG8_SB(b, h) ((4 + (b) * 2 + (h)) * HTB)
#define PG8_STAGE(bufoff, gbase, voff) do { _Pragma("unroll") for (int _i = 0; _i < 2; ++_i) \
        __builtin_amdgcn_global_load_lds((const unsigned*)((const char*)(gbase) + (voff)[_i]), (LAS unsigned*)(lds + (bufoff) + ldsw + _i * 8192), 16, 0, 0); } while (0)
#define PG8_LDA(dst, b, h) do { _Pragma("unroll") for (int m = 0; m < 4; ++m) dst[m] = cat8(*(const LAS bf16x8*)(lds + PG8_SA(b, h) + aoff + m * 2048), *(const LAS bf16x8*)(lds + PG8_SA(b, h) + aoff + m * 2048 + 1024)); } while (0)
#define PG8_LDB(dst, b, h) do { _Pragma("unroll") for (int n = 0; n < 2; ++n) dst[n] = cat8(*(const LAS bf16x8*)(lds + PG8_SB(b, h) + boff + n * 2048), *(const LAS bf16x8*)(lds + PG8_SB(b, h) + boff + n * 2048 + 1024)); } while (0)
#define PG8_MMA(ai, bj, At, Bt) do { __builtin_amdgcn_s_setprio(1); _Pragma("unroll") for (int m = 0; m < 4; ++m) _Pragma("unroll") for (int n = 0; n < 2; ++n) { \
        if constexpr (Epi::FP8) { asm volatile("v_mfma_scale_f32_16x16x128_f8f6f4 %0, %1, %2, %0, %3, %4 op_sel_hi:[0,0,0]" : "+v"(acc[ai][bj][m][n]) : "v"(Bt[n]), "v"(At[m]), "v"(sc_w), "v"(sc_a)); } \
        else { acc[ai][bj][m][n] = __builtin_amdgcn_mfma_f32_16x16x32_bf16(lo8(Bt[n]), lo8(At[m]), acc[ai][bj][m][n], 0, 0, 0); acc[ai][bj][m][n] = __builtin_amdgcn_mfma_f32_16x16x32_bf16(hi8(Bt[n]), hi8(At[m]), acc[ai][bj][m][n], 0, 0, 0); } } \
        __builtin_amdgcn_s_setprio(0); } while (0)
#define PG8_WAIT_V(n) asm volatile("s_waitcnt vmcnt(" #n ")" ::: "memory")
#define PG8_WAIT_L(n) asm volatile("s_waitcnt lgkmcnt(" #n ")" ::: "memory")
#define PG8_BAR __builtin_amdgcn_s_barrier()
#define PG8_SCHED __builtin_amdgcn_sched_barrier(0)
    Unit cur, nxt; int ui = 0;
    if (S.next(0, cur)) {
    f32x4 acc[2][2][4][2];
#pragma unroll
    for (int a = 0; a < 2; ++a)
#pragma unroll
        for (int b = 0; b < 2; ++b)
#pragma unroll
            for (int m = 0; m < 4; ++m)
#pragma unroll
                for (int n = 0; n < 2; ++n) acc[a][b][m][n] = (f32x4){0.f, 0.f, 0.f, 0.f};
    v8i_t At[4], B0[2], B1[2];
    int sc_w = 0, sc_a = 0; if constexpr (Epi::FP8) { sc_w = Epi::SCALE_W; sc_a = Epi::SCALE_A; asm volatile("" : "+v"(sc_w), "+v"(sc_a)); }
    (void)sc_w; (void)sc_a;
    const char* cA = cur.A; const char* cB = cur.B;
    PG8_STAGE(PG8_SB(0, 0), cB, voffB); PG8_STAGE(PG8_SB(0, 1), cB + hstep, voffB); PG8_STAGE(PG8_SA(0, 0), cA, voffA); PG8_STAGE(PG8_SA(0, 1), cA + hstep, voffA);
    if (wr == 1) PG8_BAR;
    PG8_WAIT_V(2); PG8_BAR;
    PG8_STAGE(PG8_SB(1, 0), cB + kstep, voffB); PG8_STAGE(PG8_SA(1, 0), cA + kstep, voffA); PG8_STAGE(PG8_SB(1, 1), cB + hstep + kstep, voffB);
    PG8_WAIT_V(6); PG8_BAR;
    for (;;) {
        const bool has_next = S.next(ui + 1, nxt);
        const char* nA = has_next ? nxt.A : cA; const char* nB = has_next ? nxt.B : cB;
#pragma nounroll
        for (int t = 0; t < nt; t += 2) {
            const bool last = (t == nt - 2);
            const char* a1 = cA + (size_t)(t + 1) * kstep;
            const char* a2 = last ? nA : cA + (size_t)(t + 2) * kstep; const char* b2 = last ? nB : cB + (size_t)(t + 2) * kstep;
            const char* a3 = a2 + kstep; const char* b3 = b2 + kstep;
            PG8_LDB(B0, 0, 0); PG8_LDB(B1, 0, 1); PG8_SCHED; PG8_LDA(At, 0, 0); PG8_STAGE(PG8_SA(1, 1), a1 + hstep, voffA);
            PG8_WAIT_V(8); PG8_WAIT_L(0); PG8_BAR; PG8_MMA(0, 0, At, B0); PG8_MMA(0, 1, At, B1); PG8_BAR; PG8_SCHED;
            PG8_LDA(At, 0, 1); PG8_STAGE(PG8_SB(0, 0), b2, voffB); PG8_STAGE(PG8_SB(0, 1), b2 + hstep, voffB); PG8_STAGE(PG8_SA(0, 0), a2, voffA);
            PG8_WAIT_V(8); PG8_WAIT_L(0); PG8_BAR; PG8_MMA(1, 0, At, B0); PG8_MMA(1, 1, At, B1); PG8_BAR; PG8_SCHED;
            PG8_LDB(B0, 1, 0); PG8_LDB(B1, 1, 1); PG8_SCHED; PG8_LDA(At, 1, 0); PG8_STAGE(PG8_SA(0, 1), a2 + hstep, voffA);
            PG8_WAIT_V(8); PG8_WAIT_L(0); PG8_BAR; PG8_MMA(0, 0, At, B0); PG8_MMA(0, 1, At, B1); PG8_BAR; PG8_SCHED;
            PG8_LDA(At, 1, 1); PG8_STAGE(PG8_SB(1, 0), b3, voffB); PG8_STAGE(PG8_SB(1, 1), b3 + hstep, voffB); PG8_STAGE(PG8_SA(1, 0), a3, voffA);
            PG8_WAIT_V(8); PG8_WAIT_L(0); PG8_BAR; PG8_MMA(1, 0, At, B0); PG8_MMA(1, 1, At, B1); PG8_BAR; PG8_SCHED;
        }
        if (wr == 0) PG8_BAR;
        if constexpr (Epi::FP8) { asm volatile("s_nop 15\n\ts_nop 3" ::: "memory"); _Pragma("unroll") for (int i_ = 0; i_ < 32; ++i_) asm volatile("" : "+v"(((f32x4*)acc)[i_])); }
        E(acc, cur, wr, wc, fr, fq);
        if (!has_next) break;
#pragma unroll
        for (int a = 0; a < 2; ++a)
#pragma unroll
            for (int b = 0; b < 2; ++b)
#pragma unroll
                for (int m = 0; m < 4; ++m)
#pragma unroll
                    for (int n = 0; n < 2; ++n) acc[a][b][m][n] = (f32x4){0.f, 0.f, 0.f, 0.f};
        cur = nxt; cA = nA; cB = nB; ++ui;
        if (wr == 1) PG8_BAR;
    }
    PG8_WAIT_V(0);
    PG8_BAR;
    }
    __syncthreads();
#undef PG8_SA
#undef PG8_SB
#undef PG8_STAGE
#undef PG8_LDA
#undef PG8_LDB
#undef PG8_MMA
#undef PG8_WAIT_V
#undef PG8_WAIT_L
#undef PG8_BAR
#undef PG8_SCHED
}
}

#define XB_TMO      128
#define XB_XCNT(j)  (256  + 64 * (j))
#define XB_XSUB(j)  (1280 + 64 * (j))
#define XB_XGEN(j)  (2304 + 64 * (j))
#define XB_TOP      3328
#define XB_TOPGEN   3392
#define XCD_BAR_WORDS 3456
#define XB_SPIN_CAP (1u << 18)
DI unsigned xb_ld(unsigned* p)              { return __hip_atomic_load(p, __ATOMIC_RELAXED, __HIP_MEMORY_SCOPE_AGENT); }
DI unsigned xb_add(unsigned* p, unsigned v) { return __hip_atomic_fetch_add(p, v, __ATOMIC_RELAXED, __HIP_MEMORY_SCOPE_AGENT); }
DI unsigned xb_xcc_id() { return (unsigned)__builtin_amdgcn_s_getreg((3 << 11) | 20) & 0xFu; }
#define XB_SPIN(cond, bar) do { unsigned _sp = 0; while (cond) { __builtin_amdgcn_s_sleep(1); \
    if ((++_sp & 255u) == 0u) { if (xb_ld(&(bar)[XB_TMO])) break; if (_sp > XB_SPIN_CAP) { atomicAdd(&(bar)[XB_TMO], 1u); break; } } } } while (0)
struct XcdBarrier { unsigned* bar; unsigned x; volatile LAS unsigned* st; };
DI XcdBarrier xcd_barrier_post(unsigned* bar, volatile LAS unsigned* st) {
    XcdBarrier b; b.bar = bar; b.x = xb_xcc_id(); b.st = st;
    if (threadIdx.x == 0) (void)xb_add(&bar[XB_XCNT(b.x)], 1u);
    return b;
}
DI void xcd_barrier_complete(unsigned* bar, unsigned x, unsigned& nloc, unsigned& nx) {
    const unsigned G = gridDim.x * gridDim.y * gridDim.z;
    unsigned sum, cnt, mine, sp = 0u;
    for (;;) {
        sum = 0u; cnt = 0u; mine = 0u;
#pragma unroll
        for (unsigned j = 0; j < 16; ++j) { const unsigned c = xb_ld(&bar[XB_XCNT(j)]); sum += c; cnt += (c > 0u) ? 1u : 0u; mine = (j == x) ? c : mine; }
        if (sum == G) break;
        __builtin_amdgcn_s_sleep(1);
        if ((++sp & 255u) == 0u) { if (xb_ld(&bar[XB_TMO])) break; if (sp > XB_SPIN_CAP) { atomicAdd(&bar[XB_TMO], 1u); break; } }
    }
    nloc = mine > 0u ? mine : 1u; nx = cnt > 0u ? cnt : 1u;
}
DI void xcd_barrier(const XcdBarrier& b) {
    asm volatile("s_waitcnt vmcnt(0)" ::: "memory");
    __syncthreads();
    if (threadIdx.x == 0) {
        unsigned* bar = b.bar;
        __builtin_amdgcn_s_waitcnt(0);
        unsigned nloc = b.st[0], nx = b.st[1];
        if (nloc == 0u) { xcd_barrier_complete(bar, b.x, nloc, nx); b.st[0] = nloc; b.st[1] = nx; }
        const unsigned old = xb_add(&bar[XB_XSUB(b.x)], 1u);
        const unsigned gen = old / nloc;
        if (old + 1u == (gen + 1u) * nloc) {
            __builtin_amdgcn_fence(__ATOMIC_RELEASE, "agent");
            asm volatile("s_waitcnt vmcnt(0)" ::: "memory");
            const unsigned og = xb_add(&bar[XB_TOP], 1u);
            const unsigned tg = og / nx;
            if (og + 1u == (tg + 1u) * nx) xb_add(&bar[XB_TOPGEN], 1u);
            else XB_SPIN(xb_ld(&bar[XB_TOPGEN]) == tg, bar);
            __builtin_amdgcn_fence(__ATOMIC_ACQUIRE, "agent");
            xb_add(&bar[XB_XGEN(b.x)], 1u);
            asm volatile("s_waitcnt vmcnt(0)" ::: "memory");
        } else {
            XB_SPIN(xb_ld(&bar[XB_XGEN(b.x)]) == gen, bar);
            __builtin_amdgcn_fence(__ATOMIC_ACQUIRE, "agent");
            asm volatile("s_waitcnt vmcnt(0)" ::: "memory");
        }
    }
    __syncthreads();
}

constexpr size_t MB = 1024 * 1024;
constexpr size_t WS_CTL    = 0;
constexpr size_t CTL_BYTES = 256 * 1024;
constexpr int    CW_BAR = 4096;
constexpr int    CW_CHK = 32768;
constexpr size_t WS_ROPE   = WS_CTL + CTL_BYTES;
constexpr size_t WS_WIN    = WS_ROPE + 512 * 1024;
constexpr size_t WS_WSBO   = WS_WIN + (size_t)NPROJ * DM * 2;
constexpr size_t WS_WRETO  = WS_WSBO + 1 * MB;
constexpr size_t WS_WMIX   = WS_WRETO + 2 * MB;
constexpr size_t WS_WCQ    = WS_WMIX + 2 * MB;
constexpr size_t WS_WCKV   = WS_WCQ + 2 * MB;
constexpr size_t WS_WCO    = WS_WCKV + 4 * MB;
constexpr size_t WS_WE1    = WS_WCO + 2 * MB;
constexpr size_t WS_WE2    = WS_WE1 + 128 * MB;
constexpr size_t WS_SMALL  = WS_WE2 + 64 * MB;
constexpr size_t WS_MEMN   = WS_SMALL + 4 * MB;
constexpr size_t WS_KVMEM  = WS_MEMN + 4 * MB;
constexpr size_t WS_GTOT   = WS_KVMEM + 8 * MB;
constexpr size_t WS_SLOTS  = WS_GTOT + 8 * MB;
constexpr size_t WS_A      = WS_SLOTS + 1 * MB;
constexpr size_t WS_B      = WS_A + 208 * MB;
constexpr size_t WS_C      = WS_B + 32 * MB;
constexpr size_t WS_D      = WS_C + 64 * MB;
constexpr size_t WS_E      = WS_D + 144 * MB;
constexpr size_t WS_END    = WS_E + 144 * MB;
static_assert((size_t)T * NPROJ * 2 <= 208 * MB && (size_t)PROWS * 1024 * 2 <= 144 * MB, "arena sizes");
constexpr size_t WS_PROJ = WS_A, WS_XG = WS_A, WS_XN1 = WS_B, WS_YRET = WS_B, WS_XN3U = WS_B, WS_TMP = WS_C, WS_X2 = WS_C;
constexpr size_t WS_YSB = WS_D, WS_MERGED = WS_D + 16 * MB, WS_XN2U = WS_D + 48 * MB  , WS_QX = WS_D + 80 * MB, WS_OX = WS_D + 112 * MB, WS_ACT = WS_D;
constexpr size_t WS_X1 = WS_E, WS_YROWS = WS_E;
constexpr size_t SM_TOPE = 0;
constexpr size_t SM_GATE = SM_TOPE + T * 16;
constexpr size_t SM_LRANK = SM_GATE + T * 16;
constexpr size_t SM_AROW = SM_LRANK + T * 16;
constexpr size_t SM_RSTD3 = SM_AROW + T * 16;
constexpr size_t SM_CNT = SM_RSTD3 + T * 4;
constexpr size_t SM_RSCALE = SM_CNT + 256 * 32 * 4;
constexpr size_t SM_RGATE = SM_RSCALE + PROWS * 4;
constexpr size_t SM_BLKE = SM_RGATE + PROWS * 4;
constexpr size_t SM_END = SM_BLKE + 4096;
static_assert(SM_END <= 4 * MB, "small tables");

constexpr int RING_OFF = 0, RING_BYTES = 131072;
constexpr int XTRA_OFF = RING_BYTES, XTRA_BYTES = 12288;
constexpr int LDSCTL_OFF = XTRA_OFF + XTRA_BYTES;
constexpr int LDS_BYTES = 147456;
static_assert(LDSCTL_OFF + 256 <= LDS_BYTES, "LDS map");
constexpr int NWAVES = 8;

struct Args { const float* in[20]; float* out; unsigned char* ws; int ph_lo, ph_hi; };

typedef const __attribute__((address_space(4))) unsigned char* kptr_t;
struct Frame {
    LAS unsigned char* lds;
    unsigned char* ws;
    int tid, lane, wave, G, bid;
    kptr_t kp;
    float* out;
};
DI const float* inp(const Frame& F, int i) { return *(const float* const __attribute__((address_space(4)))*)(F.kp + 8 * i); }
enum { I_X = 0, I_MEM, I_GMIX, I_WIN, I_WSBO, I_WRETO, I_WMIX, I_GXATTN, I_GMEM, I_WCQ, I_WCKV, I_WCO, I_GMOE, I_WROUTER, I_BROUTER, I_WE1, I_BE1, I_WE2, I_BE2, I_GFINAL };

DI float wave_sum(float v) {
#pragma unroll
    for (int o = 1; o < 64; o <<= 1) v += __shfl_xor(v, o);
    return v;
}

DI void p0_tr_item(const float* W, int N, int K, bf16* dst, LAS float* scr, int k0, int n0, int lane, const float* rowscale = nullptr) {
#pragma unroll 8
    for (int i = 0; i < 32; ++i) { const int kk = 2 * i + (lane >> 5); scr[kk * 33 + (lane & 31)] = W[(size_t)(k0 + kk) * N + n0 + (lane & 31)] * (rowscale ? rowscale[k0 + kk] : 1.0f); }
    LDS_WAIT(); asm volatile("" ::: "memory");
    const int c = lane & 7;
#pragma unroll
    for (int j = 0; j < 4; ++j) { const int n = (lane >> 3) + 8 * j; const LAS float* s = scr + (8 * c) * 33 + n;
        u32x4 o; o.x = cvtpk(s[0 * 33], s[1 * 33]); o.y = cvtpk(s[2 * 33], s[3 * 33]); o.z = cvtpk(s[4 * 33], s[5 * 33]); o.w = cvtpk(s[6 * 33], s[7 * 33]);
        *(u32x4*)(dst + (size_t)n * K + k0 + 8 * c) = o; }
    LDS_WAIT(); asm volatile("" ::: "memory");
}
DI unsigned cvt4_fp8(float a, float b, float c, float d) { int w = __builtin_amdgcn_cvt_pk_fp8_f32(a, b, 0, false); w = __builtin_amdgcn_cvt_pk_fp8_f32(c, d, w, true); return (unsigned)w; }
DI void p0_tr_item_fp8(const float* W, int N, int K, unsigned char* dst, LAS float* scr, int k0, int n0, int lane) {
#pragma unroll 8
    for (int i = 0; i < 32; ++i) { const int kk = 2 * i + (lane >> 5); scr[kk * 33 + (lane & 31)] = W[(size_t)(k0 + kk) * N + n0 + (lane & 31)] * 64.0f; }
    LDS_WAIT(); asm volatile("" ::: "memory");
    const int c = lane & 7;
#pragma unroll
    for (int j = 0; j < 4; ++j) { const int n = (lane >> 3) + 8 * j; const LAS float* s = scr + (8 * c) * 33 + n;
        u32x2 o; o.x = cvt4_fp8(s[0 * 33], s[1 * 33], s[2 * 33], s[3 * 33]); o.y = cvt4_fp8(s[4 * 33], s[5 * 33], s[6 * 33], s[7 * 33]);
        *(u32x2*)(dst + (size_t)n * K + k0 + 8 * c) = o; }
    LDS_WAIT(); asm volatile("" ::: "memory");
}
DI void rms_row_to_bf16(const float* xrow, const float* g, bf16* orow, int lane) {
    const f32x4* xr = (const f32x4*)xrow + lane; const f32x4* gr = (const f32x4*)g + lane;
    f32x4 v[4]; float s = 0.f;
#pragma unroll
    for (int j = 0; j < 4; ++j) { v[j] = xr[64 * j]; s += (v[j].x * v[j].x + v[j].y * v[j].y) + (v[j].z * v[j].z + v[j].w * v[j].w); }
    const float rstd = 1.0f / sqrtf(wave_sum(s) * (1.f / DM) + NORM_EPS);
    u32x2* o8 = (u32x2*)orow + lane;
#pragma unroll
    for (int j = 0; j < 4; ++j) { const f32x4 gg = gr[64 * j]; u32x2 w; w.x = cvtpk(v[j].x * rstd * gg.x, v[j].y * rstd * gg.y); w.y = cvtpk(v[j].z * rstd * gg.z, v[j].w * rstd * gg.w); o8[64 * j] = w; }
}
constexpr int P0_IE1 = 32 * 16 * 64, P0_IE2 = 32 * 16 * 32;
DI void p0_experts(Frame& F, int vg  , int nvg) {
    LAS float* scr = (LAS float*)(F.lds + RING_OFF + F.wave * 16384);
    constexpr int P0_BASE = 2048 * 22; const bool light = (F.G == 256) && (F.bid >= 192); const int nlv = 64 * NWAVES, lv = (F.bid - 192) * NWAVES + F.wave;
    const int n_mine = (F.G == 256) ? 22 + (light ? 8 : 0) : (P0_IE1 + P0_IE2 + nvg - 1) / nvg;
    for (int j = 0; j < n_mine; ++j) {
        int it; if (F.G != 256) { it = vg + j * nvg; if (it >= P0_IE1 + P0_IE2) break; } else if (j < 22) it = vg + j * nvg; else it = P0_BASE + lv + (j - 22) * nlv;
        int r = it;
        if (r < P0_IE1) { const int e = r / 1024, q = r % 1024, kb = q / 64, nb = q % 64, n0 = 32 * nb;
            const int drow = n0 < 1024 ? 256 * (n0 >> 7) + (n0 & 127) : 256 * ((n0 - 1024) >> 7) + 128 + ((n0 - 1024) & 127);
            p0_tr_item_fp8(inp(F, I_WE1) + (size_t)e * 1024 * 2048, 2048, 1024, F.ws + WS_WE1 + ((size_t)e * 2048 + drow) * 1024, scr, 64 * kb, n0, F.lane); continue; }
        r -= P0_IE1;
        { const int e = r / 512, q = r % 512, kb = q / 32, nb = q % 32;
            p0_tr_item_fp8(inp(F, I_WE2) + (size_t)e * 1024 * 1024, 1024, 1024, F.ws + WS_WE2 + ((size_t)e * 1024 + 32 * nb) * 1024, scr, 64 * kb, 32 * nb, F.lane); }
    }
}


DI void p0_prologue(Frame& F) {
    LAS float* scr = (LAS float*)(F.lds + RING_OFF + F.wave * 16384);
    const int gw = F.bid * NWAVES + F.wave, NGW = F.G * NWAVES;
    constexpr int I0 = 16 * 208, I1 = 8 * 32, I2 = 16 * 32, I5 = 16 * 64;
    constexpr int NITEMS = I0 + I1 + 4 * I2 + I5;
    for (int it = gw; it < NITEMS; it += NGW) {
        int r = it;
        if (r < I0) { const int kb = r / 208, nb = r % 208; p0_tr_item(inp(F, I_WIN), NPROJ, 1024, (bf16*)(F.ws + WS_WIN) + (size_t)(32 * nb) * 1024, scr, 64 * kb, 32 * nb, F.lane); continue; } r -= I0;
        if (r < I1) { const int kb = r / 32, nb = r % 32; p0_tr_item(inp(F, I_WSBO), 1024, 512, (bf16*)(F.ws + WS_WSBO) + (size_t)(32 * nb) * 512, scr, 64 * kb, 32 * nb, F.lane); continue; } r -= I1;
        if (r < I2) { const int kb = r / 32, nb = r % 32; p0_tr_item(inp(F, I_WRETO), 1024, 1024, (bf16*)(F.ws + WS_WRETO) + (size_t)(32 * nb) * 1024, scr, 64 * kb, 32 * nb, F.lane); continue; } r -= I2;
        if (r < I2) { const int kb = r / 32, nb = r % 32; p0_tr_item(inp(F, I_WMIX), 1024, 1024, (bf16*)(F.ws + WS_WMIX) + (size_t)(32 * nb) * 1024, scr, 64 * kb, 32 * nb, F.lane); continue; } r -= I2;
        if (r < I2) { const int kb = r / 32, nb = r % 32; p0_tr_item(inp(F, I_WCQ), 1024, 1024, (bf16*)(F.ws + WS_WCQ) + (size_t)(32 * nb) * 1024, scr, 64 * kb, 32 * nb, F.lane, inp(F, I_GXATTN)); continue; }   r -= I2;
        if (r < I5) { const int kb = r / 64, nb = r % 64; p0_tr_item(inp(F, I_WCKV), 2048, 1024, (bf16*)(F.ws + WS_WCKV) + (size_t)(32 * nb) * 1024, scr, 64 * kb, 32 * nb, F.lane); continue; } r -= I5;
        { const int kb = r / 32, nb = r % 32; p0_tr_item(inp(F, I_WCO), 1024, 1024, (bf16*)(F.ws + WS_WCO) + (size_t)(32 * nb) * 1024, scr, 64 * kb, 32 * nb, F.lane); }
    }
    for (int m = gw; m < T + BATCH * MEML; m += NGW) {
        if (m < T) rms_row_to_bf16(inp(F, I_X) + (size_t)m * DM, inp(F, I_GMIX), (bf16*)(F.ws + WS_XN1) + (size_t)m * DM, F.lane);
        else rms_row_to_bf16(inp(F, I_MEM) + (size_t)(m - T) * DM, inp(F, I_GMEM), (bf16*)(F.ws + WS_MEMN) + (size_t)(m - T) * DM, F.lane);
    }
    { float* ct = (float*)(F.ws + WS_ROPE); float* st = ct + SEQ * 32;
      for (int i = F.bid * 512 + F.tid; i < SEQ * 32; i += F.G * 512) { const int pos = i >> 5, k = i & 31;
          const float inv = fexp2(-(float)k * (13.287712379549449f / 32.0f)); const float ang = (float)pos * inv;
          const float n = rintf(ang * 0.15915494309189535f); float r = fmaf(-n, 6.2831854820251465f, ang); r = fmaf(-n, -1.7484555e-7f, r);
          const float rev = r * 0.15915494309189535f; ct[i] = __builtin_amdgcn_cosf(rev); st[i] = __builtin_amdgcn_sinf(rev); } }
}

typedef f32x4 AccT[2][2][4][2];
#define EPI_ROWS_BEGIN _Pragma("unroll") for (int ai = 0; ai < 2; ++ai) _Pragma("unroll") for (int m = 0; m < 4; ++m) { const int rloc = ai * 128 + wr * 64 + m * 16 + fr; const size_t row = (size_t)u.pm * 256 + rloc; (void)row;
#define EPI_ROWS_END }
DI u32x4 pack8(f32x4 a, f32x4 b) { u32x4 w; w.x = cvtpk(a[0], a[1]); w.y = cvtpk(a[2], a[3]); w.z = cvtpk(b[0], b[1]); w.w = cvtpk(b[2], b[3]); return w; }
DI void unpack8(u32x4 w, f32x4& a, f32x4& b) { a = (f32x4){bflo(w.x), bfhi(w.x), bflo(w.y), bfhi(w.y)}; b = (f32x4){bflo(w.z), bfhi(w.z), bflo(w.w), bfhi(w.w)}; }
DI f32x4 sig4(f32x4 g) { return (f32x4){sigmoidf_(g[0]), sigmoidf_(g[1]), sigmoidf_(g[2]), sigmoidf_(g[3])}; }

struct Epi1 { static constexpr bool PERM = true, FP8 = false; bf16* proj; bf16* kvmem;
    DI void operator()(const AccT& acc, const pg8::Unit& u, int wr, int wc, int fr, int fq) const {
        bf16* base; int ldc; float sc = 1.f;
        if (u.tag == 0) { base = proj; ldc = NPROJ; if (u.pn < 2) sc = SBQ_SCALE; else if (u.pn == 8 || u.pn == 9) sc = 0.125f; } else { base = kvmem; ldc = 2048; }
        const int col0 = u.pn * 256 + wc * 32 + 8 * fq;
        EPI_ROWS_BEGIN
            bf16* rowp = base + row * ldc + col0;
#pragma unroll
            for (int bj = 0; bj < 2; ++bj) *(u32x4*)(rowp + bj * 128) = pack8(acc[ai][bj][m][0] * sc, acc[ai][bj][m][1] * sc);
        EPI_ROWS_END
    }
};
struct Epi5a { static constexpr bool PERM = true, FP8 = false; const bf16* proj; bf16* tmp;
    DI void operator()(const AccT& acc, const pg8::Unit& u, int wr, int wc, int fr, int fq) const {
        const int col0 = u.pn * 256 + wc * 32 + 8 * fq;
        EPI_ROWS_BEGIN
#pragma unroll
            for (int bj = 0; bj < 2; ++bj) { f32x4 g0, g1; unpack8(*(const u32x4*)(proj + row * NPROJ + C_GSB + col0 + bj * 128), g0, g1);
                *(u32x4*)(tmp + row * DM + col0 + bj * 128) = pack8(sig4(g0) * acc[ai][bj][m][0], sig4(g1) * acc[ai][bj][m][1]); }
        EPI_ROWS_END
    }
};
struct Epi5b { static constexpr bool PERM = true, FP8 = false; const bf16* proj; const bf16* tmp; bf16* merged;
    DI void operator()(const AccT& acc, const pg8::Unit& u, int wr, int wc, int fr, int fq) const {
        const int col0 = u.pn * 256 + wc * 32 + 8 * fq;
        EPI_ROWS_BEGIN
#pragma unroll
            for (int bj = 0; bj < 2; ++bj) { f32x4 g0, g1; unpack8(*(const u32x4*)(proj + row * NPROJ + C_GRET + col0 + bj * 128), g0, g1);
                f32x4 t0, t1; unpack8(*(const u32x4*)(tmp + row * DM + col0 + bj * 128), t0, t1);
                *(u32x4*)(merged + row * DM + col0 + bj * 128) = pack8(t0 + sig4(g0) * acc[ai][bj][m][0], t1 + sig4(g1) * acc[ai][bj][m][1]); }
        EPI_ROWS_END
    }
};
template <bool FIRST> struct EpiRes { static constexpr bool PERM = true, FP8 = false; const void* xi; bf16* xo; float* slots;
    DI void operator()(const AccT& acc, const pg8::Unit& u, int wr, int wc, int fr, int fq) const {
        const int col0 = u.pn * 256 + wc * 32 + 8 * fq;
        EPI_ROWS_BEGIN
            float ss = 0.f;
#pragma unroll
            for (int bj = 0; bj < 2; ++bj) { const size_t off = row * DM + col0 + bj * 128; f32x4 a, b;
                if (FIRST) { a = *(const f32x4*)((const float*)xi + off); b = *(const f32x4*)((const float*)xi + off + 4); } else unpack8(*(const u32x4*)((const bf16*)xi + off), a, b);
                a += acc[ai][bj][m][0]; b += acc[ai][bj][m][1];
                *(u32x4*)(xo + off) = pack8(a, b);
                if (FIRST) ss += (a[0] * a[0] + a[1] * a[1]) + (a[2] * a[2] + a[3] * a[3]) + (b[0] * b[0] + b[1] * b[1]) + (b[2] * b[2] + b[3] * b[3]); }
            if (FIRST) { ss += __shfl_xor(ss, 16); ss += __shfl_xor(ss, 32); if (fq == 0) slots[row * 16 + u.pn * 4 + wc] = ss; }
        EPI_ROWS_END
    }
};
struct Epi7 { static constexpr bool PERM = true, FP8 = false; const float* slots; bf16* qx;
    DI void operator()(const AccT& acc, const pg8::Unit& u, int wr, int wc, int fr, int fq) const {
        const int col0 = u.pn * 256 + wc * 32 + 8 * fq;
        EPI_ROWS_BEGIN
            const f32x4 s4 = *(const f32x4*)(slots + row * 16 + 4 * fq); float ss = (s4[0] + s4[1]) + (s4[2] + s4[3]); ss += __shfl_xor(ss, 16); ss += __shfl_xor(ss, 32);
            const float sc = XQ_SCALE / sqrtf(ss * (1.f / DM) + NORM_EPS);
#pragma unroll
            for (int bj = 0; bj < 2; ++bj) *(u32x4*)(qx + row * DM + col0 + bj * 128) = pack8(acc[ai][bj][m][0] * sc, acc[ai][bj][m][1] * sc);
        EPI_ROWS_END
    }
};
struct Epi12 { static constexpr bool PERM = true, FP8 = true; static constexpr int SCALE_W = 0x79797979, SCALE_A = 0x7f7f7f7f;   const float* rscale; const float* b1; unsigned char* act;
    DI void operator()(const AccT& acc, const pg8::Unit& u, int wr, int wc, int fr, int fq) const {
        const int ac0 = u.pn * 128 + wc * 32 + 8 * fq; const float* bb = b1 + (size_t)u.e * 2048;
        const f32x4 bg0 = *(const f32x4*)(bb + ac0), bg1 = *(const f32x4*)(bb + ac0 + 4), bl0 = *(const f32x4*)(bb + 1024 + ac0), bl1 = *(const f32x4*)(bb + 1024 + ac0 + 4);
        EPI_ROWS_BEGIN
            const float rs = rscale[row];
            f32x4 o[2];
#pragma unroll
            for (int n = 0; n < 2; ++n) { const f32x4 gl = acc[ai][0][m][n] * rs + (n ? bg1 : bg0), li = acc[ai][1][m][n] * rs + (n ? bl1 : bl0);
#pragma unroll
                for (int i = 0; i < 4; ++i) { const float gg = fminf(gl[i], 7.0f), ll = fminf(fmaxf(li[i], -7.0f), 7.0f); o[n][i] = gg * frcp(1.0f + fexp2(-1.702f * LOG2E * gg)) * (ll + 1.0f); } }
            { u32x2 w; w.x = cvt4_fp8(o[0][0], o[0][1], o[0][2], o[0][3]); w.y = cvt4_fp8(o[1][0], o[1][1], o[1][2], o[1][3]); *(u32x2*)(act + row * DFF + ac0) = w; }
        EPI_ROWS_END
    }
};
struct Epi13 { static constexpr bool PERM = true, FP8 = true; static constexpr int SCALE_W = 0x79797979, SCALE_A = 0x7f7f7f7f; const float* rgate; const float* b2; bf16* yrows;
    DI void operator()(const AccT& acc, const pg8::Unit& u, int wr, int wc, int fr, int fq) const {
        const int col0 = u.pn * 256 + wc * 32 + 8 * fq; const float* bb = b2 + (size_t)u.e * 1024 + col0;
        f32x4 bv[2][2];
#pragma unroll
        for (int bj = 0; bj < 2; ++bj) { bv[bj][0] = *(const f32x4*)(bb + bj * 128); bv[bj][1] = *(const f32x4*)(bb + bj * 128 + 4); }
        EPI_ROWS_BEGIN
            const float gt = rgate[row];
#pragma unroll
            for (int bj = 0; bj < 2; ++bj) *(u32x4*)(yrows + row * DM + col0 + bj * 128) = pack8((acc[ai][bj][m][0] + bv[bj][0]) * gt, (acc[ai][bj][m][1] + bv[bj][1]) * gt);
        EPI_ROWS_END
    }
};

DI void lds_barrier() { asm volatile("s_waitcnt lgkmcnt(0)" ::: "memory"); __builtin_amdgcn_s_barrier(); asm volatile("" ::: "memory"); }

constexpr int SB_K = 0, SB_V = 8192;
DI void sb_unit(Frame& F, int b, int h, int qb) {
    const int lane = F.lane, r32 = lane & 31, hi = lane >> 5, wid = F.wave;
    LAS char* lds = (LAS char*)F.lds;
    const bf16* Pj = (const bf16*)(F.ws + WS_PROJ) + (size_t)b * SEQ * NPROJ;
    const int qw0 = qb * 256 + wid * 32, q = qw0 + r32;
    bf16x8 qr[4];
#pragma unroll
    for (int d0 = 0; d0 < 4; ++d0) qr[d0] = *(const bf16x8*)(Pj + (size_t)q * NPROJ + C_SBQ + h * 64 + d0 * 16 + hi * 8);
    f32x16 o0, o1;
#pragma unroll
    for (int r = 0; r < 16; ++r) { o0[r] = 0.f; o1[r] = 0.f; }
    float carry = 0.f;
    const bf16* ksrc = Pj + (size_t)lane * NPROJ + C_SBK + h * 64 + wid * 8;
    const bf16* vsrc = Pj + (size_t)(16 * (wid & 3) + (lane >> 2)) * NPROJ + C_SBV + h * 64 + (wid >> 2) * 32 + (lane & 3) * 8;
    LAS char* kdst = lds + SB_K + wid * 1024 + lane * 16; LAS char* vdst = lds + SB_V + wid * 1024 + lane * 16;
    const LAS char* kp0 = lds + SB_K + hi * 1024 + r32 * 16;
    const LAS char* vp0 = lds + SB_V + ((lane >> 4) & 1) * 32 + (lane & 3) * 8 + (4 * hi + ((lane & 15) >> 2)) * 64;
    int kt = 4 * qb + 3, par = 0;
    volatile LAS int* flg = (volatile LAS int*)(lds + XTRA_OFF + 1024);
    u32x4 kreg = *(const u32x4*)(ksrc + (size_t)kt * 64 * NPROJ), vreg = *(const u32x4*)(vsrc + (size_t)kt * 64 * NPROJ);
    for (;;) {
        *(LAS u32x4*)kdst = kreg; *(LAS u32x4*)vdst = vreg;
        __syncthreads();
        if (kt > 0) { kreg = *(const u32x4*)(ksrc + (size_t)(kt - 1) * 64 * NPROJ); vreg = *(const u32x4*)(vsrc + (size_t)(kt - 1) * 64 * NPROJ); }
        const int k0 = kt * 64;
        const bool active = (k0 < qw0 + 31) && !__all(carry >= SB_THR);
        if (active) {
            f32x16 p0, p1;
#pragma unroll
            for (int r = 0; r < 16; ++r) { p0[r] = 0.f; p1[r] = 0.f; }
#pragma unroll
            for (int d0 = 0; d0 < 4; ++d0) { const bf16x8 a0 = *(const LAS bf16x8*)(kp0 + d0 * 2048), a1 = *(const LAS bf16x8*)(kp0 + d0 * 2048 + 512);
                p0 = MFMA32(a0, qr[d0], p0); p1 = MFMA32(a1, qr[d0], p1); }
            const bool mask = (k0 + 63 >= qw0);
            float sp[8][4], Mj[8];
#pragma unroll
            for (int j = 0; j < 8; ++j) { float s = 0.f;
#pragma unroll
                for (int i = 0; i < 4; ++i) { const float zl = (j < 4) ? p0[4 * (j & 3) + i] : p1[4 * (j & 3) + i];
                    float v = fmaxf(zl, 0.f) + flog2(1.0f + fexp2(-fabsf(zl)));
                    if (mask) { const int key = k0 + 32 * (j >> 2) + 8 * (j & 3) + 4 * hi + i; v = (key < q) ? v : 0.f; }
                    sp[j][i] = v; s += v; }
                Mj[j] = s; }
            float ps = 0.f; u32x4 pw[4];
#pragma unroll
            for (int j = 7; j >= 0; --j) {
                const auto rr = __builtin_amdgcn_permlane32_swap(__float_as_uint(Mj[j]), __float_as_uint(Mj[j]), false, false);
                const float Pp = __uint_as_float(hi ? rr[0] : rr[1]);
                float C = carry + ps + (hi ? 0.f : Pp);
                float w[4];
#pragma unroll
                for (int i = 3; i >= 0; --i) { const float zl = (j < 4) ? p0[4 * (j & 3) + i] : p1[4 * (j & 3) + i];
                    C += sp[j][i]; float wv = fexp2(zl - C);
                    if (mask) { const int key = k0 + 32 * (j >> 2) + 8 * (j & 3) + 4 * hi + i; wv = (key < q) ? wv : 0.f; }
                    w[i] = wv; }
                pw[j >> 1][2 * (j & 1)] = cvtpk(w[0], w[1]); pw[j >> 1][2 * (j & 1) + 1] = cvtpk(w[2], w[3]);
                ps += Mj[j] + Pp; }
            carry += ps;
#pragma unroll
            for (int ks = 0; ks < 4; ++ks) {
                const s16x4 l0 = vtr(vp0 + ks * 1024), h0 = vtr(vp0 + ks * 1024 + 512), l1 = vtr(vp0 + 4096 + ks * 1024), h1 = vtr(vp0 + 4096 + ks * 1024 + 512);
                const bf16x8 pa = __builtin_bit_cast(bf16x8, pw[ks]);
                o0 = MFMA32(pa, ((bf16x8){l0[0], l0[1], l0[2], l0[3], h0[0], h0[1], h0[2], h0[3]}), o0);
                o1 = MFMA32(pa, ((bf16x8){l1[0], l1[1], l1[2], l1[3], h1[0], h1[1], h1[2], h1[3]}), o1); }
        }
        const int need = (kt > 0) && !__all(carry >= SB_THR);
        if (lane == 0) flg[par * 8 + wid] = need;
        __syncthreads();
        const int any = (flg[par * 8] | flg[par * 8 + 1]) | (flg[par * 8 + 2] | flg[par * 8 + 3]) | (flg[par * 8 + 4] | flg[par * 8 + 5]) | (flg[par * 8 + 6] | flg[par * 8 + 7]);
        par ^= 1;
        if (!any) break;
        --kt;
    }
    bf16* Y = (bf16*)(F.ws + WS_YSB) + (size_t)(b * SEQ + qw0) * 512 + h * 64 + r32;
#pragma unroll
    for (int r = 0; r < 16; ++r) { const int rw = crow(r, hi); Y[(size_t)rw * 512] = (bf16)(cvtpk(o0[r], 0.f) & 0xffffu); Y[(size_t)rw * 512 + 32] = (bf16)(cvtpk(o1[r], 0.f) & 0xffffu); }
}

DI float ret_log2g(int h) { const float x = fexp2(-(float)(5 + h)); return -LOG2E * (x * (1.0f + x * (0.5f + x * (0.33333334f + x * (0.25f + x * 0.2f))))); }
DI int vlay(int tok, int col) { return (col >> 5) * 4096 + (tok >> 4) * 1024 + (tok & 15) * 64 + (col & 31) * 2; }
struct RotRegs { u32x4 a, b; f32x4 c0, c1, s0, s1; };
DI void rot_load(RotRegs& R, const bf16* row  , const float* rope, int pos, int c) {
    R.a = *(const u32x4*)(row + 8 * c); R.b = *(const u32x4*)(row + 32 + 8 * c);
    const float* ct = rope + pos * 32 + 8 * c; const float* st = ct + SEQ * 32;
    R.c0 = *(const f32x4*)ct; R.c1 = *(const f32x4*)(ct + 4); R.s0 = *(const f32x4*)st; R.s1 = *(const f32x4*)(st + 4);
}
DI void rot_apply(const RotRegs& R, f32x4& y1a, f32x4& y1b, f32x4& y2a, f32x4& y2b) {
    f32x4 x1a, x1b, x2a, x2b; unpack8(R.a, x1a, x1b); unpack8(R.b, x2a, x2b);
    y1a = x1a * R.c0 - x2a * R.s0; y1b = x1b * R.c1 - x2b * R.s1; y2a = x1a * R.s0 + x2a * R.c0; y2b = x1b * R.s1 + x2b * R.c1;
}

constexpr int RT_KD = 16384, RT_V = 24576;
DI void rt_unit(Frame& F, int b, int h, int g) {
    const int lane = F.lane, r32 = lane & 31, hi = lane >> 5, wid = F.wave, tid = F.tid, di = wid >> 2, dj = wid & 3;
    LAS char* lds = (LAS char*)F.lds;
    const bf16* Pj = (const bf16*)(F.ws + WS_PROJ) + (size_t)(b * SEQ + g * 512) * NPROJ;
    const float* rope = (const float*)(F.ws + WS_ROPE);
    const float lg = ret_log2g(h);
    f32x16 acc;
#pragma unroll
    for (int r = 0; r < 16; ++r) acc[r] = 0.f;
    const int ktok = tid >> 2, kc = tid & 3;
    RotRegs R; u32x4 v0, v1;
    const int vt0 = tid >> 4, vc0 = tid & 15, vt1 = (tid + 512) >> 4;
#define RT_LOADS(step_) do { const bf16* base_ = Pj + (size_t)((step_) * 64) * NPROJ; \
        if (tid < 256) rot_load(R, base_ + (size_t)ktok * NPROJ + C_RK + h * 64, rope, g * 512 + (step_) * 64 + ktok, kc); \
        v0 = *(const u32x4*)(base_ + (size_t)vt0 * NPROJ + C_RV + h * 128 + 8 * vc0); v1 = *(const u32x4*)(base_ + (size_t)vt1 * NPROJ + C_RV + h * 128 + 8 * vc0); } while (0)
    RT_LOADS(0);
    const LAS char* trb = lds + ((lane >> 4) & 1) * 32 + (lane & 3) * 8 + (4 * hi + ((lane & 15) >> 2)) * 64;
    for (int step = 0; step < 8; ++step) {
        if (tid < 256) { f32x4 y1a, y1b, y2a, y2b; rot_apply(R, y1a, y1b, y2a, y2b); const float dec = fexp2(lg * (float)(511 - (step * 64 + ktok)));
            *(LAS u32x4*)(lds + RT_KD + vlay(ktok, 8 * kc)) = pack8(y1a * dec, y1b * dec); *(LAS u32x4*)(lds + RT_KD + vlay(ktok, 32 + 8 * kc)) = pack8(y2a * dec, y2b * dec); }
        *(LAS u32x4*)(lds + RT_V + vlay(vt0, 8 * vc0)) = v0; *(LAS u32x4*)(lds + RT_V + vlay(vt1, 8 * vc0)) = v1;
        __syncthreads();
        if (step < 7) RT_LOADS(step + 1);
#pragma unroll
        for (int ks = 0; ks < 4; ++ks) {
            const s16x4 al = vtr(trb + RT_KD + di * 4096 + ks * 1024), ah = vtr(trb + RT_KD + di * 4096 + ks * 1024 + 512);
            const s16x4 bl = vtr(trb + RT_V + dj * 4096 + ks * 1024), bh = vtr(trb + RT_V + dj * 4096 + ks * 1024 + 512);
            acc = MFMA32(((bf16x8){al[0], al[1], al[2], al[3], ah[0], ah[1], ah[2], ah[3]}), ((bf16x8){bl[0], bl[1], bl[2], bl[3], bh[0], bh[1], bh[2], bh[3]}), acc); }
        __syncthreads();
    }
    float* G = (float*)(F.ws + WS_GTOT) + (size_t)((b * 8 + h) * 4 + g) * 8192 + dj * 32 + r32;
#pragma unroll
    for (int r = 0; r < 16; ++r) G[(di * 32 + crow(r, hi)) * 128] = acc[r];
}

constexpr int RO_QD = 0, RO_KI = 8192, RO_KD = 16384, RO_V = 24576, RO_SS = 40960, RO_OST = 57344;
DI void ro_unit(Frame& F, int b, int h, int g) {
    const int lane = F.lane, r32 = lane & 31, hi = lane >> 5, wid = F.wave, tid = F.tid, ci = wid >> 2, dj = wid & 3;
    LAS char* lds = (LAS char*)F.lds;
    const bf16* Pg = (const bf16*)(F.ws + WS_PROJ) + (size_t)(b * SEQ + g * 512) * NPROJ;
    const float* rope = (const float*)(F.ws + WS_ROPE);
    const float lg = ret_log2g(h);
    f32x16 st;
#pragma unroll
    for (int r = 0; r < 16; ++r) st[r] = 0.f;
    for (int gp = 0; gp < g; ++gp) { const float coef = fexp2(lg * (float)(512 * (g - 1 - gp)));
        const float* G = (const float*)(F.ws + WS_GTOT) + (size_t)((b * 8 + h) * 4 + gp) * 8192 + dj * 32 + r32;
#pragma unroll
        for (int r = 0; r < 16; ++r) st[r] += coef * G[(ci * 32 + crow(r, hi)) * 128]; }
    const float dec64 = fexp2(lg * 64.0f);
    const bool isq = tid < 256; const int rtok = (tid & 255) >> 2, rc = tid & 3;
    RotRegs R; u32x4 v0, v1, gn0, gn1, gc0, gc1;
    const int vt0 = tid >> 4, vc0 = tid & 15, vt1 = (tid + 512) >> 4;
    const int grow = tid >> 3, gseg = tid & 7;
#define RO_LOADS(n_) do { const bf16* base_ = Pg + (size_t)((n_) * 64) * NPROJ; \
        rot_load(R, base_ + (size_t)rtok * NPROJ + (isq ? C_RQ : C_RK) + h * 64, rope, g * 512 + (n_) * 64 + rtok, rc); \
        v0 = *(const u32x4*)(base_ + (size_t)vt0 * NPROJ + C_RV + h * 128 + 8 * vc0); v1 = *(const u32x4*)(base_ + (size_t)vt1 * NPROJ + C_RV + h * 128 + 8 * vc0); \
        gn0 = *(const u32x4*)(base_ + (size_t)grow * NPROJ + C_RG + h * 128 + gseg * 16); gn1 = *(const u32x4*)(base_ + (size_t)grow * NPROJ + C_RG + h * 128 + gseg * 16 + 8); } while (0)
    RO_LOADS(0);
    const LAS char* trv = lds + ((lane >> 4) & 1) * 32 + (lane & 3) * 8 + (4 * hi + ((lane & 15) >> 2)) * 64;
    const LAS char* trs = lds + ((lane >> 4) & 1) * 32 + (lane & 3) * 8 + (8 * hi + ((lane & 15) >> 2)) * 64;
    for (int n = 0; n < 8; ++n) {
        lds_barrier();
        gc0 = gn0; gc1 = gn1;
        { f32x4 y1a, y1b, y2a, y2b; rot_apply(R, y1a, y1b, y2a, y2b);
          if (isq) { const float s = fexp2(lg * (float)(rtok + 1));
              *(LAS u32x4*)(lds + RO_QD + rc * 1024 + rtok * 16) = pack8(y1a * s, y1b * s); *(LAS u32x4*)(lds + RO_QD + (rc + 4) * 1024 + rtok * 16) = pack8(y2a * s, y2b * s); }
          else { const float si = fexp2(-lg * (float)(rtok + 1)), sd = fexp2(lg * (float)(63 - rtok));
              *(LAS u32x4*)(lds + RO_KI + rc * 1024 + rtok * 16) = pack8(y1a * si, y1b * si); *(LAS u32x4*)(lds + RO_KI + (rc + 4) * 1024 + rtok * 16) = pack8(y2a * si, y2b * si);
              *(LAS u32x4*)(lds + RO_KD + vlay(rtok, 8 * rc)) = pack8(y1a * sd, y1b * sd); *(LAS u32x4*)(lds + RO_KD + vlay(rtok, 32 + 8 * rc)) = pack8(y2a * sd, y2b * sd); } }
        *(LAS u32x4*)(lds + RO_V + vlay(vt0, 8 * vc0)) = v0; *(LAS u32x4*)(lds + RO_V + vlay(vt1, 8 * vc0)) = v1;
#pragma unroll
        for (int r = 0; r < 16; ++r) *(LAS bf16*)(lds + RO_SS + vlay(ci * 32 + crow(r, hi), dj * 32 + r32)) = (bf16)(cvtpk(st[r], 0.f) & 0xffffu);
        lds_barrier();
        if (n < 7) RO_LOADS(n + 1);
        bf16x8 qf[4];
#pragma unroll
        for (int d0 = 0; d0 < 4; ++d0) qf[d0] = *(const LAS bf16x8*)(lds + RO_QD + (2 * d0 + hi) * 1024 + (ci * 32 + r32) * 16);
        f32x16 p0, p1, o;
#pragma unroll
        for (int r = 0; r < 16; ++r) { p0[r] = 0.f; p1[r] = 0.f; o[r] = 0.f; }
#pragma unroll
        for (int d0 = 0; d0 < 4; ++d0) { p0 = MFMA32(*(const LAS bf16x8*)(lds + RO_KI + (2 * d0 + hi) * 1024 + r32 * 16), qf[d0], p0);
            if (ci) p1 = MFMA32(*(const LAS bf16x8*)(lds + RO_KI + (2 * d0 + hi) * 1024 + 512 + r32 * 16), qf[d0], p1); }
        const int ql = ci * 32 + r32;
        u32x4 pw[4];
#pragma unroll
        for (int j = 0; j < 8; ++j) { float w[4];
#pragma unroll
            for (int i = 0; i < 4; ++i) { const float z = (j < 4) ? p0[4 * (j & 3) + i] : p1[4 * (j & 3) + i]; const int key = 32 * (j >> 2) + 8 * (j & 3) + 4 * hi + i; w[i] = (key <= ql) ? z : 0.f; }
            pw[j >> 1][2 * (j & 1)] = cvtpk(w[0], w[1]); pw[j >> 1][2 * (j & 1) + 1] = cvtpk(w[2], w[3]); }
#pragma unroll
        for (int r = 0; r < 16; ++r) st[r] *= dec64;
#pragma unroll
        for (int ks = 0; ks < 4; ++ks) {
            const s16x4 bl = vtr(trv + RO_V + dj * 4096 + ks * 1024), bh = vtr(trv + RO_V + dj * 4096 + ks * 1024 + 512);
            const bf16x8 vf = (bf16x8){bl[0], bl[1], bl[2], bl[3], bh[0], bh[1], bh[2], bh[3]};
            if (ks < 2 || ci) o = MFMA32(__builtin_bit_cast(bf16x8, pw[ks]), vf, o);
            const s16x4 al = vtr(trv + RO_KD + ci * 4096 + ks * 1024), ah = vtr(trv + RO_KD + ci * 4096 + ks * 1024 + 512);
            st = MFMA32(((bf16x8){al[0], al[1], al[2], al[3], ah[0], ah[1], ah[2], ah[3]}), vf, st); }
#pragma unroll
        for (int d0 = 0; d0 < 4; ++d0) { const s16x4 sl = vtr(trs + RO_SS + dj * 4096 + d0 * 1024), sh = vtr(trs + RO_SS + dj * 4096 + d0 * 1024 + 256);
            o = MFMA32(qf[d0], ((bf16x8){sl[0], sl[1], sl[2], sl[3], sh[0], sh[1], sh[2], sh[3]}), o); }
#pragma unroll
        for (int r = 0; r < 16; ++r) *(LAS float*)(lds + RO_OST + ((ci * 32 + crow(r, hi)) * 132 + dj * 32 + r32) * 4) = o[r];
        lds_barrier();
        { const LAS float* orow = (const LAS float*)(lds + RO_OST) + grow * 132 + gseg * 16; f32x4 x[4]; float s = 0.f;
#pragma unroll
          for (int k = 0; k < 4; ++k) { x[k] = *(const LAS f32x4*)(orow + 4 * k); s += (x[k][0] + x[k][1]) + (x[k][2] + x[k][3]); }
          s += __shfl_xor(s, 1); s += __shfl_xor(s, 2); s += __shfl_xor(s, 4);
          const float mu = s * (1.f / 128.f); float qv = 0.f;
#pragma unroll
          for (int k = 0; k < 4; ++k) { x[k] = x[k] - mu; qv += (x[k][0] * x[k][0] + x[k][1] * x[k][1]) + (x[k][2] * x[k][2] + x[k][3] * x[k][3]); }
          qv += __shfl_xor(qv, 1); qv += __shfl_xor(qv, 2); qv += __shfl_xor(qv, 4);
          const float rstd = 1.0f / sqrtf(qv * (1.f / 128.f) + NORM_EPS);
          const size_t trow = (size_t)(b * SEQ + g * 512 + n * 64 + grow);
          f32x4 g0, g1, g2, g3; unpack8(gc0, g0, g1); unpack8(gc1, g2, g3);
          bf16* yo = (bf16*)(F.ws + WS_YRET) + trow * DM + h * 128 + gseg * 16;
          *(u32x4*)yo = pack8(g0 * sig4(g0) * x[0] * rstd, g1 * sig4(g1) * x[1] * rstd); *(u32x4*)(yo + 8) = pack8(g2 * sig4(g2) * x[2] * rstd, g3 * sig4(g3) * x[3] * rstd); }
    }
}

DI void xa_unit(Frame& F, int b, int hx, int qb) {
    const int lane = F.lane, r32 = lane & 31, hi = lane >> 5, wid = F.wave, tid = F.tid;
    LAS char* lds = (LAS char*)F.lds;
    const int qw0 = qb * 256 + wid * 32;
    const bf16* Q = (const bf16*)(F.ws + WS_QX) + (size_t)(b * SEQ + qw0 + r32) * DM + hx * 256 + hi * 8;
    const bf16* KV = (const bf16*)(F.ws + WS_KVMEM) + (size_t)(b * MEML) * 2048 + hx * 256;
    bf16x8 qr[16];
#pragma unroll
    for (int d0 = 0; d0 < 16; ++d0) qr[d0] = *(const bf16x8*)(Q + d0 * 16);
    __syncthreads();
#pragma unroll 4
    for (int j = 0; j < 16; ++j) { const int i = tid + 512 * j, c = i & 31, key = i >> 5;
        *(LAS u32x4*)(lds + (key >> 6) * 32768 + c * 1024 + (key & 63) * 16) = *(const u32x4*)(KV + (size_t)key * 2048 + 8 * c); }
    __syncthreads();
    f32x16 sc[8];
#pragma unroll
    for (int t = 0; t < 8; ++t)
#pragma unroll
        for (int r = 0; r < 16; ++r) sc[t][r] = 0.f;
#pragma unroll
    for (int kt = 0; kt < 4; ++kt)
#pragma unroll
        for (int d0 = 0; d0 < 16; ++d0) { const LAS char* kp = lds + kt * 32768 + (2 * d0 + hi) * 1024 + r32 * 16;
            sc[2 * kt] = MFMA32(*(const LAS bf16x8*)kp, qr[d0], sc[2 * kt]); sc[2 * kt + 1] = MFMA32(*(const LAS bf16x8*)(kp + 512), qr[d0], sc[2 * kt + 1]); }
    float mx = -3.0e38f;
#pragma unroll
    for (int t = 0; t < 8; ++t)
#pragma unroll
        for (int r = 0; r < 16; ++r) mx = fmaxf(mx, sc[t][r]);
    { const auto rr = __builtin_amdgcn_permlane32_swap(__float_as_uint(mx), __float_as_uint(mx), false, false); mx = fmaxf(__uint_as_float(rr[0]), __uint_as_float(rr[1])); }
    float l = 0.f; u32x4 pa[16];
#pragma unroll
    for (int t = 0; t < 8; ++t)
#pragma unroll
        for (int r2 = 0; r2 < 8; ++r2) { const float e0 = fexp2(sc[t][2 * r2] - mx), e1 = fexp2(sc[t][2 * r2 + 1] - mx); l += e0 + e1; pa[2 * t + (r2 >> 2)][r2 & 3] = cvtpk(e0, e1); }
    { const auto rr = __builtin_amdgcn_permlane32_swap(__float_as_uint(l), __float_as_uint(l), false, false); l = __uint_as_float(rr[0]) + __uint_as_float(rr[1]); }
    LAS float* wsf = (LAS float*)(lds + XTRA_OFF) + wid * 32;
    if (hi == 0) wsf[r32] = 1.0f / l;
    __syncthreads();
#pragma unroll 4
    for (int j = 0; j < 16; ++j) { const int i = tid + 512 * j, c = i & 31, key = i >> 5;
        *(LAS u32x4*)(lds + (key >> 6) * 32768 + (c >> 2) * 4096 + ((key & 63) >> 4) * 1024 + (key & 15) * 64 + (c & 3) * 16) = *(const u32x4*)(KV + (size_t)key * 2048 + 1024 + 8 * c); }
    __syncthreads();
    f32x16 o[8];
#pragma unroll
    for (int t = 0; t < 8; ++t)
#pragma unroll
        for (int r = 0; r < 16; ++r) o[t][r] = 0.f;
    const LAS char* vp0 = lds + ((lane >> 4) & 1) * 32 + (lane & 3) * 8 + (4 * hi + ((lane & 15) >> 2)) * 64;
#pragma unroll
    for (int vt = 0; vt < 4; ++vt)
#pragma unroll
        for (int ks = 0; ks < 4; ++ks) { const bf16x8 pf = __builtin_bit_cast(bf16x8, pa[4 * vt + ks]);
#pragma unroll
            for (int d0 = 0; d0 < 8; ++d0) { const s16x4 lo = vtr(vp0 + vt * 32768 + d0 * 4096 + ks * 1024), hh = vtr(vp0 + vt * 32768 + d0 * 4096 + ks * 1024 + 512);
                o[d0] = MFMA32(pf, ((bf16x8){lo[0], lo[1], lo[2], lo[3], hh[0], hh[1], hh[2], hh[3]}), o[d0]); } }
    bf16* O = (bf16*)(F.ws + WS_OX) + (size_t)(b * SEQ + qw0) * DM + hx * 256 + r32;
#pragma unroll
    for (int r = 0; r < 16; ++r) { const int rw = crow(r, hi); const float il = wsf[rw];
#pragma unroll
        for (int d0 = 0; d0 < 8; ++d0) O[(size_t)rw * DM + d0 * 32] = (bf16)(cvtpk(o[d0][r] * il, 0.f) & 0xffffu); }
}

DI void route_a(Frame& F, int tb) {
    const int lane = F.lane, wid = F.wave, tid = F.tid, tg = wid >> 2, kq = wid & 3, hi = lane >> 5, e31 = lane & 31;
    LAS char* lds = (LAS char*)F.lds;
    const float* wr = inp(F, I_WROUTER); const float* gm = inp(F, I_GMOE); const bf16* x2 = (const bf16*)(F.ws + WS_XN3U);
    unsigned char* sm = F.ws + WS_SMALL;
    __syncthreads();
#pragma unroll 4
    for (int j = 0; j < 16; ++j) { const int i = tid + 512 * j, k = i >> 3, e4 = (i & 7) * 4; *(LAS f32x4*)(lds + (k * 32 + e4) * 4) = *(const f32x4*)(wr + k * 32 + e4) * gm[k]; }
    __syncthreads();
    const int tok = tb * 64 + tg * 32 + e31;
    const bf16* xr = x2 + (size_t)tok * DM + kq * 256 + 4 * hi;
    f32x16 acc;
#pragma unroll
    for (int r = 0; r < 16; ++r) acc[r] = 0.f;
    float ss = 0.f;
    const LAS float* WR = (const LAS float*)lds + (kq * 256 + 4 * hi) * 32 + e31;
    u32x2 xv[32];
#pragma unroll
    for (int m = 0; m < 32; ++m) xv[m] = *(const u32x2*)(xr + 8 * m);
#pragma unroll
    for (int m = 0; m < 32; ++m) { const f32x4 x4 = (f32x4){bflo(xv[m].x), bfhi(xv[m].x), bflo(xv[m].y), bfhi(xv[m].y)}; ss += (x4[0] * x4[0] + x4[1] * x4[1]) + (x4[2] * x4[2] + x4[3] * x4[3]);
#pragma unroll
        for (int t = 0; t < 4; ++t) acc = __builtin_amdgcn_mfma_f32_32x32x2f32(x4[t], WR[(8 * m + t) * 32], acc, 0, 0, 0); }
    ss += __shfl_xor(ss, 32);
    __syncthreads();
    LAS float* PL = (LAS float*)lds;
    LAS float* SSP = (LAS float*)(lds + 32768);
    LAS float* LG = (LAS float*)(lds + 36864);
    LAS int* SEL = (LAS int*)(lds + 49152);
#pragma unroll
    for (int r = 0; r < 16; ++r) PL[(kq * 64 + tg * 32 + crow(r, hi)) * 32 + e31] = acc[r];
    if (hi == 0) SSP[kq * 64 + tg * 32 + e31] = ss;
    __syncthreads();
#pragma unroll
    for (int j = 0; j < 4; ++j) { const int idx = tid + 512 * j, tl = idx >> 5, e = idx & 31;
        const float rstd = 1.0f / sqrtf(((SSP[tl] + SSP[64 + tl]) + (SSP[128 + tl] + SSP[192 + tl])) * (1.f / DM) + NORM_EPS);
        LG[tl * 33 + e] = rstd * ((PL[tl * 32 + e] + PL[(64 + tl) * 32 + e]) + (PL[(128 + tl) * 32 + e] + PL[(192 + tl) * 32 + e])) + inp(F, I_BROUTER)[e];
        if (e == 0) ((float*)(sm + SM_RSTD3))[tb * 64 + tl] = rstd; }
    __syncthreads();
    if (tid < 64) {
        int sel[4]; float val[4];
#pragma unroll
        for (int k = 0; k < 4; ++k) { float best = -3.0e38f; int bi = 0;
            for (int e = 0; e < 32; ++e) { const float v = LG[tid * 33 + e]; bool taken = false;
#pragma unroll
                for (int k2 = 0; k2 < 4; ++k2) if (k2 < k) taken = taken || (sel[k2] == e);
                if (!taken && v > best) { best = v; bi = e; } }
            sel[k] = bi; val[k] = best; }
        float ex[4], sum = 0.f;
#pragma unroll
        for (int k = 0; k < 4; ++k) { ex[k] = fexp2((val[k] - val[0]) * LOG2E); sum += ex[k]; }
        const float inv = 1.0f / sum; const int tk = tb * 64 + tid;
#pragma unroll
        for (int k = 0; k < 4; ++k) { ((int*)(sm + SM_TOPE))[tk * 4 + k] = sel[k]; ((float*)(sm + SM_GATE))[tk * 4 + k] = ex[k] * inv; SEL[tid * 4 + k] = sel[k]; }
    }
    __syncthreads();
    LAS int* WC = (LAS int*)(lds + 51200);
    int e_my = 0, rank_w = 0;
    if (tid < 256) { e_my = SEL[tid]; const unsigned long long lt = (1ull << lane) - 1ull;
        for (int ex = 0; ex < 32; ++ex) { const unsigned long long m = __ballot(e_my == ex); if (e_my == ex) rank_w = __popcll(m & lt); if (lane == ex) WC[wid * 32 + ex] = __popcll(m); } }
    __syncthreads();
    if (tid < 256) { int rank = rank_w; for (int w = 0; w < wid; ++w) rank += WC[w * 32 + e_my]; ((int*)(sm + SM_LRANK))[(tb * 64 + (tid >> 2)) * 4 + (tid & 3)] = rank; }
    else if (tid < 288) { const int e = tid - 256; ((int*)(sm + SM_CNT))[tb * 32 + e] = (WC[e] + WC[32 + e]) + (WC[64 + e] + WC[96 + e]); }
}

DI void route_b(Frame& F, int tb) {
    const int lane = F.lane, wid = F.wave, tid = F.tid;
    LAS int* L = (LAS int*)F.lds;
    unsigned char* sm = F.ws + WS_SMALL;
    const int* CNT = (const int*)(sm + SM_CNT);
    u32x4 xv[8][2];
#pragma unroll
    for (int j = 0; j < 8; ++j) { const u32x4* sp = (const u32x4*)((const bf16*)(F.ws + WS_XN3U) + (size_t)(tb * 64 + wid * 8 + j) * DM) + 2 * lane; xv[j][0] = sp[0]; xv[j][1] = sp[1]; }
    __syncthreads();
    { const int e = tid & 31, seg = tid >> 5; int t = 0, p = 0;
      for (int w = seg * 16; w < seg * 16 + 16; ++w) { const int c = CNT[w * 32 + e]; t += c; p += (w < tb) ? c : 0; }
      L[seg * 32 + e] = t; L[512 + seg * 32 + e] = p; }
    __syncthreads();
    if (tid < 32) { int t = 0, p = 0; for (int s = 0; s < 16; ++s) { t += L[s * 32 + tid]; p += L[512 + s * 32 + tid]; } L[1024 + tid] = t; L[1056 + tid] = p; }
    __syncthreads();
    if (tid == 0) { int run = 0; for (int e = 0; e < 32; ++e) { L[1088 + e] = run; run += ((L[1024 + e] + 255) >> 8) << 8; } L[1120] = run >> 8; }
    __syncthreads();
    if (tid < 256) { const int tok = tb * 64 + (tid >> 2), a = tok * 4 + (tid & 3); const int e = ((const int*)(sm + SM_TOPE))[a];
        const int row = L[1088 + e] + L[1056 + e] + ((const int*)(sm + SM_LRANK))[a];
        ((int*)(sm + SM_AROW))[a] = row; ((float*)(sm + SM_RSCALE))[row] = ((const float*)(sm + SM_RSTD3))[tok]; ((float*)(sm + SM_RGATE))[row] = ((const float*)(sm + SM_GATE))[a]; L[1152 + tid] = row; }
    if (tb == 0 && tid >= 256 && tid < 288) { const int e = tid - 256, nb = (L[1024 + e] + 255) >> 8, b0 = L[1088 + e] >> 8; int* BLKE = (int*)(sm + SM_BLKE);
        for (int i = 0; i < nb; ++i) BLKE[b0 + i] = e; if (e == 0) BLKE[MAXBLK] = L[1120]; }
    __syncthreads();
    unsigned char* XG = F.ws + WS_XG;
    f32x4 gm[4];
#pragma unroll
    for (int k = 0; k < 4; ++k) gm[k] = *((const f32x4*)inp(F, I_GMOE) + 4 * lane + k);
#pragma unroll
    for (int j = 0; j < 8; ++j) { const u32x4 v0 = xv[j][0], v1 = xv[j][1]; u32x4 o;
        o.x = cvt4_fp8(bflo(v0.x) * gm[0][0], bfhi(v0.x) * gm[0][1], bflo(v0.y) * gm[0][2], bfhi(v0.y) * gm[0][3]); o.y = cvt4_fp8(bflo(v0.z) * gm[1][0], bfhi(v0.z) * gm[1][1], bflo(v0.w) * gm[1][2], bfhi(v0.w) * gm[1][3]);
        o.z = cvt4_fp8(bflo(v1.x) * gm[2][0], bfhi(v1.x) * gm[2][1], bflo(v1.y) * gm[2][2], bfhi(v1.y) * gm[2][3]); o.w = cvt4_fp8(bflo(v1.z) * gm[3][0], bfhi(v1.z) * gm[3][1], bflo(v1.w) * gm[3][2], bfhi(v1.w) * gm[3][3]);
#pragma unroll
        for (int k = 0; k < 4; ++k) *((u32x4*)(XG + (size_t)L[1152 + (wid * 8 + j) * 4 + k] * DM) + lane) = o; }
}

DI void combine_final(Frame& F) {
    const int gw = F.bid * NWAVES + F.wave, NGW = F.G * NWAVES, lane = F.lane;
    const bf16* x2 = (const bf16*)(F.ws + WS_XN3U); const bf16* Y = (const bf16*)(F.ws + WS_YROWS); const int* AROW = (const int*)(F.ws + WS_SMALL + SM_AROW);
    const f32x4* gf = (const f32x4*)inp(F, I_GFINAL) + lane;
    for (int tok = gw; tok < T; tok += NGW) {
        const u32x2* xr = (const u32x2*)(x2 + (size_t)tok * DM) + lane; f32x4 v[4];
#pragma unroll
        for (int j = 0; j < 4; ++j) { const u32x2 w = xr[64 * j]; v[j] = (f32x4){bflo(w.x), bfhi(w.x), bflo(w.y), bfhi(w.y)}; }
#pragma unroll
        for (int k = 0; k < 4; ++k) { const int row = AROW[tok * 4 + k]; const u32x2* yr = (const u32x2*)(Y + (size_t)row * DM) + lane;
#pragma unroll
            for (int j = 0; j < 4; ++j) { const u32x2 w = yr[64 * j]; v[j] += (f32x4){bflo(w.x), bfhi(w.x), bflo(w.y), bfhi(w.y)}; } }
        float s = 0.f;
#pragma unroll
        for (int j = 0; j < 4; ++j) s += (v[j][0] * v[j][0] + v[j][1] * v[j][1]) + (v[j][2] * v[j][2] + v[j][3] * v[j][3]);
        const float rstd = 1.0f / sqrtf(wave_sum(s) * (1.f / DM) + NORM_EPS);
        f32x4* o = (f32x4*)(F.out + (size_t)tok * DM) + lane;
#pragma unroll
        for (int j = 0; j < 4; ++j) o[64 * j] = v[j] * rstd * gf[64 * j];
    }
}

constexpr int NPHASE = 14;
__global__ void __launch_bounds__(NWAVES * 64, 2) mega_fwd(Args args) {
    extern __shared__ __attribute__((aligned(16))) unsigned char lds_raw[];
    Frame F;
    F.lds = (LAS unsigned char*)lds_raw; F.ws = args.ws; F.out = args.out;
    F.tid = threadIdx.x; F.lane = F.tid & 63; F.wave = __builtin_amdgcn_readfirstlane(F.tid >> 6); F.G = gridDim.x; F.bid = blockIdx.x;
    F.kp = (kptr_t)__builtin_amdgcn_kernarg_segment_ptr();
    if (F.tid < 64) ((LAS unsigned*)(F.lds + LDSCTL_OFF))[F.tid] = 0u;
    __syncthreads();
    const int lo = args.ph_lo, hi = args.ph_hi;
    XcdBarrier bar; bar.bar = (unsigned*)(F.ws + WS_CTL) + CW_BAR; bar.x = 0; bar.st = nullptr;
    if (hi - lo > 1) bar = xcd_barrier_post((unsigned*)(F.ws + WS_CTL) + CW_BAR, (volatile LAS unsigned*)(F.lds + LDSCTL_OFF) + 8);
#ifndef PHASE_MASK
#define PHASE_MASK 0xFFFF
#endif
#define IN(k) (((PHASE_MASK >> (k)) & 1) && lo <= (k) && (k) < hi)
#ifndef PROBE_MASK
#define PROBE_MASK 0
#endif
#define REP(k) (((PROBE_MASK >> (k)) & 1) ? 2 : 1)
#define LAUNDER() do { asm volatile("" : "+s"(F.kp), "+s"(F.ws), "+s"(F.out), "+v"(F.tid), "+s"(F.bid), "+s"(F.G)); F.lane = F.tid & 63; F.wave = __builtin_amdgcn_readfirstlane(F.tid >> 6); ws = F.ws; } while (0)
#define PHASE(k, ...) do { if (IN(k)) { __VA_ARGS__ if (REP(k) == 2) { xcd_barrier(bar); LAUNDER(); __VA_ARGS__ } } } while (0)
#ifdef DOUBLE_BAR
#define SEAM(k) do { if (IN(k) && IN((k) + 1)) { xcd_barrier(bar); xcd_barrier(bar); } LAUNDER(); } while (0)
#else
#define SEAM(k) do { if (IN(k) && IN((k) + 1)) xcd_barrier(bar); LAUNDER(); } while (0)
#endif
    unsigned char* ws = F.ws;
    LAS unsigned char* ring = F.lds + RING_OFF;

    PHASE(0, { p0_prologue(F); }); SEAM(0);

    PHASE(1, {
        const bool conv_first = ((F.bid >> 3) & 1) != 0;
        if (conv_first) { p0_experts(F, F.bid * NWAVES + F.wave, F.G * NWAVES); __syncthreads(); }
        pg8::Sched2 S{(const bf16*)(ws + WS_XN1), (const bf16*)(ws + WS_WIN), T / 256, NPROJ / 256, (const bf16*)(ws + WS_MEMN), (const bf16*)(ws + WS_WCKV), (BATCH * MEML) / 256, 2048 / 256, F.G, F.bid, 1024};
        Epi1 E{(bf16*)(ws + WS_PROJ), (bf16*)(ws + WS_KVMEM)};
        pg8::gemm_phase(ring, 1024, S, E);
        if (!conv_first) { p0_experts(F, F.bid * NWAVES + F.wave, F.G * NWAVES); }
    }); SEAM(1);

    PHASE(2, {
        for (int L = F.bid; L < 512 + 192; L += F.G) {
            if (L < 512) sb_unit(F, L >> 6, (L >> 3) & 7, L & 7);
            else { const int q = L - 512; rt_unit(F, (q / 3) >> 3, (q / 3) & 7, q % 3); }
        }
    }); SEAM(2);

    PHASE(3, { for (int L = F.bid; L < 256; L += F.G) ro_unit(F, L >> 5, (L >> 2) & 7, L & 3); }); SEAM(3);

    PHASE(4, {
        { pg8::Sched2 S{(const bf16*)(ws + WS_YSB), (const bf16*)(ws + WS_WSBO), T / 256, 4, nullptr, nullptr, 0, 1, F.G, F.bid, 512};
          Epi5a E{(const bf16*)(ws + WS_PROJ), (bf16*)(ws + WS_TMP)}; pg8::gemm_phase(ring, 512, S, E); }
        { pg8::Sched2 S{(const bf16*)(ws + WS_YRET), (const bf16*)(ws + WS_WRETO), T / 256, 4, nullptr, nullptr, 0, 1, F.G, F.bid, 1024};
          Epi5b E{(const bf16*)(ws + WS_PROJ), (const bf16*)(ws + WS_TMP), (bf16*)(ws + WS_MERGED)}; pg8::gemm_phase(ring, 1024, S, E); }
    }); SEAM(4);

    PHASE(5, {
        pg8::Sched2 S{(const bf16*)(ws + WS_MERGED), (const bf16*)(ws + WS_WMIX), T / 256, 4, nullptr, nullptr, 0, 1, F.G, F.bid, 1024};
        EpiRes<true> E{inp(F, I_X), (bf16*)(ws + WS_XN2U), (float*)(ws + WS_SLOTS)}; pg8::gemm_phase(ring, 1024, S, E);
    }); SEAM(5);

    PHASE(6, {
        pg8::Sched2 S{(const bf16*)(ws + WS_XN2U), (const bf16*)(ws + WS_WCQ), T / 256, 4, nullptr, nullptr, 0, 1, F.G, F.bid, 1024};
        Epi7 E{(const float*)(ws + WS_SLOTS), (bf16*)(ws + WS_QX)}; pg8::gemm_phase(ring, 1024, S, E);
    }); LAUNDER();

    PHASE(7, { for (int L = F.bid; L < 256; L += F.G) { int pm_, pn_; pg8::map_unit(L, 256, 64, 4, pm_, pn_); xa_unit(F, pm_ >> 3, pn_, pm_ & 7); } }); SEAM(7);

    PHASE(8, {
        pg8::Sched2 S{(const bf16*)(ws + WS_OX), (const bf16*)(ws + WS_WCO), T / 256, 4, nullptr, nullptr, 0, 1, F.G, F.bid, 1024};
        EpiRes<false> E{(const void*)(ws + WS_XN2U), (bf16*)(ws + WS_XN3U), nullptr}; pg8::gemm_phase(ring, 1024, S, E);
    }); SEAM(8);

    PHASE(9, { for (int tb = F.bid; tb < T / 64; tb += F.G) route_a(F, tb); }); SEAM(9);
    PHASE(10, { for (int tb = F.bid; tb < T / 64; tb += F.G) route_b(F, tb); }); SEAM(10);

    PHASE(11, {
        const int* BLKE = (const int*)(ws + WS_SMALL + SM_BLKE); const int nblk = __builtin_amdgcn_readfirstlane(__hip_atomic_load(BLKE + MAXBLK, RLX_AGENT));
        pg8::SchedMoE S{ws + WS_XG, ws + WS_WE1, BLKE, nblk, 8, F.G, F.bid, 1024, (size_t)2048 * 1024};
        Epi12 E{(const float*)(ws + WS_SMALL + SM_RSCALE), inp(F, I_BE1), ws + WS_ACT}; pg8::gemm_phase(ring, 1024, S, E);
    }); SEAM(11);

    PHASE(12, {
        const int* BLKE = (const int*)(ws + WS_SMALL + SM_BLKE); const int nblk = __builtin_amdgcn_readfirstlane(__hip_atomic_load(BLKE + MAXBLK, RLX_AGENT));
        pg8::SchedMoE S{ws + WS_ACT, ws + WS_WE2, BLKE, nblk, 4, F.G, F.bid, 1024, (size_t)1024 * 1024};
        Epi13 E{(const float*)(ws + WS_SMALL + SM_RGATE), inp(F, I_BE2), (bf16*)(ws + WS_YROWS)}; pg8::gemm_phase(ring, 1024, S, E);
    }); SEAM(12);

    PHASE(13, { combine_final(F); });
#undef IN
#undef SEAM
}

#if MK_DEBUG
DI unsigned hsh(unsigned x) { x ^= x >> 16; x *= 0x7feb352du; x ^= x >> 15; x *= 0x846ca68bu; x ^= x >> 16; return x; }
DI void chk_report(unsigned char* ws, int phase, float got, float ref, float atol) {
    float e = fabsf(got - ref) / (fabsf(ref) + atol); if (!(e == e)) e = 1.0e9f; if (e > 1.0e9f) e = 1.0e9f;
    atomicMax((unsigned*)(ws + WS_CTL) + CW_CHK + phase, __float_as_uint(e));
}
DI float dbg_bf(const bf16* p, size_t i) { return bf2f(p[i]); }
DI float dbg_f8(const unsigned char* p, size_t i) { const unsigned b = p[i]; const int e = (b >> 3) & 15, m = b & 7; const float v = e ? (1.0f + m * 0.125f) * exp2f((float)(e - 7)) : m * 0.125f * 0.015625f; return (b & 128) ? -v : v; }
DI float dbg_sigm(float x) { return 1.0f / (1.0f + expf(-x)); }
DI float dbg_rope(const float* rope, int pos, int i, bool sn) { return rope[(sn ? SEQ * 32 : 0) + pos * 32 + i]; }
DI float dbg_rot(const bf16* row, const float* rope, int pos, int d) {
    const int i = d & 31; const float x1 = bf2f(row[i]), x2 = bf2f(row[32 + i]); const float c = dbg_rope(rope, pos, i, false), s = dbg_rope(rope, pos, i, true);
    return d < 32 ? x1 * c - x2 * s : x1 * s + x2 * c;
}
__global__ void __launch_bounds__(64) dbg_kernel(Args a, int phase) {
    const unsigned sid = blockIdx.x * 64 + threadIdx.x; unsigned char* ws = a.ws;
    const unsigned r0 = hsh(sid * 4 + 1 + phase * 7919), r1 = hsh(sid * 4 + 2 + phase * 104729), r2 = hsh(sid * 4 + 3 + phase * 31), r3 = hsh(sid * 4 + 4 + phase * 17);
    const float* rope = (const float*)(ws + WS_ROPE);
    const bf16* PROJ = (const bf16*)(ws + WS_PROJ);
    if (phase == 0) {
        const int which = sid % 12;
        if (which == 7 || which == 8) {   } else if (which < 9) {
            const float* W; const bf16* WT; int K, N; int e = 0;
            switch (which) { case 0: W = a.in[I_WIN]; WT = (const bf16*)(ws + WS_WIN); K = 1024; N = NPROJ; break; case 1: W = a.in[I_WSBO]; WT = (const bf16*)(ws + WS_WSBO); K = 512; N = 1024; break;
                case 2: W = a.in[I_WRETO]; WT = (const bf16*)(ws + WS_WRETO); K = 1024; N = 1024; break; case 3: W = a.in[I_WMIX]; WT = (const bf16*)(ws + WS_WMIX); K = 1024; N = 1024; break;
                case 4: W = a.in[I_WCQ]; WT = (const bf16*)(ws + WS_WCQ); K = 1024; N = 1024; break; case 5: W = a.in[I_WCKV]; WT = (const bf16*)(ws + WS_WCKV); K = 1024; N = 2048; break;
                case 6: W = a.in[I_WCO]; WT = (const bf16*)(ws + WS_WCO); K = 1024; N = 1024; break;
                case 7: e = r2 % 32; W = a.in[I_WE1] + (size_t)e * 1024 * 2048; WT = (const bf16*)(ws + WS_WE1 + (size_t)e * 2048 * 1024); K = 1024; N = 2048; break;
                default: e = r2 % 32; W = a.in[I_WE2] + (size_t)e * 1024 * 1024; WT = (const bf16*)(ws + WS_WE2 + (size_t)e * 1024 * 1024); K = 1024; N = 1024; break; }
            const int k = r0 % K, n = r1 % N; int nr = n; if (which == 7) nr = n < 1024 ? 256 * (n >> 7) + (n & 127) : 256 * ((n - 1024) >> 7) + 128 + ((n - 1024) & 127);
            if (which >= 7) chk_report(ws, 0, dbg_f8((const unsigned char*)WT, (size_t)nr * K + k), W[(size_t)k * N + n] * 64.0f, 0.5f);
            else { const float ref = bf2f((bf16)(cvtpk(W[(size_t)k * N + n], 0.f) & 0xffffu)); chk_report(ws, 0, dbg_bf(WT, (size_t)nr * K + k), ref, 1e-6f); }
        } else if (which < 11) {
            const bool isx = which == 9; const int row = isx ? r0 % T : r0 % (BATCH * MEML), col = r1 % DM;
            const float* xr = (isx ? a.in[I_X] : a.in[I_MEM]) + (size_t)row * DM; double ss = 0; for (int k = 0; k < DM; ++k) ss += (double)xr[k] * xr[k];
            const float ref = xr[col] * (float)(1.0 / sqrt(ss / DM + 1e-5)) * (isx ? a.in[I_GMIX] : a.in[I_GMEM])[col];
            chk_report(ws, 0, dbg_bf((const bf16*)(ws + (isx ? WS_XN1 : WS_MEMN)), (size_t)row * DM + col), ref, 0.5f);
        } else { const int pos = r0 % SEQ, i = r1 % 32; const double inv = exp2(-(double)i * 13.287712379549449 / 32.0); const float angf = (float)pos * (float)inv; double an = (double)angf; an -= 6.283185307179586 * rint(an / 6.283185307179586);
            const float rev = (float)(an / 6.283185307179586); chk_report(ws, 0, dbg_rope(rope, pos, i, false), __builtin_amdgcn_cosf(rev), 0.5f); chk_report(ws, 0, dbg_rope(rope, pos, i, true), __builtin_amdgcn_sinf(rev), 0.5f); }
    } else if (phase == 1) {
        if (sid % 3 == 2) {
            const int e = r2 % 32; const bool w1 = (sid & 4) != 0; const int K = 1024, N = w1 ? 2048 : 1024; const float* W = (w1 ? a.in[I_WE1] : a.in[I_WE2]) + (size_t)e * K * N; const unsigned char* WT = ws + (w1 ? WS_WE1 : WS_WE2) + (size_t)e * N * K;
            const int k = r0 % K, n = r1 % N; int nr = n; if (w1) nr = n < 1024 ? 256 * (n >> 7) + (n & 127) : 256 * ((n - 1024) >> 7) + 128 + ((n - 1024) & 127);
            chk_report(ws, 1, dbg_f8(WT, (size_t)nr * K + k), W[(size_t)k * N + n] * 64.0f, 0.5f);
        } else if (sid & 1) { const int row = r0 % T, col = r1 % NPROJ; const bf16* xr = (const bf16*)(ws + WS_XN1) + (size_t)row * DM; const float* W = a.in[I_WIN]; double s = 0; for (int k = 0; k < DM; ++k) s += (double)bf2f(xr[k]) * W[(size_t)k * NPROJ + col];
            const float sc = col < 512 ? SBQ_SCALE : ((col >= C_RK && col < C_RV) ? 0.125f : 1.0f); chk_report(ws, 1, dbg_bf(PROJ, (size_t)row * NPROJ + col), (float)s * sc, sc); }
        else { const int row = r0 % (BATCH * MEML), col = r1 % 2048; const bf16* xr = (const bf16*)(ws + WS_MEMN) + (size_t)row * DM; const float* W = a.in[I_WCKV]; double s = 0; for (int k = 0; k < DM; ++k) s += (double)bf2f(xr[k]) * W[(size_t)k * 2048 + col];
            chk_report(ws, 1, dbg_bf((const bf16*)(ws + WS_KVMEM), (size_t)row * 2048 + col), (float)s, 1.0f); }
    } else if (phase == 2) {
        if (sid & 1) {
            const int b = r0 % BATCH, h = r1 % 8, t = (sid & 2) ? r2 % SEQ : r2 % 300, d = r3 % 64; const bf16* Pb = PROJ + (size_t)b * SEQ * NPROJ; const bf16* qrow = Pb + (size_t)t * NPROJ + C_SBQ + h * 64;
            double o = 0, between = 0;
            for (int s = t - 1; s >= 0; --s) { const bf16* krow = Pb + (size_t)s * NPROJ + C_SBK + h * 64; double zl = 0; for (int k = 0; k < 64; ++k) zl += (double)bf2f(qrow[k]) * bf2f(krow[k]);
                const double z = zl / 1.4426950408889634; const double lsp = z > 0 ? z + log1p(exp(-z)) : log1p(exp(z));
                const double w = exp(z - lsp + between); between -= lsp; o += w * bf2f(Pb[(size_t)s * NPROJ + C_SBV + h * 64 + d]); if (between < -200.0) break; }
            chk_report(ws, 2, dbg_bf((const bf16*)(ws + WS_YSB), (size_t)(b * SEQ + t) * 512 + h * 64 + d), (float)o, 0.5f);
        } else {
            const int b = r0 % BATCH, h = r1 % 8, g = r2 % 3, dk = r3 % 64, dv = (r3 >> 8) % 128; const double gam = 1.0 - exp2(-5.0 - h); double s = 0;
            for (int p = 0; p < 512; ++p) { const int pos = g * 512 + p; const bf16* row = PROJ + (size_t)(b * SEQ + pos) * NPROJ; s += pow(gam, 511 - p) * dbg_rot(row + C_RK + h * 64, rope, pos, dk) * bf2f(row[C_RV + h * 128 + dv]); }
            chk_report(ws, 2, ((const float*)(ws + WS_GTOT))[(size_t)((b * 8 + h) * 4 + g) * 8192 + dk * 128 + dv], (float)s, 0.5f);
        }
    } else if (phase == 3) {
        const int b = r0 % BATCH, h = r1 % 8, t = (sid & 1) ? r2 % SEQ : r2 % 200; const double gam = 1.0 - exp2(-5.0 - h); const bf16* Pb = PROJ + (size_t)b * SEQ * NPROJ;
        float q[64];
#pragma unroll
        for (int d = 0; d < 64; ++d) q[d] = dbg_rot(Pb + (size_t)t * NPROJ + C_RQ + h * 64, rope, t, d);
        float o[128];
#pragma unroll
        for (int e = 0; e < 128; ++e) o[e] = 0.f;
        for (int s = 0; s <= t; ++s) { const bf16* row = Pb + (size_t)s * NPROJ; float dot = 0.f;
#pragma unroll
            for (int d = 0; d < 64; ++d) dot += q[d] * dbg_rot(row + C_RK + h * 64, rope, s, d);
            const float w = dot * (float)pow(gam, t - s);
#pragma unroll
            for (int e = 0; e < 128; ++e) o[e] += w * bf2f(row[C_RV + h * 128 + e]); }
        float mu = 0.f;
#pragma unroll
        for (int e = 0; e < 128; ++e) mu += o[e];
        mu *= (1.f / 128.f); float var = 0.f;
#pragma unroll
        for (int e = 0; e < 128; ++e) var += (o[e] - mu) * (o[e] - mu);
        const float rstd = 1.0f / sqrtf(var * (1.f / 128.f) + 1e-5f);
#pragma unroll
        for (int e = 0; e < 128; ++e) { const float gv = bf2f(Pb[(size_t)t * NPROJ + C_RG + h * 128 + e]); chk_report(ws, 3, dbg_bf((const bf16*)(ws + WS_YRET), (size_t)(b * SEQ + t) * DM + h * 128 + e), gv * dbg_sigm(gv) * (o[e] - mu) * rstd, 1.0f); }
    } else if (phase == 4) {
        const int row = r0 % T, col = r1 % DM; const bf16* ys = (const bf16*)(ws + WS_YSB) + (size_t)row * 512; const bf16* yr = (const bf16*)(ws + WS_YRET) + (size_t)row * DM; double s1 = 0, s2 = 0;
        for (int k = 0; k < 512; ++k) s1 += (double)bf2f(ys[k]) * a.in[I_WSBO][(size_t)k * DM + col]; for (int k = 0; k < DM; ++k) s2 += (double)bf2f(yr[k]) * a.in[I_WRETO][(size_t)k * DM + col];
        const float ref = dbg_sigm(bf2f(PROJ[(size_t)row * NPROJ + C_GSB + col])) * (float)s1 + dbg_sigm(bf2f(PROJ[(size_t)row * NPROJ + C_GRET + col])) * (float)s2;
        chk_report(ws, 4, dbg_bf((const bf16*)(ws + WS_MERGED), (size_t)row * DM + col), ref, 0.5f);
    } else if (phase == 5 || phase == 8) {
        const bool p5 = phase == 5; const int row = r0 % T, col = r1 % DM; const bf16* ar = (const bf16*)(ws + (p5 ? WS_MERGED : WS_OX)) + (size_t)row * DM; const float* W = p5 ? a.in[I_WMIX] : a.in[I_WCO];
        double s = 0; for (int k = 0; k < DM; ++k) s += (double)bf2f(ar[k]) * W[(size_t)k * DM + col];
        const float xi = p5 ? a.in[I_X][(size_t)row * DM + col] : dbg_bf((const bf16*)(ws + WS_XN2U), (size_t)row * DM + col); const float ref = xi + (float)s; const float got = dbg_bf((const bf16*)(ws + (p5 ? WS_XN2U : WS_XN3U)), (size_t)row * DM + col);
        chk_report(ws, phase, got, ref, 1.0f);
        if (p5) { const bf16* xr = (const bf16*)(ws + WS_XN2U) + (size_t)row * DM; double ss = 0; for (int k = 0; k < DM; ++k) ss += (double)bf2f(xr[k]) * bf2f(xr[k]); float sl = 0; for (int k = 0; k < 16; ++k) sl += ((const float*)(ws + WS_SLOTS))[(size_t)row * 16 + k]; chk_report(ws, 5, sl, (float)ss, 100.0f); }
    } else if (phase == 6) {
        const int row = r0 % T, col = r1 % DM; const bf16* ar = (const bf16*)(ws + WS_XN2U) + (size_t)row * DM; double s = 0, ss = 0; for (int k = 0; k < DM; ++k) { const double x = bf2f(ar[k]); s += x * a.in[I_GXATTN][k] * a.in[I_WCQ][(size_t)k * DM + col]; ss += x * x; }
        chk_report(ws, 6, dbg_bf((const bf16*)(ws + WS_QX), (size_t)row * DM + col), (float)(s / sqrt(ss / DM + 1e-5)) * XQ_SCALE, XQ_SCALE);
    } else if (phase == 7) {
        const int b = r0 % BATCH, t = r1 % SEQ, hx = r2 % 4, d = r3 % 256; const bf16* qrow = (const bf16*)(ws + WS_QX) + (size_t)(b * SEQ + t) * DM + hx * 256; const bf16* KV = (const bf16*)(ws + WS_KVMEM) + (size_t)(b * MEML) * 2048;
        double mx = -1e30; for (int m = 0; m < MEML; ++m) { double z = 0; for (int k = 0; k < 256; ++k) z += (double)bf2f(qrow[k]) * bf2f(KV[(size_t)m * 2048 + hx * 256 + k]); if (z > mx) mx = z; }
        double l = 0, o = 0; for (int m = 0; m < MEML; ++m) { double z = 0; for (int k = 0; k < 256; ++k) z += (double)bf2f(qrow[k]) * bf2f(KV[(size_t)m * 2048 + hx * 256 + k]); const double p = exp2(z - mx); l += p; o += p * bf2f(KV[(size_t)m * 2048 + 1024 + hx * 256 + d]); }
        chk_report(ws, 7, dbg_bf((const bf16*)(ws + WS_OX), (size_t)(b * SEQ + t) * DM + hx * 256 + d), (float)(o / l), 0.1f);
    } else if (phase == 9) {
        const int tok = r0 % T; const bf16* xr = (const bf16*)(ws + WS_XN3U) + (size_t)tok * DM; double ss = 0; for (int k = 0; k < DM; ++k) ss += (double)bf2f(xr[k]) * bf2f(xr[k]); const double rstd = 1.0 / sqrt(ss / DM + 1e-5);
        chk_report(ws, 9, ((const float*)(ws + WS_SMALL + SM_RSTD3))[tok], (float)rstd, 1e-3f);
        double v0 = -1e30, v1 = -1e30, v2 = -1e30, v3 = -1e30, v4 = -1e30; int i0 = -1, i1 = -1, i2 = -1, i3 = -1;
        for (int e = 0; e < 32; ++e) { double s = 0; for (int k = 0; k < DM; ++k) s += (double)bf2f(xr[k]) * a.in[I_GMOE][k] * a.in[I_WROUTER][k * 32 + e]; s = s * rstd + a.in[I_BROUTER][e];
            if (s > v0) { v4 = v3; v3 = v2; i3 = i2; v2 = v1; i2 = i1; v1 = v0; i1 = i0; v0 = s; i0 = e; } else if (s > v1) { v4 = v3; v3 = v2; i3 = i2; v2 = v1; i2 = i1; v1 = s; i1 = e; }
            else if (s > v2) { v4 = v3; v3 = v2; i3 = i2; v2 = s; i2 = e; } else if (s > v3) { v4 = v3; v3 = s; i3 = e; } else if (s > v4) v4 = s; }
        const int* te = (const int*)(ws + WS_SMALL + SM_TOPE) + tok * 4; const float* tg = (const float*)(ws + WS_SMALL + SM_GATE) + tok * 4;
        const bool close = (v0 - v1 < 1e-4) || (v1 - v2 < 1e-4) || (v2 - v3 < 1e-4) || (v3 - v4 < 1e-4);
        if (!close) { chk_report(ws, 9, (te[0] == i0 && te[1] == i1 && te[2] == i2 && te[3] == i3) ? 0.f : 1.f, 0.f, 1.0f);
            const double e1 = exp(v1 - v0), e2 = exp(v2 - v0), e3 = exp(v3 - v0), sm = 1.0 + e1 + e2 + e3; chk_report(ws, 9, tg[0], (float)(1.0 / sm), 0.01f); chk_report(ws, 9, tg[3], (float)(e3 / sm), 0.01f); }
    } else if (phase == 10) {
        const int tok = r0 % T, k = r1 % 4, col = r2 % DM; const int row = ((const int*)(ws + WS_SMALL + SM_AROW))[tok * 4 + k], e = ((const int*)(ws + WS_SMALL + SM_TOPE))[tok * 4 + k]; const int* BLKE = (const int*)(ws + WS_SMALL + SM_BLKE);
        const bool okr = row >= 0 && row < BLKE[MAXBLK] * 256; chk_report(ws, 10, okr ? 0.f : 1.f, 0.f, 1.0f);
        if (okr) { chk_report(ws, 10, BLKE[row >> 8] == e ? 0.f : 1.f, 0.f, 1.0f); chk_report(ws, 10, dbg_f8(ws + WS_XG, (size_t)row * DM + col), dbg_bf((const bf16*)(ws + WS_XN3U), (size_t)tok * DM + col) * a.in[I_GMOE][col], 0.5f);
            chk_report(ws, 10, ((const float*)(ws + WS_SMALL + SM_RSCALE))[row], ((const float*)(ws + WS_SMALL + SM_RSTD3))[tok], 1e-6f); chk_report(ws, 10, ((const float*)(ws + WS_SMALL + SM_RGATE))[row], ((const float*)(ws + WS_SMALL + SM_GATE))[tok * 4 + k], 1e-6f);
 }
    } else if (phase == 11) {
        const int tok = r0 % T, k = r1 % 4, col = r2 % DFF; const int row = ((const int*)(ws + WS_SMALL + SM_AROW))[tok * 4 + k], e = ((const int*)(ws + WS_SMALL + SM_TOPE))[tok * 4 + k];
        const unsigned char* xr = ws + WS_XG + (size_t)row * DM; const unsigned char* W = ws + WS_WE1 + (size_t)e * 2048 * 1024; const int rg = 256 * (col >> 7) + (col & 127), rl = rg + 128; double sg = 0, sl = 0;
        for (int kk = 0; kk < DM; ++kk) { const double x = dbg_f8(xr, kk); sg += x * dbg_f8(W, (size_t)rg * 1024 + kk); sl += x * dbg_f8(W, (size_t)rl * 1024 + kk); }
        sg *= (1.0 / 64.0); sl *= (1.0 / 64.0);
        const float rs = ((const float*)(ws + WS_SMALL + SM_RSTD3))[tok]; float gl = (float)sg * rs + a.in[I_BE1][e * 2048 + col], li = (float)sl * rs + a.in[I_BE1][e * 2048 + 1024 + col]; gl = fminf(gl, 7.f); li = fminf(fmaxf(li, -7.f), 7.f);
        chk_report(ws, 11, dbg_f8(ws + WS_ACT, (size_t)row * DFF + col), gl * dbg_sigm(1.702f * gl) * (li + 1.0f), 0.5f);
    } else if (phase == 12) {
        const int tok = r0 % T, k = r1 % 4, col = r2 % DM; const int row = ((const int*)(ws + WS_SMALL + SM_AROW))[tok * 4 + k], e = ((const int*)(ws + WS_SMALL + SM_TOPE))[tok * 4 + k];
        const unsigned char* ar = ws + WS_ACT + (size_t)row * DFF; const unsigned char* W = ws + WS_WE2 + (size_t)e * 1024 * 1024; double s = 0; for (int kk = 0; kk < DFF; ++kk) s += (double)dbg_f8(ar, kk) * dbg_f8(W, (size_t)col * 1024 + kk);
        s *= (1.0 / 64.0);
        chk_report(ws, 12, dbg_bf((const bf16*)(ws + WS_YROWS), (size_t)row * DM + col), ((float)s + a.in[I_BE2][e * 1024 + col]) * ((const float*)(ws + WS_SMALL + SM_GATE))[tok * 4 + k], 0.1f);
    }
}
__global__ void dbg_rows_a(Args a) { const int i = blockIdx.x * 256 + threadIdx.x; if (i < T * 4) atomicAdd((int*)(a.ws + WS_E + 64 * MB) + ((const int*)(a.ws + WS_SMALL + SM_AROW))[i], 1); }
__global__ void dbg_rows_b(Args a) { const int i = blockIdx.x * 256 + threadIdx.x; if (i < PROWS) { const int c = ((const int*)(a.ws + WS_E + 64 * MB))[i]; if (c > 1) atomicMax((unsigned*)(a.ws + WS_CTL) + CW_CHK + 10, __float_as_uint(100.0f + c)); } }
__global__ void dbg_verdict(Args a) {
    const unsigned* chk = (const unsigned*)(a.ws + WS_CTL) + CW_CHK; int code = 0;
    for (int p = 0; p < NPHASE; ++p) if (code == 0 && __uint_as_float(chk[p]) > 0.08f) code = p + 1;
    if (code) { const float sc = 1.0f + (float)code; for (size_t i = (size_t)blockIdx.x * 256 + threadIdx.x; i < (size_t)T * DM; i += (size_t)gridDim.x * 256) a.out[i] *= sc; }
}
static void dbg_check(int p, const Args& a, hipStream_t stream) {
    if (p == 13) { hipLaunchKernelGGL(dbg_verdict, dim3(1024), dim3(256), 0, stream, a); return; }
    if (p == 10) { (void)hipMemsetAsync(a.ws + WS_E + 64 * MB, 0, (size_t)PROWS * 4, stream); hipLaunchKernelGGL(dbg_rows_a, dim3(T * 4 / 256), dim3(256), 0, stream, a); hipLaunchKernelGGL(dbg_rows_b, dim3(PROWS / 256), dim3(256), 0, stream, a); }
    hipLaunchKernelGGL(dbg_kernel, dim3(p == 3 ? 2 : 16), dim3(64), 0, stream, a, p);
}
#endif

extern "C" void kernel_launch(void* const* d_in, const int* in_sizes, int n_in, void* d_out, int out_size, void* d_ws, size_t ws_size, hipStream_t stream) {
    static int grid = 0;
    if (grid == 0) {
        if (n_in != 20 || in_sizes[0] != T * DM || out_size != T * DM || ws_size < WS_END) { fprintf(stderr, "kernel_launch: unexpected problem shape (n_in %d, in0 %d, out %d, ws %zu < %zu)\n", n_in, n_in > 0 ? in_sizes[0] : -1, out_size, ws_size, (size_t)WS_END); grid = -1; return; }
        int dev = 0, cus = 0;
        if (hipGetDevice(&dev) != hipSuccess || hipDeviceGetAttribute(&cus, hipDeviceAttributeMultiprocessorCount, dev) != hipSuccess) { grid = -1; return; }
        if (hipFuncSetAttribute((const void*)mega_fwd, hipFuncAttributeMaxDynamicSharedMemorySize, LDS_BYTES) != hipSuccess) { fprintf(stderr, "kernel_launch: hipFuncSetAttribute failed\n"); grid = -1; return; }
        grid = cus;
    }
    if (grid < 0) return;
    (void)hipMemsetAsync((char*)d_ws + WS_CTL, 0, CTL_BYTES, stream);
    Args a{};
    for (int i = 0; i < 20; ++i) a.in[i] = (const float*)d_in[i];
    a.out = (float*)d_out; a.ws = (unsigned char*)d_ws;
#if MK_DEBUG
    for (int p = 0; p < NPHASE; ++p) { a.ph_lo = p; a.ph_hi = p + 1; hipLaunchKernelGGL(mega_fwd, dim3(grid), dim3(NWAVES * 64), LDS_BYTES, stream, a); dbg_check(p, a, stream); }
#else
    a.ph_lo = 0; a.ph_hi = NPHASE;
    hipLaunchKernelGGL(mega_fwd, dim3(grid), dim3(NWAVES * 64), LDS_BYTES, stream, a);
#endif
}
```

```cpp
#include <hip/hip_runtime.h>
#include <cstdio>
#include <cstdint>

#ifndef MK_DEBUG
#define MK_DEBUG 0
#endif

#define LAS __attribute__((address_space(3)))
#define GAS __attribute__((address_space(1)))
typedef unsigned short bf16;
typedef short bf16x8 __attribute__((ext_vector_type(8)));
typedef short s16x4 __attribute__((ext_vector_type(4)));
typedef short v4i16_t __attribute__((ext_vector_type(4)));
typedef float f32x2 __attribute__((ext_vector_type(2)));
typedef float f32x4 __attribute__((ext_vector_type(4)));
typedef float f32x16 __attribute__((ext_vector_type(16)));
typedef unsigned u32x2 __attribute__((ext_vector_type(2)));
typedef unsigned u32x4 __attribute__((ext_vector_type(4)));
typedef __bf16 bf16x2_t __attribute__((ext_vector_type(2)));
typedef GAS unsigned gu32;
#define RLX_AGENT __ATOMIC_RELAXED, __HIP_MEMORY_SCOPE_AGENT
#define LDS_WAIT() asm volatile("s_waitcnt lgkmcnt(0)" ::: "memory")
#define VM_WAIT() asm volatile("s_waitcnt vmcnt(0)" ::: "memory")
#define DI __device__ __forceinline__

DI unsigned cvtpk(float lo, float hi) { f32x2 v = {lo, hi}; bf16x2_t b = __builtin_convertvector(v, bf16x2_t); return __builtin_bit_cast(unsigned, b); }
DI float bflo(unsigned w) { return __uint_as_float(w << 16); }
DI float bfhi(unsigned w) { return __uint_as_float(w & 0xffff0000u); }
DI float bf2f(bf16 u) { return __uint_as_float((unsigned)u << 16); }
DI float fexp2(float x) { return __builtin_amdgcn_exp2f(x); }
DI float flog2(float x) { return __builtin_amdgcn_logf(x); }
DI float frcp(float x) { return __builtin_amdgcn_rcpf(x); }
DI float sigmoidf_(float x) { return frcp(1.0f + fexp2(-1.4426950408889634f * x)); }
DI int crow(int r, int hi) { return (r & 3) + 8 * (r >> 2) + 4 * hi; }
DI s16x4 vtr(const LAS char* p) { return __builtin_bit_cast(s16x4, __builtin_amdgcn_ds_read_tr16_b64_v4i16((LAS v4i16_t*)p)); }
#define MFMA32(a, b, c) __builtin_amdgcn_mfma_f32_32x32x16_bf16((a), (b), (c), 0, 0, 0)

constexpr int BATCH = 8, SEQ = 2048, DM = 1024, T = BATCH * SEQ, NPROJ = 6656, MEML = 256;
constexpr int C_SBQ = 0, C_SBK = 512, C_SBV = 1024, C_RQ = 1536, C_RK = 2048, C_RV = 2560, C_RG = 3584, C_GSB = 4608, C_GRET = 5632;
constexpr int NEXP = 32, TOPK = 4, DFF = 1024;
constexpr int MAXBLK = 288, PROWS = MAXBLK * 256;
constexpr float NORM_EPS = 1e-5f;
constexpr float LOG2E = 1.4426950408889634f;
constexpr float SBQ_SCALE = 0.125f * LOG2E;
constexpr float XQ_SCALE = 0.0625f * LOG2E;
constexpr float SB_THR = 150.0f;

namespace pg8 {
constexpr int BM = 256, BK = 64, HALF = 128, HTB = HALF * BK * 2, STAGE_BYTES = 8 * HTB, NXCD = 8;
__host__ __device__ __forceinline__ int lds_byte(int r, int c) { const int st = (r >> 4) * 2 + (c >> 5), rr = r & 15, cc = c & 31, ob = rr * 64 + cc * 2; return st * 1024 + (ob ^ (((ob >> 9) & 1) << 5)); }
__host__ __device__ __forceinline__ void stage_rc(int b, int& R, int& C) { const int st = b / 1024, sb = b % 1024, swz = sb ^ (((sb >> 9) & 1) << 5); R = (st >> 1) * 16 + swz / 64; C = (st & 1) * 32 + (swz % 64) / 2; }
__host__ __device__ __forceinline__ int perm32(int rho) { const int n = rho >> 4, i = rho & 15; return 8 * (i >> 2) + 4 * n + (i & 3); }

typedef int v8i_t __attribute__((ext_vector_type(8)));
typedef int v4i_t __attribute__((ext_vector_type(4)));
DI v8i_t cat8(bf16x8 a, bf16x8 b) { const v4i_t x = __builtin_bit_cast(v4i_t, a), y = __builtin_bit_cast(v4i_t, b); return __builtin_shufflevector(x, y, 0, 1, 2, 3, 4, 5, 6, 7); }
DI bf16x8 lo8(v8i_t v) { return __builtin_bit_cast(bf16x8, (v4i_t)__builtin_shufflevector(v, v, 0, 1, 2, 3)); }
DI bf16x8 hi8(v8i_t v) { return __builtin_bit_cast(bf16x8, (v4i_t)__builtin_shufflevector(v, v, 4, 5, 6, 7)); }
struct Unit { int pm, pn; const char* A; const char* B; int tag, e; };

DI void map_unit(int L, int nwg, int nM, int nN, int& pm, int& pn, const int WGM = 4) {
    int wgid = L; { const int q = nwg / NXCD, r = nwg % NXCD, xcd = wgid % NXCD, off = wgid / NXCD; wgid = (xcd < r ? xcd * (q + 1) : r * (q + 1) + (xcd - r) * q) + off; }
    const int nig = WGM * nN, gid = wgid / nig, fm = gid * WGM, gsz = (nM - fm) < WGM ? (nM - fm) : WGM;
    pm = fm + ((wgid % nig) % gsz); pn = (wgid % nig) / gsz;
}
struct Sched2 {
    const bf16* A0; const bf16* B0; int nM0, nN0; const bf16* A1; const bf16* B1; int nM1, nN1; int G, c, K; int wgm = 4;
    DI bool next(int i, Unit& u) const {
        const int n0 = nM0 * nN0, n1 = nM1 * nN1; const long L = (long)i * G + c; if (L >= n0 + n1) return false;
        const bool first = L < n0; int pm, pn; map_unit(first ? (int)L : (int)L - n0, first ? n0 : n1, first ? nM0 : nM1, first ? nN0 : nN1, pm, pn, wgm);
        u.pm = pm; u.pn = pn; u.tag = first ? 0 : 1; u.e = 0;
        u.A = (const char*)(first ? A0 : A1) + (size_t)pm * BM * K * 2; u.B = (const char*)(first ? B0 : B1) + (size_t)pn * BM * K * 2; return true;
    }
};
struct SchedMoE {
    const unsigned char* A; const unsigned char* Wt; const int* blk_e; int nblk, nN, G, c, K; size_t estride; int wgm = 4;
    DI bool next(int i, Unit& u) const {
        const int nwg = nblk * nN; const long L = (long)i * G + c; if (L >= nwg) return false;
        int pm, pn; map_unit((int)L, nwg, nblk, nN, pm, pn, wgm);
        const int e = __builtin_amdgcn_readfirstlane(__hip_atomic_load(blk_e + pm, RLX_AGENT));
        u.pm = pm; u.pn = pn; u.tag = 0; u.e = e;
        u.A = (const char*)A + (size_t)pm * BM * K; u.B = (const char*)Wt + ((size_t)e * estride + (size_t)pn * BM * K); return true;
    }
};

template <class Epi, class Sched>
DI void gemm_phase(LAS unsigned char* lds, const int K, const Sched& S, const Epi& E) {
    const int tid = threadIdx.x, wid = __builtin_amdgcn_readfirstlane(tid >> 6), lane = tid & 63, wr = wid >> 2, wc = wid & 3, fr = lane & 15, fq = lane >> 4;
    constexpr int ESZ = Epi::FP8 ? 1 : 2;
    int nt = K * ESZ / 128; asm volatile("" : "+s"(nt));
    unsigned voffA[2], voffB[2];
#pragma unroll
    for (int i = 0; i < 2; ++i) { int R, C; stage_rc(tid * 16 + i * 8192, R, C); const int Rb = Epi::PERM ? ((R & ~31) + perm32(R & 31)) : R;
        voffA[i] = (unsigned)(R * K * ESZ + 2 * C); voffB[i] = (unsigned)(Rb * K * ESZ + 2 * C); }
    const size_t kstep = (size_t)(BK * 2);
    const size_t hstep = (size_t)HALF * K * ESZ;
    const unsigned ldsw = (unsigned)wid * 1024u;
    const int aoff = lds_byte(wr * 64 + fr, fq * 8), boff = lds_byte(wc * 32 + fr, fq * 8);
#define PG8_SA(b, h) (((b) * 2 + (h)) * HTB)
#define PG8_SB(b, h) ((4 + (b) * 2 + (h)) * HTB)
#define PG8_STAGE(bufoff, gbase, voff) do { _Pragma("unroll") for (int _i = 0; _i < 2; ++_i) \
        __builtin_amdgcn_global_load_lds((const unsigned*)((const char*)(gbase) + (voff)[_i]), (LAS unsigned*)(lds + (bufoff) + ldsw + _i * 8192), 16, 0, 0); } while (0)
#define PG8_LDA(dst, b, h) do { _Pragma("unroll") for (int m = 0; m < 4; ++m) dst[m] = cat8(*(const LAS bf16x8*)(lds + PG8_SA(b, h) + aoff + m * 2048), *(const LAS bf16x8*)(lds + PG8_SA(b, h) + aoff + m * 2048 + 1024)); } while (0)
#define PG8_LDB(dst, b, h) do { _Pragma("unroll") for (int n = 0; n < 2; ++n) dst[n] = cat8(*(const LAS bf16x8*)(lds + PG8_SB(b, h) + boff + n * 2048), *(const LAS bf16x8*)(lds + PG8_SB(b, h) + boff + n * 2048 + 1024)); } while (0)
#define PG8_MMA(ai, bj, At, Bt) do { __builtin_amdgcn_s_setprio(1); _Pragma("unroll") for (int m = 0; m < 4; ++m) _Pragma("unroll") for (int n = 0; n < 2; ++n) { \
        if constexpr (Epi::FP8) { asm volatile("v_mfma_scale_f32_16x16x128_f8f6f4 %0, %1, %2, %0, %3, %4 op_sel_hi:[0,0,0]" : "+v"(acc[ai][bj][m][n]) : "v"(Bt[n]), "v"(At[m]), "v"(sc_w), "v"(sc_a)); } \
        else { acc[ai][bj][m][n] = __builtin_amdgcn_mfma_f32_16x16x32_bf16(lo8(Bt[n]), lo8(At[m]), acc[ai][bj][m][n], 0, 0, 0); acc[ai][bj][m][n] = __builtin_amdgcn_mfma_f32_16x16x32_bf16(hi8(Bt[n]), hi8(At[m]), acc[ai][bj][m][n], 0, 0, 0); } } \
        __builtin_amdgcn_s_setprio(0); } while (0)
#define PG8_WAIT_V(n) asm volatile("s_waitcnt vmcnt(" #n ")" ::: "memory")
#define PG8_WAIT_L(n) asm volatile("s_waitcnt lgkmcnt(" #n ")" ::: "memory")
#define PG8_BAR __builtin_amdgcn_s_barrier()
#define PG8_SCHED __builtin_amdgcn_sched_barrier(0)
    Unit cur, nxt; int ui = 0;
    if (S.next(0, cur)) {
    f32x4 acc[2][2][4][2];
#pragma unroll
    for (int a = 0; a < 2; ++a)
#pragma unroll
        for (int b = 0; b < 2; ++b)
#pragma unroll
            for (int m = 0; m < 4; ++m)
#pragma unroll
                for (int n = 0; n < 2; ++n) acc[a][b][m][n] = (f32x4){0.f, 0.f, 0.f, 0.f};
    v8i_t At[4], B0[2], B1[2];
    int sc_w = 0, sc_a = 0; if constexpr (Epi::FP8) { sc_w = Epi::SCALE_W; sc_a = Epi::SCALE_A; asm volatile("" : "+v"(sc_w), "+v"(sc_a)); }
    (void)sc_w; (void)sc_a;
    const char* cA = cur.A; const char* cB = cur.B;
    PG8_STAGE(PG8_SB(0, 0), cB, voffB); PG8_STAGE(PG8_SB(0, 1), cB + hstep, voffB); PG8_STAGE(PG8_SA(0, 0), cA, voffA); PG8_STAGE(PG8_SA(0, 1), cA + hstep, voffA);
    if (wr == 1) PG8_BAR;
    PG8_WAIT_V(2); PG8_BAR;
    PG8_STAGE(PG8_SB(1, 0), cB + kstep, voffB); PG8_STAGE(PG8_SA(1, 0), cA + kstep, voffA); PG8_STAGE(PG8_SB(1, 1), cB + hstep + kstep, voffB);
    PG8_WAIT_V(6); PG8_BAR;
    for (;;) {
        const bool has_next = S.next(ui + 1, nxt);
        const char* nA = has_next ? nxt.A : cA; const char* nB = has_next ? nxt.B : cB;
#pragma nounroll
        for (int t = 0; t < nt; t += 2) {
            const bool last = (t == nt - 2);
            const char* a1 = cA + (size_t)(t + 1) * kstep;
            const char* a2 = last ? nA : cA + (size_t)(t + 2) * kstep; const char* b2 = last ? nB : cB + (size_t)(t + 2) * kstep;
            const char* a3 = a2 + kstep; const char* b3 = b2 + kstep;
            PG8_LDB(B0, 0, 0); PG8_LDB(B1, 0, 1); PG8_SCHED; PG8_LDA(At, 0, 0); PG8_STAGE(PG8_SA(1, 1), a1 + hstep, voffA);
            PG8_WAIT_V(8); PG8_WAIT_L(0); PG8_BAR; PG8_MMA(0, 0, At, B0); PG8_MMA(0, 1, At, B1); PG8_BAR; PG8_SCHED;
            PG8_LDA(At, 0, 1); PG8_STAGE(PG8_SB(0, 0), b2, voffB); PG8_STAGE(PG8_SB(0, 1), b2 + hstep, voffB); PG8_STAGE(PG8_SA(0, 0), a2, voffA);
            PG8_WAIT_V(8); PG8_WAIT_L(0); PG8_BAR; PG8_MMA(1, 0, At, B0); PG8_MMA(1, 1, At, B1); PG8_BAR; PG8_SCHED;
            PG8_LDB(B0, 1, 0); PG8_LDB(B1, 1, 1); PG8_SCHED; PG8_LDA(At, 1, 0); PG8_STAGE(PG8_SA(0, 1), a2 + hstep, voffA);
            PG8_WAIT_V(8); PG8_WAIT_L(0); PG8_BAR; PG8_MMA(0, 0, At, B0); PG8_MMA(0, 1, At, B1); PG8_BAR; PG8_SCHED;
            PG8_LDA(At, 1, 1); PG8_STAGE(PG8_SB(1, 0), b3, voffB); PG8_STAGE(PG8_SB(1, 1), b3 + hstep, voffB); PG8_STAGE(PG8_SA(1, 0), a3, voffA);
            PG8_WAIT_V(8); PG8_WAIT_L(0); PG8_BAR; PG8_MMA(1, 0, At, B0); PG8_MMA(1, 1, At, B1); PG8_BAR; PG8_SCHED;
        }
        if (wr == 0) PG8_BAR;
        if constexpr (Epi::FP8) { asm volatile("s_nop 15\n\ts_nop 3" ::: "memory"); _Pragma("unroll") for (int i_ = 0; i_ < 32; ++i_) asm volatile("" : "+v"(((f32x4*)acc)[i_])); }
        E(acc, cur, wr, wc, fr, fq);
        if (!has_next) break;
#pragma unroll
        for (int a = 0; a < 2; ++a)
#pragma unroll
            for (int b = 0; b < 2; ++b)
#pragma unroll
                for (int m = 0; m < 4; ++m)
#pragma unroll
                    for (int n = 0; n < 2; ++n) acc[a][b][m][n] = (f32x4){0.f, 0.f, 0.f, 0.f};
        cur = nxt; cA = nA; cB = nB; ++ui;
        if (wr == 1) PG8_BAR;
    }
    PG8_WAIT_V(0);
    PG8_BAR;
    }
    __syncthreads();
#undef PG8_SA
#undef PG8_SB
#undef PG8_STAGE
#undef PG8_LDA
#undef PG8_LDB
#undef PG8_MMA
#undef PG8_WAIT_V
#undef PG8_WAIT_L
#undef PG8_BAR
#undef PG8_SCHED
}
}

#define XB_TMO      128
#define XB_XCNT(j)  (256  + 64 * (j))
#define XB_XSUB(j)  (1280 + 64 * (j))
#define XB_XGEN(j)  (2304 + 64 * (j))
#define XB_TOP      3328
#define XB_TOPGEN   3392
#define XCD_BAR_WORDS 3456
#define XB_SPIN_CAP (1u << 18)
DI unsigned xb_ld(unsigned* p)              { return __hip_atomic_load(p, __ATOMIC_RELAXED, __HIP_MEMORY_SCOPE_AGENT); }
DI unsigned xb_add(unsigned* p, unsigned v) { return __hip_atomic_fetch_add(p, v, __ATOMIC_RELAXED, __HIP_MEMORY_SCOPE_AGENT); }
DI unsigned xb_xcc_id() { return (unsigned)__builtin_amdgcn_s_getreg((3 << 11) | 20) & 0xFu; }
#define XB_SPIN(cond, bar) do { unsigned _sp = 0; while (cond) { __builtin_amdgcn_s_sleep(1); \
    if ((++_sp & 255u) == 0u) { if (xb_ld(&(bar)[XB_TMO])) break; if (_sp > XB_SPIN_CAP) { atomicAdd(&(bar)[XB_TMO], 1u); break; } } } } while (0)
struct XcdBarrier { unsigned* bar; unsigned x; volatile LAS unsigned* st; };
DI XcdBarrier xcd_barrier_post(unsigned* bar, volatile LAS unsigned* st) {
    XcdBarrier b; b.bar = bar; b.x = xb_xcc_id(); b.st = st;
    if (threadIdx.x == 0) (void)xb_add(&bar[XB_XCNT(b.x)], 1u);
    return b;
}
DI void xcd_barrier_complete(unsigned* bar, unsigned x, unsigned& nloc, unsigned& nx) {
    const unsigned G = gridDim.x * gridDim.y * gridDim.z;
    unsigned sum, cnt, mine, sp = 0u;
    for (;;) {
        sum = 0u; cnt = 0u; mine = 0u;
#pragma unroll
        for (unsigned j = 0; j < 16; ++j) { const unsigned c = xb_ld(&bar[XB_XCNT(j)]); sum += c; cnt += (c > 0u) ? 1u : 0u; mine = (j == x) ? c : mine; }
        if (sum == G) break;
        __builtin_amdgcn_s_sleep(1);
        if ((++sp & 255u) == 0u) { if (xb_ld(&bar[XB_TMO])) break; if (sp > XB_SPIN_CAP) { atomicAdd(&bar[XB_TMO], 1u); break; } }
    }
    nloc = mine > 0u ? mine : 1u; nx = cnt > 0u ? cnt : 1u;
}
DI void xcd_barrier(const XcdBarrier& b) {
    asm volatile("s_waitcnt vmcnt(0)" ::: "memory");
    __syncthreads();
    if (threadIdx.x == 0) {
        unsigned* bar = b.bar;
        __builtin_amdgcn_s_waitcnt(0);
        unsigned nloc = b.st[0], nx = b.st[1];
        if (nloc == 0u) { xcd_barrier_complete(bar, b.x, nloc, nx); b.st[0] = nloc; b.st[1] = nx; }
        const unsigned old = xb_add(&bar[XB_XSUB(b.x)], 1u);
        const unsigned gen = old / nloc;
        if (old + 1u == (gen + 1u) * nloc) {
            __builtin_amdgcn_fence(__ATOMIC_RELEASE, "agent");
            asm volatile("s_waitcnt vmcnt(0)" ::: "memory");
            const unsigned og = xb_add(&bar[XB_TOP], 1u);
            const unsigned tg = og / nx;
            if (og + 1u == (tg + 1u) * nx) xb_add(&bar[XB_TOPGEN], 1u);
            else XB_SPIN(xb_ld(&bar[XB_TOPGEN]) == tg, bar);
            __builtin_amdgcn_fence(__ATOMIC_ACQUIRE, "agent");
            xb_add(&bar[XB_XGEN(b.x)], 1u);
            asm volatile("s_waitcnt vmcnt(0)" ::: "memory");
        } else {
            XB_SPIN(xb_ld(&bar[XB_XGEN(b.x)]) == gen, bar);
            __builtin_amdgcn_fence(__ATOMIC_ACQUIRE, "agent");
            asm volatile("s_waitcnt vmcnt(0)" ::: "memory");
        }
    }
    __syncthreads();
}

constexpr size_t MB = 1024 * 1024;
constexpr size_t WS_CTL    = 0;
constexpr size_t CTL_BYTES = 256 * 1024;
constexpr int    CW_BAR = 4096;
constexpr int    CW_CHK = 32768;
constexpr size_t WS_ROPE   = WS_CTL + CTL_BYTES;
constexpr size_t WS_WIN    = WS_ROPE + 512 * 1024;
constexpr size_t WS_WSBO   = WS_WIN + (size_t)NPROJ * DM * 2;
constexpr size_t WS_WRETO  = WS_WSBO + 1 * MB;
constexpr size_t WS_WMIX   = WS_WRETO + 2 * MB;
constexpr size_t WS_WCQ    = WS_WMIX + 2 * MB;
constexpr size_t WS_WCKV   = WS_WCQ + 2 * MB;
constexpr size_t WS_WCO    = WS_WCKV + 4 * MB;
constexpr size_t WS_WE1    = WS_WCO + 2 * MB;
constexpr size_t WS_WE2    = WS_WE1 + 128 * MB;
constexpr size_t WS_SMALL  = WS_WE2 + 64 * MB;
constexpr size_t WS_MEMN   = WS_SMALL + 4 * MB;
constexpr size_t WS_KVMEM  = WS_MEMN + 4 * MB;
constexpr size_t WS_GTOT   = WS_KVMEM + 8 * MB;
constexpr size_t WS_SLOTS  = WS_GTOT + 8 * MB;
constexpr size_t WS_A      = WS_SLOTS + 1 * MB;
constexpr size_t WS_B      = WS_A + 208 * MB;
constexpr size_t WS_C      = WS_B + 32 * MB;
constexpr size_t WS_D      = WS_C + 64 * MB;
constexpr size_t WS_E      = WS_D + 144 * MB;
constexpr size_t WS_END    = WS_E + 144 * MB;
static_assert((size_t)T * NPROJ * 2 <= 208 * MB && (size_t)PROWS * 1024 * 2 <= 144 * MB, "arena sizes");
constexpr size_t WS_PROJ = WS_A, WS_XG = WS_A, WS_XN1 = WS_B, WS_YRET = WS_B, WS_XN3U = WS_B, WS_TMP = WS_C, WS_X2 = WS_C;
constexpr size_t WS_YSB = WS_D, WS_MERGED = WS_D + 16 * MB, WS_XN2U = WS_D + 48 * MB  , WS_QX = WS_D + 80 * MB, WS_OX = WS_D + 112 * MB, WS_ACT = WS_D;
constexpr size_t WS_X1 = WS_E, WS_YROWS = WS_E;
constexpr size_t SM_TOPE = 0;
constexpr size_t SM_GATE = SM_TOPE + T * 16;
constexpr size_t SM_LRANK = SM_GATE + T * 16;
constexpr size_t SM_AROW = SM_LRANK + T * 16;
constexpr size_t SM_RSTD3 = SM_AROW + T * 16;
constexpr size_t SM_CNT = SM_RSTD3 + T * 4;
constexpr size_t SM_RSCALE = SM_CNT + 256 * 32 * 4;
constexpr size_t SM_RGATE = SM_RSCALE + PROWS * 4;
constexpr size_t SM_BLKE = SM_RGATE + PROWS * 4;
constexpr size_t SM_END = SM_BLKE + 4096;
static_assert(SM_END <= 4 * MB, "small tables");

constexpr int RING_OFF = 0, RING_BYTES = 131072;
constexpr int XTRA_OFF = RING_BYTES, XTRA_BYTES = 12288;
constexpr int LDSCTL_OFF = XTRA_OFF + XTRA_BYTES;
constexpr int LDS_BYTES = 147456;
static_assert(LDSCTL_OFF + 256 <= LDS_BYTES, "LDS map");
constexpr int NWAVES = 8;

struct Args { const float* in[20]; float* out; unsigned char* ws; int ph_lo, ph_hi; };

typedef const __attribute__((address_space(4))) unsigned char* kptr_t;
struct Frame {
    LAS unsigned char* lds;
    unsigned char* ws;
    int tid, lane, wave, G, bid;
    kptr_t kp;
    float* out;
};
DI const float* inp(const Frame& F, int i) { return *(const float* const __attribute__((address_space(4)))*)(F.kp + 8 * i); }
enum { I_X = 0, I_MEM, I_GMIX, I_WIN, I_WSBO, I_WRETO, I_WMIX, I_GXATTN, I_GMEM, I_WCQ, I_WCKV, I_WCO, I_GMOE, I_WROUTER, I_BROUTER, I_WE1, I_BE1, I_WE2, I_BE2, I_GFINAL };

DI float wave_sum(float v) {
#pragma unroll
    for (int o = 1; o < 64; o <<= 1) v += __shfl_xor(v, o);
    return v;
}

DI void p0_tr_item(const float* W, int N, int K, bf16* dst, LAS float* scr, int k0, int n0, int lane, const float* rowscale = nullptr) {
#pragma unroll 8
    for (int i = 0; i < 32; ++i) { const int kk = 2 * i + (lane >> 5); scr[kk * 33 + (lane & 31)] = W[(size_t)(k0 + kk) * N + n0 + (lane & 31)] * (rowscale ? rowscale[k0 + kk] : 1.0f); }
    LDS_WAIT(); asm volatile("" ::: "memory");
    const int c = lane & 7;
#pragma unroll
    for (int j = 0; j < 4; ++j) { const int n = (lane >> 3) + 8 * j; const LAS float* s = scr + (8 * c) * 33 + n;
        u32x4 o; o.x = cvtpk(s[0 * 33], s[1 * 33]); o.y = cvtpk(s[2 * 33], s[3 * 33]); o.z = cvtpk(s[4 * 33], s[5 * 33]); o.w = cvtpk(s[6 * 33], s[7 * 33]);
        *(u32x4*)(dst + (size_t)n * K + k0 + 8 * c) = o; }
    LDS_WAIT(); asm volatile("" ::: "memory");
}
DI unsigned cvt4_fp8(float a, float b, float c, float d) { int w = __builtin_amdgcn_cvt_pk_fp8_f32(a, b, 0, false); w = __builtin_amdgcn_cvt_pk_fp8_f32(c, d, w, true); return (unsigned)w; }
DI void p0_tr_item_fp8(const float* W, int N, int K, unsigned char* dst, LAS float* scr, int k0, int n0, int lane) {
#pragma unroll 8
    for (int i = 0; i < 32; ++i) { const int kk = 2 * i + (lane >> 5); scr[kk * 33 + (lane & 31)] = W[(size_t)(k0 + kk) * N + n0 + (lane & 31)] * 64.0f; }
    LDS_WAIT(); asm volatile("" ::: "memory");
    const int c = lane & 7;
#pragma unroll
    for (int j = 0; j < 4; ++j) { const int n = (lane >> 3) + 8 * j; const LAS float* s = scr + (8 * c) * 33 + n;
        u32x2 o; o.x = cvt4_fp8(s[0 * 33], s[1 * 33], s[2 * 33], s[3 * 33]); o.y = cvt4_fp8(s[4 * 33], s[5 * 33], s[6 * 33], s[7 * 33]);
        *(u32x2*)(dst + (size_t)n * K + k0 + 8 * c) = o; }
    LDS_WAIT(); asm volatile("" ::: "memory");
}
DI void rms_row_to_bf16(const float* xrow, const float* g, bf16* orow, int lane) {
    const f32x4* xr = (const f32x4*)xrow + lane; const f32x4* gr = (const f32x4*)g + lane;
    f32x4 v[4]; float s = 0.f;
#pragma unroll
    for (int j = 0; j < 4; ++j) { v[j] = xr[64 * j]; s += (v[j].x * v[j].x + v[j].y * v[j].y) + (v[j].z * v[j].z + v[j].w * v[j].w); }
    const float rstd = 1.0f / sqrtf(wave_sum(s) * (1.f / DM) + NORM_EPS);
    u32x2* o8 = (u32x2*)orow + lane;
#pragma unroll
    for (int j = 0; j < 4; ++j) { const f32x4 gg = gr[64 * j]; u32x2 w; w.x = cvtpk(v[j].x * rstd * gg.x, v[j].y * rstd * gg.y); w.y = cvtpk(v[j].z * rstd * gg.z, v[j].w * rstd * gg.w); o8[64 * j] = w; }
}
constexpr int P0_IE1 = 32 * 16 * 64, P0_IE2 = 32 * 16 * 32;
DI void p0_experts(Frame& F, int vg  , int nvg) {
    LAS float* scr = (LAS float*)(F.lds + RING_OFF + F.wave * 16384);
    constexpr int P0_BASE = 2048 * 22; const bool light = (F.G == 256) && (F.bid >= 192); const int nlv = 64 * NWAVES, lv = (F.bid - 192) * NWAVES + F.wave;
    const int n_mine = (F.G == 256) ? 22 + (light ? 8 : 0) : (P0_IE1 + P0_IE2 + nvg - 1) / nvg;
    for (int j = 0; j < n_mine; ++j) {
        int it; if (F.G != 256) { it = vg + j * nvg; if (it >= P0_IE1 + P0_IE2) break; } else if (j < 22) it = vg + j * nvg; else it = P0_BASE + lv + (j - 22) * nlv;
        int r = it;
        if (r < P0_IE1) { const int e = r / 1024, q = r % 1024, kb = q / 64, nb = q % 64, n0 = 32 * nb;
            const int drow = n0 < 1024 ? 256 * (n0 >> 7) + (n0 & 127) : 256 * ((n0 - 1024) >> 7) + 128 + ((n0 - 1024) & 127);
            p0_tr_item_fp8(inp(F, I_WE1) + (size_t)e * 1024 * 2048, 2048, 1024, F.ws + WS_WE1 + ((size_t)e * 2048 + drow) * 1024, scr, 64 * kb, n0, F.lane); continue; }
        r -= P0_IE1;
        { const int e = r / 512, q = r % 512, kb = q / 32, nb = q % 32;
            p0_tr_item_fp8(inp(F, I_WE2) + (size_t)e * 1024 * 1024, 1024, 1024, F.ws + WS_WE2 + ((size_t)e * 1024 + 32 * nb) * 1024, scr, 64 * kb, 32 * nb, F.lane); }
    }
}


DI void p0_prologue(Frame& F) {
    LAS float* scr = (LAS float*)(F.lds + RING_OFF + F.wave * 16384);
    const int gw = F.bid * NWAVES + F.wave, NGW = F.G * NWAVES;
    constexpr int I0 = 16 * 208, I1 = 8 * 32, I2 = 16 * 32, I5 = 16 * 64;
    constexpr int NITEMS = I0 + I1 + 4 * I2 + I5;
    for (int it = gw; it < NITEMS; it += NGW) {
        int r = it;
        if (r < I0) { const int kb = r / 208, nb = r % 208; p0_tr_item(inp(F, I_WIN), NPROJ, 1024, (bf16*)(F.ws + WS_WIN) + (size_t)(32 * nb) * 1024, scr, 64 * kb, 32 * nb, F.lane); continue; } r -= I0;
        if (r < I1) { const int kb = r / 32, nb = r % 32; p0_tr_item(inp(F, I_WSBO), 1024, 512, (bf16*)(F.ws + WS_WSBO) + (size_t)(32 * nb) * 512, scr, 64 * kb, 32 * nb, F.lane); continue; } r -= I1;
        if (r < I2) { const int kb = r / 32, nb = r % 32; p0_tr_item(inp(F, I_WRETO), 1024, 1024, (bf16*)(F.ws + WS_WRETO) + (size_t)(32 * nb) * 1024, scr, 64 * kb, 32 * nb, F.lane); continue; } r -= I2;
        if (r < I2) { const int kb = r / 32, nb = r % 32; p0_tr_item(inp(F, I_WMIX), 1024, 1024, (bf16*)(F.ws + WS_WMIX) + (size_t)(32 * nb) * 1024, scr, 64 * kb, 32 * nb, F.lane); continue; } r -= I2;
        if (r < I2) { const int kb = r / 32, nb = r % 32; p0_tr_item(inp(F, I_WCQ), 1024, 1024, (bf16*)(F.ws + WS_WCQ) + (size_t)(32 * nb) * 1024, scr, 64 * kb, 32 * nb, F.lane, inp(F, I_GXATTN)); continue; }   r -= I2;
        if (r < I5) { const int kb = r / 64, nb = r % 64; p0_tr_item(inp(F, I_WCKV), 2048, 1024, (bf16*)(F.ws + WS_WCKV) + (size_t)(32 * nb) * 1024, scr, 64 * kb, 32 * nb, F.lane); continue; } r -= I5;
        { const int kb = r / 32, nb = r % 32; p0_tr_item(inp(F, I_WCO), 1024, 1024, (bf16*)(F.ws + WS_WCO) + (size_t)(32 * nb) * 1024, scr, 64 * kb, 32 * nb, F.lane); }
    }
    for (int m = gw; m < T + BATCH * MEML; m += NGW) {
        if (m < T) rms_row_to_bf16(inp(F, I_X) + (size_t)m * DM, inp(F, I_GMIX), (bf16*)(F.ws + WS_XN1) + (size_t)m * DM, F.lane);
        else rms_row_to_bf16(inp(F, I_MEM) + (size_t)(m - T) * DM, inp(F, I_GMEM), (bf16*)(F.ws + WS_MEMN) + (size_t)(m - T) * DM, F.lane);
    }
    { float* ct = (float*)(F.ws + WS_ROPE); float* st = ct + SEQ * 32;
      for (int i = F.bid * 512 + F.tid; i < SEQ * 32; i += F.G * 512) { const int pos = i >> 5, k = i & 31;
          const float inv = fexp2(-(float)k * (13.287712379549449f / 32.0f)); const float ang = (float)pos * inv;
          const float n = rintf(ang * 0.15915494309189535f); float r = fmaf(-n, 6.2831854820251465f, ang); r = fmaf(-n, -1.7484555e-7f, r);
          const float rev = r * 0.15915494309189535f; ct[i] = __builtin_amdgcn_cosf(rev); st[i] = __builtin_amdgcn_sinf(rev); } }
}

typedef f32x4 AccT[2][2][4][2];
#define EPI_ROWS_BEGIN _Pragma("unroll") for (int ai = 0; ai < 2; ++ai) _Pragma("unroll") for (int m = 0; m < 4; ++m) { const int rloc = ai * 128 + wr * 64 + m * 16 + fr; const size_t row = (size_t)u.pm * 256 + rloc; (void)row;
#define EPI_ROWS_END }
DI u32x4 pack8(f32x4 a, f32x4 b) { u32x4 w; w.x = cvtpk(a[0], a[1]); w.y = cvtpk(a[2], a[3]); w.z = cvtpk(b[0], b[1]); w.w = cvtpk(b[2], b[3]); return w; }
DI void unpack8(u32x4 w, f32x4& a, f32x4& b) { a = (f32x4){bflo(w.x), bfhi(w.x), bflo(w.y), bfhi(w.y)}; b = (f32x4){bflo(w.z), bfhi(w.z), bflo(w.w), bfhi(w.w)}; }
DI f32x4 sig4(f32x4 g) { return (f32x4){sigmoidf_(g[0]), sigmoidf_(g[1]), sigmoidf_(g[2]), sigmoidf_(g[3])}; }

struct Epi1 { static constexpr bool PERM = true, FP8 = false; bf16* proj; bf16* kvmem;
    DI void operator()(const AccT& acc, const pg8::Unit& u, int wr, int wc, int fr, int fq) const {
        bf16* base; int ldc; float sc = 1.f;
        if (u.tag == 0) { base = proj; ldc = NPROJ; if (u.pn < 2) sc = SBQ_SCALE; else if (u.pn == 8 || u.pn == 9) sc = 0.125f; } else { base = kvmem; ldc = 2048; }
        const int col0 = u.pn * 256 + wc * 32 + 8 * fq;
        EPI_ROWS_BEGIN
            bf16* rowp = base + row * ldc + col0;
#pragma unroll
            for (int bj = 0; bj < 2; ++bj) *(u32x4*)(rowp + bj * 128) = pack8(acc[ai][bj][m][0] * sc, acc[ai][bj][m][1] * sc);
        EPI_ROWS_END
    }
};
struct Epi5a { static constexpr bool PERM = true, FP8 = false; const bf16* proj; bf16* tmp;
    DI void operator()(const AccT& acc, const pg8::Unit& u, int wr, int wc, int fr, int fq) const {
        const int col0 = u.pn * 256 + wc * 32 + 8 * fq;
        EPI_ROWS_BEGIN
#pragma unroll
            for (int bj = 0; bj < 2; ++bj) { f32x4 g0, g1; unpack8(*(const u32x4*)(proj + row * NPROJ + C_GSB + col0 + bj * 128), g0, g1);
                *(u32x4*)(tmp + row * DM + col0 + bj * 128) = pack8(sig4(g0) * acc[ai][bj][m][0], sig4(g1) * acc[ai][bj][m][1]); }
        EPI_ROWS_END
    }
};
struct Epi5b { static constexpr bool PERM = true, FP8 = false; const bf16* proj; const bf16* tmp; bf16* merged;
    DI void operator()(const AccT& acc, const pg8::Unit& u, int wr, int wc, int fr, int fq) const {
        const int col0 = u.pn * 256 + wc * 32 + 8 * fq;
        EPI_ROWS_BEGIN
#pragma unroll
            for (int bj = 0; bj < 2; ++bj) { f32x4 g0, g1; unpack8(*(const u32x4*)(proj + row * NPROJ + C_GRET + col0 + bj * 128), g0, g1);
                f32x4 t0, t1; unpack8(*(const u32x4*)(tmp + row * DM + col0 + bj * 128), t0, t1);
                *(u32x4*)(merged + row * DM + col0 + bj * 128) = pack8(t0 + sig4(g0) * acc[ai][bj][m][0], t1 + sig4(g1) * acc[ai][bj][m][1]); }
        EPI_ROWS_END
    }
};
template <bool FIRST> struct EpiRes { static constexpr bool PERM = true, FP8 = false; const void* xi; bf16* xo; float* slots;
    DI void operator()(const AccT& acc, const pg8::Unit& u, int wr, int wc, int fr, int fq) const {
        const int col0 = u.pn * 256 + wc * 32 + 8 * fq;
        EPI_ROWS_BEGIN
            float ss = 0.f;
#pragma unroll
            for (int bj = 0; bj < 2; ++bj) { const size_t off = row * DM + col0 + bj * 128; f32x4 a, b;
                if (FIRST) { a = *(const f32x4*)((const float*)xi + off); b = *(const f32x4*)((const float*)xi + off + 4); } else unpack8(*(const u32x4*)((const bf16*)xi + off), a, b);
                a += acc[ai][bj][m][0]; b += acc[ai][bj][m][1];
                *(u32x4*)(xo + off) = pack8(a, b);
                if (FIRST) ss += (a[0] * a[0] + a[1] * a[1]) + (a[2] * a[2] + a[3] * a[3]) + (b[0] * b[0] + b[1] * b[1]) + (b[2] * b[2] + b[3] * b[3]); }
            if (FIRST) { ss += __shfl_xor(ss, 16); ss += __shfl_xor(ss, 32); if (fq == 0) slots[row * 16 + u.pn * 4 + wc] = ss; }
        EPI_ROWS_END
    }
};
struct Epi7 { static constexpr bool PERM = true, FP8 = false; const float* slots; bf16* qx;
    DI void operator()(const AccT& acc, const pg8::Unit& u, int wr, int wc, int fr, int fq) const {
        const int col0 = u.pn * 256 + wc * 32 + 8 * fq;
        EPI_ROWS_BEGIN
            const f32x4 s4 = *(const f32x4*)(slots + row * 16 + 4 * fq); float ss = (s4[0] + s4[1]) + (s4[2] + s4[3]); ss += __shfl_xor(ss, 16); ss += __shfl_xor(ss, 32);
            const float sc = XQ_SCALE / sqrtf(ss * (1.f / DM) + NORM_EPS);
#pragma unroll
            for (int bj = 0; bj < 2; ++bj) *(u32x4*)(qx + row * DM + col0 + bj * 128) = pack8(acc[ai][bj][m][0] * sc, acc[ai][bj][m][1] * sc);
        EPI_ROWS_END
    }
};
struct Epi12 { static constexpr bool PERM = true, FP8 = true; static constexpr int SCALE_W = 0x79797979, SCALE_A = 0x7f7f7f7f;   const float* rscale; const float* b1; unsigned char* act;
    DI void operator()(const AccT& acc, const pg8::Unit& u, int wr, int wc, int fr, int fq) const {
        const int ac0 = u.pn * 128 + wc * 32 + 8 * fq; const float* bb = b1 + (size_t)u.e * 2048;
        const f32x4 bg0 = *(const f32x4*)(bb + ac0), bg1 = *(const f32x4*)(bb + ac0 + 4), bl0 = *(const f32x4*)(bb + 1024 + ac0), bl1 = *(const f32x4*)(bb + 1024 + ac0 + 4);
        EPI_ROWS_BEGIN
            const float rs = rscale[row];
            f32x4 o[2];
#pragma unroll
            for (int n = 0; n < 2; ++n) { const f32x4 gl = acc[ai][0][m][n] * rs + (n ? bg1 : bg0), li = acc[ai][1][m][n] * rs + (n ? bl1 : bl0);
#pragma unroll
                for (int i = 0; i < 4; ++i) { const float gg = fminf(gl[i], 7.0f), ll = fminf(fmaxf(li[i], -7.0f), 7.0f); o[n][i] = gg * frcp(1.0f + fexp2(-1.702f * LOG2E * gg)) * (ll + 1.0f); } }
            { u32x2 w; w.x = cvt4_fp8(o[0][0], o[0][1], o[0][2], o[0][3]); w.y = cvt4_fp8(o[1][0], o[1][1], o[1][2], o[1][3]); *(u32x2*)(act + row * DFF + ac0) = w; }
        EPI_ROWS_END
    }
};
struct Epi13 { static constexpr bool PERM = true, FP8 = true; static constexpr int SCALE_W = 0x79797979, SCALE_A = 0x7f7f7f7f; const float* rgate; const float* b2; bf16* yrows;
    DI void operator()(const AccT& acc, const pg8::Unit& u, int wr, int wc, int fr, int fq) const {
        const int col0 = u.pn * 256 + wc * 32 + 8 * fq; const float* bb = b2 + (size_t)u.e * 1024 + col0;
        f32x4 bv[2][2];
#pragma unroll
        for (int bj = 0; bj < 2; ++bj) { bv[bj][0] = *(const f32x4*)(bb + bj * 128); bv[bj][1] = *(const f32x4*)(bb + bj * 128 + 4); }
        EPI_ROWS_BEGIN
            const float gt = rgate[row];
#pragma unroll
            for (int bj = 0; bj < 2; ++bj) *(u32x4*)(yrows + row * DM + col0 + bj * 128) = pack8((acc[ai][bj][m][0] + bv[bj][0]) * gt, (acc[ai][bj][m][1] + bv[bj][1]) * gt);
        EPI_ROWS_END
    }
};

DI void lds_barrier() { asm volatile("s_waitcnt lgkmcnt(0)" ::: "memory"); __builtin_amdgcn_s_barrier(); asm volatile("" ::: "memory"); }

constexpr int SB_K = 0, SB_V = 8192;
DI void sb_unit(Frame& F, int b, int h, int qb) {
    const int lane = F.lane, r32 = lane & 31, hi = lane >> 5, wid = F.wave;
    LAS char* lds = (LAS char*)F.lds;
    const bf16* Pj = (const bf16*)(F.ws + WS_PROJ) + (size_t)b * SEQ * NPROJ;
    const int qw0 = qb * 256 + wid * 32, q = qw0 + r32;
    bf16x8 qr[4];
#pragma unroll
    for (int d0 = 0; d0 < 4; ++d0) qr[d0] = *(const bf16x8*)(Pj + (size_t)q * NPROJ + C_SBQ + h * 64 + d0 * 16 + hi * 8);
    f32x16 o0, o1;
#pragma unroll
    for (int r = 0; r < 16; ++r) { o0[r] = 0.f; o1[r] = 0.f; }
    float carry = 0.f;
    const bf16* ksrc = Pj + (size_t)lane * NPROJ + C_SBK + h * 64 + wid * 8;
    const bf16* vsrc = Pj + (size_t)(16 * (wid & 3) + (lane >> 2)) * NPROJ + C_SBV + h * 64 + (wid >> 2) * 32 + (lane & 3) * 8;
    LAS char* kdst = lds + SB_K + wid * 1024 + lane * 16; LAS char* vdst = lds + SB_V + wid * 1024 + lane * 16;
    const LAS char* kp0 = lds + SB_K + hi * 1024 + r32 * 16;
    const LAS char* vp0 = lds + SB_V + ((lane >> 4) & 1) * 32 + (lane & 3) * 8 + (4 * hi + ((lane & 15) >> 2)) * 64;
    int kt = 4 * qb + 3, par = 0;
    volatile LAS int* flg = (volatile LAS int*)(lds + XTRA_OFF + 1024);
    u32x4 kreg = *(const u32x4*)(ksrc + (size_t)kt * 64 * NPROJ), vreg = *(const u32x4*)(vsrc + (size_t)kt * 64 * NPROJ);
    for (;;) {
        *(LAS u32x4*)kdst = kreg; *(LAS u32x4*)vdst = vreg;
        __syncthreads();
        if (kt > 0) { kreg = *(const u32x4*)(ksrc + (size_t)(kt - 1) * 64 * NPROJ); vreg = *(const u32x4*)(vsrc + (size_t)(kt - 1) * 64 * NPROJ); }
        const int k0 = kt * 64;
        const bool active = (k0 < qw0 + 31) && !__all(carry >= SB_THR);
        if (active) {
            f32x16 p0, p1;
#pragma unroll
            for (int r = 0; r < 16; ++r) { p0[r] = 0.f; p1[r] = 0.f; }
#pragma unroll
            for (int d0 = 0; d0 < 4; ++d0) { const bf16x8 a0 = *(const LAS bf16x8*)(kp0 + d0 * 2048), a1 = *(const LAS bf16x8*)(kp0 + d0 * 2048 + 512);
                p0 = MFMA32(a0, qr[d0], p0); p1 = MFMA32(a1, qr[d0], p1); }
            const bool mask = (k0 + 63 >= qw0);
            float sp[8][4], Mj[8];
#pragma unroll
            for (int j = 0; j < 8; ++j) { float s = 0.f;
#pragma unroll
                for (int i = 0; i < 4; ++i) { const float zl = (j < 4) ? p0[4 * (j & 3) + i] : p1[4 * (j & 3) + i];
                    float v = fmaxf(zl, 0.f) + flog2(1.0f + fexp2(-fabsf(zl)));
                    if (mask) { const int key = k0 + 32 * (j >> 2) + 8 * (j & 3) + 4 * hi + i; v = (key < q) ? v : 0.f; }
                    sp[j][i] = v; s += v; }
                Mj[j] = s; }
            float ps = 0.f; u32x4 pw[4];
#pragma unroll
            for (int j = 7; j >= 0; --j) {
                const auto rr = __builtin_amdgcn_permlane32_swap(__float_as_uint(Mj[j]), __float_as_uint(Mj[j]), false, false);
                const float Pp = __uint_as_float(hi ? rr[0] : rr[1]);
                float C = carry + ps + (hi ? 0.f : Pp);
                float w[4];
#pragma unroll
                for (int i = 3; i >= 0; --i) { const float zl = (j < 4) ? p0[4 * (j & 3) + i] : p1[4 * (j & 3) + i];
                    C += sp[j][i]; float wv = fexp2(zl - C);
                    if (mask) { const int key = k0 + 32 * (j >> 2) + 8 * (j & 3) + 4 * hi + i; wv = (key < q) ? wv : 0.f; }
                    w[i] = wv; }
                pw[j >> 1][2 * (j & 1)] = cvtpk(w[0], w[1]); pw[j >> 1][2 * (j & 1) + 1] = cvtpk(w[2], w[3]);
                ps += Mj[j] + Pp; }
            carry += ps;
#pragma unroll
            for (int ks = 0; ks < 4; ++ks) {
                const s16x4 l0 = vtr(vp0 + ks * 1024), h0 = vtr(vp0 + ks * 1024 + 512), l1 = vtr(vp0 + 4096 + ks * 1024), h1 = vtr(vp0 + 4096 + ks * 1024 + 512);
                const bf16x8 pa = __builtin_bit_cast(bf16x8, pw[ks]);
                o0 = MFMA32(pa, ((bf16x8){l0[0], l0[1], l0[2], l0[3], h0[0], h0[1], h0[2], h0[3]}), o0);
                o1 = MFMA32(pa, ((bf16x8){l1[0], l1[1], l1[2], l1[3], h1[0], h1[1], h1[2], h1[3]}), o1); }
        }
        const int need = (kt > 0) && !__all(carry >= SB_THR);
        if (lane == 0) flg[par * 8 + wid] = need;
        __syncthreads();
        const int any = (flg[par * 8] | flg[par * 8 + 1]) | (flg[par * 8 + 2] | flg[par * 8 + 3]) | (flg[par * 8 + 4] | flg[par * 8 + 5]) | (flg[par * 8 + 6] | flg[par * 8 + 7]);
        par ^= 1;
        if (!any) break;
        --kt;
    }
    bf16* Y = (bf16*)(F.ws + WS_YSB) + (size_t)(b * SEQ + qw0) * 512 + h * 64 + r32;
#pragma unroll
    for (int r = 0; r < 16; ++r) { const int rw = crow(r, hi); Y[(size_t)rw * 512] = (bf16)(cvtpk(o0[r], 0.f) & 0xffffu); Y[(size_t)rw * 512 + 32] = (bf16)(cvtpk(o1[r], 0.f) & 0xffffu); }
}

DI float ret_log2g(int h) { const float x = fexp2(-(float)(5 + h)); return -LOG2E * (x * (1.0f + x * (0.5f + x * (0.33333334f + x * (0.25f + x * 0.2f))))); }
DI int vlay(int tok, int col) { return (col >> 5) * 4096 + (tok >> 4) * 1024 + (tok & 15) * 64 + (col & 31) * 2; }
struct RotRegs { u32x4 a, b; f32x4 c0, c1, s0, s1; };
DI void rot_load(RotRegs& R, const bf16* row  , const float* rope, int pos, int c) {
    R.a = *(const u32x4*)(row + 8 * c); R.b = *(const u32x4*)(row + 32 + 8 * c);
    const float* ct = rope + pos * 32 + 8 * c; const float* st = ct + SEQ * 32;
    R.c0 = *(const f32x4*)ct; R.c1 = *(const f32x4*)(ct + 4); R.s0 = *(const f32x4*)st; R.s1 = *(const f32x4*)(st + 4);
}
DI void rot_apply(const RotRegs& R, f32x4& y1a, f32x4& y1b, f32x4& y2a, f32x4& y2b) {
    f32x4 x1a, x1b, x2a, x2b; unpack8(R.a, x1a, x1b); unpack8(R.b, x2a, x2b);
    y1a = x1a * R.c0 - x2a * R.s0; y1b = x1b * R.c1 - x2b * R.s1; y2a = x1a * R.s0 + x2a * R.c0; y2b = x1b * R.s1 + x2b * R.c1;
}

constexpr int RT_KD = 16384, RT_V = 24576;
DI void rt_unit(Frame& F, int b, int h, int g) {
    const int lane = F.lane, r32 = lane & 31, hi = lane >> 5, wid = F.wave, tid = F.tid, di = wid >> 2, dj = wid & 3;
    LAS char* lds = (LAS char*)F.lds;
    const bf16* Pj = (const bf16*)(F.ws + WS_PROJ) + (size_t)(b * SEQ + g * 512) * NPROJ;
    const float* rope = (const float*)(F.ws + WS_ROPE);
    const float lg = ret_log2g(h);
    f32x16 acc;
#pragma unroll
    for (int r = 0; r < 16; ++r) acc[r] = 0.f;
    const int ktok = tid >> 2, kc = tid & 3;
    RotRegs R; u32x4 v0, v1;
    const int vt0 = tid >> 4, vc0 = tid & 15, vt1 = (tid + 512) >> 4;
#define RT_LOADS(step_) do { const bf16* base_ = Pj + (size_t)((step_) * 64) * NPROJ; \
        if (tid < 256) rot_load(R, base_ + (size_t)ktok * NPROJ + C_RK + h * 64, rope, g * 512 + (step_) * 64 + ktok, kc); \
        v0 = *(const u32x4*)(base_ + (size_t)vt0 * NPROJ + C_RV + h * 128 + 8 * vc0); v1 = *(const u32x4*)(base_ + (size_t)vt1 * NPROJ + C_RV + h * 128 + 8 * vc0); } while (0)
    RT_LOADS(0);
    const LAS char* trb = lds + ((lane >> 4) & 1) * 32 + (lane & 3) * 8 + (4 * hi + ((lane & 15) >> 2)) * 64;
    for (int step = 0; step < 8; ++step) {
        if (tid < 256) { f32x4 y1a, y1b, y2a, y2b; rot_apply(R, y1a, y1b, y2a, y2b); const float dec = fexp2(lg * (float)(511 - (step * 64 + ktok)));
            *(LAS u32x4*)(lds + RT_KD + vlay(ktok, 8 * kc)) = pack8(y1a * dec, y1b * dec); *(LAS u32x4*)(lds + RT_KD + vlay(ktok, 32 + 8 * kc)) = pack8(y2a * dec, y2b * dec); }
        *(LAS u32x4*)(lds + RT_V + vlay(vt0, 8 * vc0)) = v0; *(LAS u32x4*)(lds + RT_V + vlay(vt1, 8 * vc0)) = v1;
        __syncthreads();
        if (step < 7) RT_LOADS(step + 1);
#pragma unroll
        for (int ks = 0; ks < 4; ++ks) {
            const s16x4 al = vtr(trb + RT_KD + di * 4096 + ks * 1024), ah = vtr(trb + RT_KD + di * 4096 + ks * 1024 + 512);
            const s16x4 bl = vtr(trb + RT_V + dj * 4096 + ks * 1024), bh = vtr(trb + RT_V + dj * 4096 + ks * 1024 + 512);
            acc = MFMA32(((bf16x8){al[0], al[1], al[2], al[3], ah[0], ah[1], ah[2], ah[3]}), ((bf16x8){bl[0], bl[1], bl[2], bl[3], bh[0], bh[1], bh[2], bh[3]}), acc); }
        __syncthreads();
    }
    float* G = (float*)(F.ws + WS_GTOT) + (size_t)((b * 8 + h) * 4 + g) * 8192 + dj * 32 + r32;
#pragma unroll
    for (int r = 0; r < 16; ++r) G[(di * 32 + crow(r, hi)) * 128] = acc[r];
}

constexpr int RO_QD = 0, RO_KI = 8192, RO_KD = 16384, RO_V = 24576, RO_SS = 40960, RO_OST = 57344;
DI void ro_unit(Frame& F, int b, int h, int g) {
    const int lane = F.lane, r32 = lane & 31, hi = lane >> 5, wid = F.wave, tid = F.tid, ci = wid >> 2, dj = wid & 3;
    LAS char* lds = (LAS char*)F.lds;
    const bf16* Pg = (const bf16*)(F.ws + WS_PROJ) + (size_t)(b * SEQ + g * 512) * NPROJ;
    const float* rope = (const float*)(F.ws + WS_ROPE);
    const float lg = ret_log2g(h);
    f32x16 st;
#pragma unroll
    for (int r = 0; r < 16; ++r) st[r] = 0.f;
    for (int gp = 0; gp < g; ++gp) { const float coef = fexp2(lg * (float)(512 * (g - 1 - gp)));
        const float* G = (const float*)(F.ws + WS_GTOT) + (size_t)((b * 8 + h) * 4 + gp) * 8192 + dj * 32 + r32;
#pragma unroll
        for (int r = 0; r < 16; ++r) st[r] += coef * G[(ci * 32 + crow(r, hi)) * 128]; }
    const float dec64 = fexp2(lg * 64.0f);
    const bool isq = tid < 256; const int rtok = (tid & 255) >> 2, rc = tid & 3;
    RotRegs R; u32x4 v0, v1, gn0, gn1, gc0, gc1;
    const int vt0 = tid >> 4, vc0 = tid & 15, vt1 = (tid + 512) >> 4;
    const int grow = tid >> 3, gseg = tid & 7;
#define RO_LOADS(n_) do { const bf16* base_ = Pg + (size_t)((n_) * 64) * NPROJ; \
        rot_load(R, base_ + (size_t)rtok * NPROJ + (isq ? C_RQ : C_RK) + h * 64, rope, g * 512 + (n_) * 64 + rtok, rc); \
        v0 = *(const u32x4*)(base_ + (size_t)vt0 * NPROJ + C_RV + h * 128 + 8 * vc0); v1 = *(const u32x4*)(base_ + (size_t)vt1 * NPROJ + C_RV + h * 128 + 8 * vc0); \
        gn0 = *(const u32x4*)(base_ + (size_t)grow * NPROJ + C_RG + h * 128 + gseg * 16); gn1 = *(const u32x4*)(base_ + (size_t)grow * NPROJ + C_RG + h * 128 + gseg * 16 + 8); } while (0)
    RO_LOADS(0);
    const LAS char* trv = lds + ((lane >> 4) & 1) * 32 + (lane & 3) * 8 + (4 * hi + ((lane & 15) >> 2)) * 64;
    const LAS char* trs = lds + ((lane >> 4) & 1) * 32 + (lane & 3) * 8 + (8 * hi + ((lane & 15) >> 2)) * 64;
    for (int n = 0; n < 8; ++n) {
        lds_barrier();
        gc0 = gn0; gc1 = gn1;
        { f32x4 y1a, y1b, y2a, y2b; rot_apply(R, y1a, y1b, y2a, y2b);
          if (isq) { const float s = fexp2(lg * (float)(rtok + 1));
              *(LAS u32x4*)(lds + RO_QD + rc * 1024 + rtok * 16) = pack8(y1a * s, y1b * s); *(LAS u32x4*)(lds + RO_QD + (rc + 4) * 1024 + rtok * 16) = pack8(y2a * s, y2b * s); }
          else { const float si = fexp2(-lg * (float)(rtok + 1)), sd = fexp2(lg * (float)(63 - rtok));
              *(LAS u32x4*)(lds + RO_KI + rc * 1024 + rtok * 16) = pack8(y1a * si, y1b * si); *(LAS u32x4*)(lds + RO_KI + (rc + 4) * 1024 + rtok * 16) = pack8(y2a * si, y2b * si);
              *(LAS u32x4*)(lds + RO_KD + vlay(rtok, 8 * rc)) = pack8(y1a * sd, y1b * sd); *(LAS u32x4*)(lds + RO_KD + vlay(rtok, 32 + 8 * rc)) = pack8(y2a * sd, y2b * sd); } }
        *(LAS u32x4*)(lds + RO_V + vlay(vt0, 8 * vc0)) = v0; *(LAS u32x4*)(lds + RO_V + vlay(vt1, 8 * vc0)) = v1;
#pragma unroll
        for (int r = 0; r < 16; ++r) *(LAS bf16*)(lds + RO_SS + vlay(ci * 32 + crow(r, hi), dj * 32 + r32)) = (bf16)(cvtpk(st[r], 0.f) & 0xffffu);
        lds_barrier();
        if (n < 7) RO_LOADS(n + 1);
        bf16x8 qf[4];
#pragma unroll
        for (int d0 = 0; d0 < 4; ++d0) qf[d0] = *(const LAS bf16x8*)(lds + RO_QD + (2 * d0 + hi) * 1024 + (ci * 32 + r32) * 16);
        f32x16 p0, p1, o;
#pragma unroll
        for (int r = 0; r < 16; ++r) { p0[r] = 0.f; p1[r] = 0.f; o[r] = 0.f; }
#pragma unroll
        for (int d0 = 0; d0 < 4; ++d0) { p0 = MFMA32(*(const LAS bf16x8*)(lds + RO_KI + (2 * d0 + hi) * 1024 + r32 * 16), qf[d0], p0);
            if (ci) p1 = MFMA32(*(const LAS bf16x8*)(lds + RO_KI + (2 * d0 + hi) * 1024 + 512 + r32 * 16), qf[d0], p1); }
        const int ql = ci * 32 + r32;
        u32x4 pw[4];
#pragma unroll
        for (int j = 0; j < 8; ++j) { float w[4];
#pragma unroll
            for (int i = 0; i < 4; ++i) { const float z = (j < 4) ? p0[4 * (j & 3) + i] : p1[4 * (j & 3) + i]; const int key = 32 * (j >> 2) + 8 * (j & 3) + 4 * hi + i; w[i] = (key <= ql) ? z : 0.f; }
            pw[j >> 1][2 * (j & 1)] = cvtpk(w[0], w[1]); pw[j >> 1][2 * (j & 1) + 1] = cvtpk(w[2], w[3]); }
#pragma unroll
        for (int r = 0; r < 16; ++r) st[r] *= dec64;
#pragma unroll
        for (int ks = 0; ks < 4; ++ks) {
            const s16x4 bl = vtr(trv + RO_V + dj * 4096 + ks * 1024), bh = vtr(trv + RO_V + dj * 4096 + ks * 1024 + 512);
            const bf16x8 vf = (bf16x8){bl[0], bl[1], bl[2], bl[3], bh[0], bh[1], bh[2], bh[3]};
            if (ks < 2 || ci) o = MFMA32(__builtin_bit_cast(bf16x8, pw[ks]), vf, o);
            const s16x4 al = vtr(trv + RO_KD + ci * 4096 + ks * 1024), ah = vtr(trv + RO_KD + ci * 4096 + ks * 1024 + 512);
            st = MFMA32(((bf16x8){al[0], al[1], al[2], al[3], ah[0], ah[1], ah[2], ah[3]}), vf, st); }
#pragma unroll
        for (int d0 = 0; d0 < 4; ++d0) { const s16x4 sl = vtr(trs + RO_SS + dj * 4096 + d0 * 1024), sh = vtr(trs + RO_SS + dj * 4096 + d0 * 1024 + 256);
            o = MFMA32(qf[d0], ((bf16x8){sl[0], sl[1], sl[2], sl[3], sh[0], sh[1], sh[2], sh[3]}), o); }
#pragma unroll
        for (int r = 0; r < 16; ++r) *(LAS float*)(lds + RO_OST + ((ci * 32 + crow(r, hi)) * 132 + dj * 32 + r32) * 4) = o[r];
        lds_barrier();
        { const LAS float* orow = (const LAS float*)(lds + RO_OST) + grow * 132 + gseg * 16; f32x4 x[4]; float s = 0.f;
#pragma unroll
          for (int k = 0; k < 4; ++k) { x[k] = *(const LAS f32x4*)(orow + 4 * k); s += (x[k][0] + x[k][1]) + (x[k][2] + x[k][3]); }
          s += __shfl_xor(s, 1); s += __shfl_xor(s, 2); s += __shfl_xor(s, 4);
          const float mu = s * (1.f / 128.f); float qv = 0.f;
#pragma unroll
          for (int k = 0; k < 4; ++k) { x[k] = x[k] - mu; qv += (x[k][0] * x[k][0] + x[k][1] * x[k][1]) + (x[k][2] * x[k][2] + x[k][3] * x[k][3]); }
          qv += __shfl_xor(qv, 1); qv += __shfl_xor(qv, 2); qv += __shfl_xor(qv, 4);
          const float rstd = 1.0f / sqrtf(qv * (1.f / 128.f) + NORM_EPS);
          const size_t trow = (size_t)(b * SEQ + g * 512 + n * 64 + grow);
          f32x4 g0, g1, g2, g3; unpack8(gc0, g0, g1); unpack8(gc1, g2, g3);
          bf16* yo = (bf16*)(F.ws + WS_YRET) + trow * DM + h * 128 + gseg * 16;
          *(u32x4*)yo = pack8(g0 * sig4(g0) * x[0] * rstd, g1 * sig4(g1) * x[1] * rstd); *(u32x4*)(yo + 8) = pack8(g2 * sig4(g2) * x[2] * rstd, g3 * sig4(g3) * x[3] * rstd); }
    }
}

DI void xa_unit(Frame& F, int b, int hx, int qb) {
    const int lane = F.lane, r32 = lane & 31, hi = lane >> 5, wid = F.wave, tid = F.tid;
    LAS char* lds = (LAS char*)F.lds;
    const int qw0 = qb * 256 + wid * 32;
    const bf16* Q = (const bf16*)(F.ws + WS_QX) + (size_t)(b * SEQ + qw0 + r32) * DM + hx * 256 + hi * 8;
    const bf16* KV = (const bf16*)(F.ws + WS_KVMEM) + (size_t)(b * MEML) * 2048 + hx * 256;
    bf16x8 qr[16];
#pragma unroll
    for (int d0 = 0; d0 < 16; ++d0) qr[d0] = *(const bf16x8*)(Q + d0 * 16);
    __syncthreads();
#pragma unroll 4
    for (int j = 0; j < 16; ++j) { const int i = tid + 512 * j, c = i & 31, key = i >> 5;
        *(LAS u32x4*)(lds + (key >> 6) * 32768 + c * 1024 + (key & 63) * 16) = *(const u32x4*)(KV + (size_t)key * 2048 + 8 * c); }
    __syncthreads();
    f32x16 sc[8];
#pragma unroll
    for (int t = 0; t < 8; ++t)
#pragma unroll
        for (int r = 0; r < 16; ++r) sc[t][r] = 0.f;
#pragma unroll
    for (int kt = 0; kt < 4; ++kt)
#pragma unroll
        for (int d0 = 0; d0 < 16; ++d0) { const LAS char* kp = lds + kt * 32768 + (2 * d0 + hi) * 1024 + r32 * 16;
            sc[2 * kt] = MFMA32(*(const LAS bf16x8*)kp, qr[d0], sc[2 * kt]); sc[2 * kt + 1] = MFMA32(*(const LAS bf16x8*)(kp + 512), qr[d0], sc[2 * kt + 1]); }
    float mx = -3.0e38f;
#pragma unroll
    for (int t = 0; t < 8; ++t)
#pragma unroll
        for (int r = 0; r < 16; ++r) mx = fmaxf(mx, sc[t][r]);
    { const auto rr = __builtin_amdgcn_permlane32_swap(__float_as_uint(mx), __float_as_uint(mx), false, false); mx = fmaxf(__uint_as_float(rr[0]), __uint_as_float(rr[1])); }
    float l = 0.f; u32x4 pa[16];
#pragma unroll
    for (int t = 0; t < 8; ++t)
#pragma unroll
        for (int r2 = 0; r2 < 8; ++r2) { const float e0 = fexp2(sc[t][2 * r2] - mx), e1 = fexp2(sc[t][2 * r2 + 1] - mx); l += e0 + e1; pa[2 * t + (r2 >> 2)][r2 & 3] = cvtpk(e0, e1); }
    { const auto rr = __builtin_amdgcn_permlane32_swap(__float_as_uint(l), __float_as_uint(l), false, false); l = __uint_as_float(rr[0]) + __uint_as_float(rr[1]); }
    LAS float* wsf = (LAS float*)(lds + XTRA_OFF) + wid * 32;
    if (hi == 0) wsf[r32] = 1.0f / l;
    __syncthreads();
#pragma unroll 4
    for (int j = 0; j < 16; ++j) { const int i = tid + 512 * j, c = i & 31, key = i >> 5;
        *(LAS u32x4*)(lds + (key >> 6) * 32768 + (c >> 2) * 4096 + ((key & 63) >> 4) * 1024 + (key & 15) * 64 + (c & 3) * 16) = *(const u32x4*)(KV + (size_t)key * 2048 + 1024 + 8 * c); }
    __syncthreads();
    f32x16 o[8];
#pragma unroll
    for (int t = 0; t < 8; ++t)
#pragma unroll
        for (int r = 0; r < 16; ++r) o[t][r] = 0.f;
    const LAS char* vp0 = lds + ((lane >> 4) & 1) * 32 + (lane & 3) * 8 + (4 * hi + ((lane & 15) >> 2)) * 64;
#pragma unroll
    for (int vt = 0; vt < 4; ++vt)
#pragma unroll
        for (int ks = 0; ks < 4; ++ks) { const bf16x8 pf = __builtin_bit_cast(bf16x8, pa[4 * vt + ks]);
#pragma unroll
            for (int d0 = 0; d0 < 8; ++d0) { const s16x4 lo = vtr(vp0 + vt * 32768 + d0 * 4096 + ks * 1024), hh = vtr(vp0 + vt * 32768 + d0 * 4096 + ks * 1024 + 512);
                o[d0] = MFMA32(pf, ((bf16x8){lo[0], lo[1], lo[2], lo[3], hh[0], hh[1], hh[2], hh[3]}), o[d0]); } }
    bf16* O = (bf16*)(F.ws + WS_OX) + (size_t)(b * SEQ + qw0) * DM + hx * 256 + r32;
#pragma unroll
    for (int r = 0; r < 16; ++r) { const int rw = crow(r, hi); const float il = wsf[rw];
#pragma unroll
        for (int d0 = 0; d0 < 8; ++d0) O[(size_t)rw * DM + d0 * 32] = (bf16)(cvtpk(o[d0][r] * il, 0.f) & 0xffffu); }
}

DI void route_a(Frame& F, int tb) {
    const int lane = F.lane, wid = F.wave, tid = F.tid, tg = wid >> 2, kq = wid & 3, hi = lane >> 5, e31 = lane & 31;
    LAS char* lds = (LAS char*)F.lds;
    const float* wr = inp(F, I_WROUTER); const float* gm = inp(F, I_GMOE); const bf16* x2 = (const bf16*)(F.ws + WS_XN3U);
    unsigned char* sm = F.ws + WS_SMALL;
    __syncthreads();
#pragma unroll 4
    for (int j = 0; j < 16; ++j) { const int i = tid + 512 * j, k = i >> 3, e4 = (i & 7) * 4; *(LAS f32x4*)(lds + (k * 32 + e4) * 4) = *(const f32x4*)(wr + k * 32 + e4) * gm[k]; }
    __syncthreads();
    const int tok = tb * 64 + tg * 32 + e31;
    const bf16* xr = x2 + (size_t)tok * DM + kq * 256 + 4 * hi;
    f32x16 acc;
#pragma unroll
    for (int r = 0; r < 16; ++r) acc[r] = 0.f;
    float ss = 0.f;
    const LAS float* WR = (const LAS float*)lds + (kq * 256 + 4 * hi) * 32 + e31;
    u32x2 xv[32];
#pragma unroll
    for (int m = 0; m < 32; ++m) xv[m] = *(const u32x2*)(xr + 8 * m);
#pragma unroll
    for (int m = 0; m < 32; ++m) { const f32x4 x4 = (f32x4){bflo(xv[m].x), bfhi(xv[m].x), bflo(xv[m].y), bfhi(xv[m].y)}; ss += (x4[0] * x4[0] + x4[1] * x4[1]) + (x4[2] * x4[2] + x4[3] * x4[3]);
#pragma unroll
        for (int t = 0; t < 4; ++t) acc = __builtin_amdgcn_mfma_f32_32x32x2f32(x4[t], WR[(8 * m + t) * 32], acc, 0, 0, 0); }
    ss += __shfl_xor(ss, 32);
    __syncthreads();
    LAS float* PL = (LAS float*)lds;
    LAS float* SSP = (LAS float*)(lds + 32768);
    LAS float* LG = (LAS float*)(lds + 36864);
    LAS int* SEL = (LAS int*)(lds + 49152);
#pragma unroll
    for (int r = 0; r < 16; ++r) PL[(kq * 64 + tg * 32 + crow(r, hi)) * 32 + e31] = acc[r];
    if (hi == 0) SSP[kq * 64 + tg * 32 + e31] = ss;
    __syncthreads();
#pragma unroll
    for (int j = 0; j < 4; ++j) { const int idx = tid + 512 * j, tl = idx >> 5, e = idx & 31;
        const float rstd = 1.0f / sqrtf(((SSP[tl] + SSP[64 + tl]) + (SSP[128 + tl] + SSP[192 + tl])) * (1.f / DM) + NORM_EPS);
        LG[tl * 33 + e] = rstd * ((PL[tl * 32 + e] + PL[(64 + tl) * 32 + e]) + (PL[(128 + tl) * 32 + e] + PL[(192 + tl) * 32 + e])) + inp(F, I_BROUTER)[e];
        if (e == 0) ((float*)(sm + SM_RSTD3))[tb * 64 + tl] = rstd; }
    __syncthreads();
    if (tid < 64) {
        int sel[4]; float val[4];
#pragma unroll
        for (int k = 0; k < 4; ++k) { float best = -3.0e38f; int bi = 0;
            for (int e = 0; e < 32; ++e) { const float v = LG[tid * 33 + e]; bool taken = false;
#pragma unroll
                for (int k2 = 0; k2 < 4; ++k2) if (k2 < k) taken = taken || (sel[k2] == e);
                if (!taken && v > best) { best = v; bi = e; } }
            sel[k] = bi; val[k] = best; }
        float ex[4], sum = 0.f;
#pragma unroll
        for (int k = 0; k < 4; ++k) { ex[k] = fexp2((val[k] - val[0]) * LOG2E); sum += ex[k]; }
        const float inv = 1.0f / sum; const int tk = tb * 64 + tid;
#pragma unroll
        for (int k = 0; k < 4; ++k) { ((int*)(sm + SM_TOPE))[tk * 4 + k] = sel[k]; ((float*)(sm + SM_GATE))[tk * 4 + k] = ex[k] * inv; SEL[tid * 4 + k] = sel[k]; }
    }
    __syncthreads();
    LAS int* WC = (LAS int*)(lds + 51200);
    int e_my = 0, rank_w = 0;
    if (tid < 256) { e_my = SEL[tid]; const unsigned long long lt = (1ull << lane) - 1ull;
        for (int ex = 0; ex < 32; ++ex) { const unsigned long long m = __ballot(e_my == ex); if (e_my == ex) rank_w = __popcll(m & lt); if (lane == ex) WC[wid * 32 + ex] = __popcll(m); } }
    __syncthreads();
    if (tid < 256) { int rank = rank_w; for (int w = 0; w < wid; ++w) rank += WC[w * 32 + e_my]; ((int*)(sm + SM_LRANK))[(tb * 64 + (tid >> 2)) * 4 + (tid & 3)] = rank; }
    else if (tid < 288) { const int e = tid - 256; ((int*)(sm + SM_CNT))[tb * 32 + e] = (WC[e] + WC[32 + e]) + (WC[64 + e] + WC[96 + e]); }
}

DI void route_b(Frame& F, int tb) {
    const int lane = F.lane, wid = F.wave, tid = F.tid;
    LAS int* L = (LAS int*)F.lds;
    unsigned char* sm = F.ws + WS_SMALL;
    const int* CNT = (const int*)(sm + SM_CNT);
    u32x4 xv[8][2];
#pragma unroll
    for (int j = 0; j < 8; ++j) { const u32x4* sp = (const u32x4*)((const bf16*)(F.ws + WS_XN3U) + (size_t)(tb * 64 + wid * 8 + j) * DM) + 2 * lane; xv[j][0] = sp[0]; xv[j][1] = sp[1]; }
    __syncthreads();
    { const int e = tid & 31, seg = tid >> 5; int t = 0, p = 0;
      for (int w = seg * 16; w < seg * 16 + 16; ++w) { const int c = CNT[w * 32 + e]; t += c; p += (w < tb) ? c : 0; }
      L[seg * 32 + e] = t; L[512 + seg * 32 + e] = p; }
    __syncthreads();
    if (tid < 32) { int t = 0, p = 0; for (int s = 0; s < 16; ++s) { t += L[s * 32 + tid]; p += L[512 + s * 32 + tid]; } L[1024 + tid] = t; L[1056 + tid] = p; }
    __syncthreads();
    if (tid == 0) { int run = 0; for (int e = 0; e < 32; ++e) { L[1088 + e] = run; run += ((L[1024 + e] + 255) >> 8) << 8; } L[1120] = run >> 8; }
    __syncthreads();
    if (tid < 256) { const int tok = tb * 64 + (tid >> 2), a = tok * 4 + (tid & 3); const int e = ((const int*)(sm + SM_TOPE))[a];
        const int row = L[1088 + e] + L[1056 + e] + ((const int*)(sm + SM_LRANK))[a];
        ((int*)(sm + SM_AROW))[a] = row; ((float*)(sm + SM_RSCALE))[row] = ((const float*)(sm + SM_RSTD3))[tok]; ((float*)(sm + SM_RGATE))[row] = ((const float*)(sm + SM_GATE))[a]; L[1152 + tid] = row; }
    if (tb == 0 && tid >= 256 && tid < 288) { const int e = tid - 256, nb = (L[1024 + e] + 255) >> 8, b0 = L[1088 + e] >> 8; int* BLKE = (int*)(sm + SM_BLKE);
        for (int i = 0; i < nb; ++i) BLKE[b0 + i] = e; if (e == 0) BLKE[MAXBLK] = L[1120]; }
    __syncthreads();
    unsigned char* XG = F.ws + WS_XG;
    f32x4 gm[4];
#pragma unroll
    for (int k = 0; k < 4; ++k) gm[k] = *((const f32x4*)inp(F, I_GMOE) + 4 * lane + k);
#pragma unroll
    for (int j = 0; j < 8; ++j) { const u32x4 v0 = xv[j][0], v1 = xv[j][1]; u32x4 o;
        o.x = cvt4_fp8(bflo(v0.x) * gm[0][0], bfhi(v0.x) * gm[0][1], bflo(v0.y) * gm[0][2], bfhi(v0.y) * gm[0][3]); o.y = cvt4_fp8(bflo(v0.z) * gm[1][0], bfhi(v0.z) * gm[1][1], bflo(v0.w) * gm[1][2], bfhi(v0.w) * gm[1][3]);
        o.z = cvt4_fp8(bflo(v1.x) * gm[2][0], bfhi(v1.x) * gm[2][1], bflo(v1.y) * gm[2][2], bfhi(v1.y) * gm[2][3]); o.w = cvt4_fp8(bflo(v1.z) * gm[3][0], bfhi(v1.z) * gm[3][1], bflo(v1.w) * gm[3][2], bfhi(v1.w) * gm[3][3]);
#pragma unroll
        for (int k = 0; k < 4; ++k) *((u32x4*)(XG + (size_t)L[1152 + (wid * 8 + j) * 4 + k] * DM) + lane) = o; }
}

DI void combine_final(Frame& F) {
    const int gw = F.bid * NWAVES + F.wave, NGW = F.G * NWAVES, lane = F.lane;
    const bf16* x2 = (const bf16*)(F.ws + WS_XN3U); const bf16* Y = (const bf16*)(F.ws + WS_YROWS); const int* AROW = (const int*)(F.ws + WS_SMALL + SM_AROW);
    const f32x4* gf = (const f32x4*)inp(F, I_GFINAL) + lane;
    for (int tok = gw; tok < T; tok += NGW) {
        const u32x2* xr = (const u32x2*)(x2 + (size_t)tok * DM) + lane; f32x4 v[4];
#pragma unroll
        for (int j = 0; j < 4; ++j) { const u32x2 w = xr[64 * j]; v[j] = (f32x4){bflo(w.x), bfhi(w.x), bflo(w.y), bfhi(w.y)}; }
#pragma unroll
        for (int k = 0; k < 4; ++k) { const int row = AROW[tok * 4 + k]; const u32x2* yr = (const u32x2*)(Y + (size_t)row * DM) + lane;
#pragma unroll
            for (int j = 0; j < 4; ++j) { const u32x2 w = yr[64 * j]; v[j] += (f32x4){bflo(w.x), bfhi(w.x), bflo(w.y), bfhi(w.y)}; } }
        float s = 0.f;
#pragma unroll
        for (int j = 0; j < 4; ++j) s += (v[j][0] * v[j][0] + v[j][1] * v[j][1]) + (v[j][2] * v[j][2] + v[j][3] * v[j][3]);
        const float rstd = 1.0f / sqrtf(wave_sum(s) * (1.f / DM) + NORM_EPS);
        f32x4* o = (f32x4*)(F.out + (size_t)tok * DM) + lane;
#pragma unroll
        for (int j = 0; j < 4; ++j) o[64 * j] = v[j] * rstd * gf[64 * j];
    }
}

constexpr int NPHASE = 14;
#ifndef WGM_P1
#define WGM_P1 2
#endif
#ifndef WGM_MOE
#define WGM_MOE 4
#endif
__global__ void __launch_bounds__(NWAVES * 64, 2) mega_fwd(Args args) {
    extern __shared__ __attribute__((aligned(16))) unsigned char lds_raw[];
    Frame F;
    F.lds = (LAS unsigned char*)lds_raw; F.ws = args.ws; F.out = args.out;
    F.tid = threadIdx.x; F.lane = F.tid & 63; F.wave = __builtin_amdgcn_readfirstlane(F.tid >> 6); F.G = gridDim.x; F.bid = blockIdx.x;
    F.kp = (kptr_t)__builtin_amdgcn_kernarg_segment_ptr();
    if (F.tid < 64) ((LAS unsigned*)(F.lds + LDSCTL_OFF))[F.tid] = 0u;
    __syncthreads();
    const int lo = args.ph_lo, hi = args.ph_hi;
    XcdBarrier bar; bar.bar = (unsigned*)(F.ws + WS_CTL) + CW_BAR; bar.x = 0; bar.st = nullptr;
    if (hi - lo > 1) bar = xcd_barrier_post((unsigned*)(F.ws + WS_CTL) + CW_BAR, (volatile LAS unsigned*)(F.lds + LDSCTL_OFF) + 8);
#ifndef PHASE_MASK
#define PHASE_MASK 0xFFFF
#endif
#define IN(k) (((PHASE_MASK >> (k)) & 1) && lo <= (k) && (k) < hi)
#ifndef PROBE_MASK
#define PROBE_MASK 0
#endif
#define REP(k) (((PROBE_MASK >> (k)) & 1) ? 2 : 1)
#define LAUNDER() do { asm volatile("" : "+s"(F.kp), "+s"(F.ws), "+s"(F.out), "+v"(F.tid), "+s"(F.bid), "+s"(F.G)); F.lane = F.tid & 63; F.wave = __builtin_amdgcn_readfirstlane(F.tid >> 6); ws = F.ws; } while (0)
#define PHASE(k, ...) do { if (IN(k)) { __VA_ARGS__ if (REP(k) == 2) { xcd_barrier(bar); LAUNDER(); __VA_ARGS__ } } } while (0)
#ifdef DOUBLE_BAR
#define SEAM(k) do { if (IN(k) && IN((k) + 1)) { xcd_barrier(bar); xcd_barrier(bar); } LAUNDER(); } while (0)
#else
#define SEAM(k) do { if (IN(k) && IN((k) + 1)) xcd_barrier(bar); LAUNDER(); } while (0)
#endif
    unsigned char* ws = F.ws;
    LAS unsigned char* ring = F.lds + RING_OFF;

    PHASE(0, { p0_prologue(F); }); SEAM(0);

    PHASE(1, {
        const bool conv_first = ((F.bid >> 3) & 1) != 0;
        if (conv_first) { p0_experts(F, F.bid * NWAVES + F.wave, F.G * NWAVES); __syncthreads(); }
        pg8::Sched2 S{(const bf16*)(ws + WS_XN1), (const bf16*)(ws + WS_WIN), T / 256, NPROJ / 256, (const bf16*)(ws + WS_MEMN), (const bf16*)(ws + WS_WCKV), (BATCH * MEML) / 256, 2048 / 256, F.G, F.bid, 1024, WGM_P1};
        Epi1 E{(bf16*)(ws + WS_PROJ), (bf16*)(ws + WS_KVMEM)};
        pg8::gemm_phase(ring, 1024, S, E);
        if (!conv_first) { p0_experts(F, F.bid * NWAVES + F.wave, F.G * NWAVES); }
    }); SEAM(1);

    PHASE(2, {
        for (int L = F.bid; L < 512 + 192; L += F.G) {
            if (L < 512) sb_unit(F, L >> 6, (L >> 3) & 7, L & 7);
            else { const int q = L - 512; rt_unit(F, (q / 3) >> 3, (q / 3) & 7, q % 3); }
        }
    }); SEAM(2);

    PHASE(3, { for (int L = F.bid; L < 256; L += F.G) ro_unit(F, L >> 5, (L >> 2) & 7, L & 3); }); SEAM(3);

    PHASE(4, {
        { pg8::Sched2 S{(const bf16*)(ws + WS_YSB), (const bf16*)(ws + WS_WSBO), T / 256, 4, nullptr, nullptr, 0, 1, F.G, F.bid, 512};
          Epi5a E{(const bf16*)(ws + WS_PROJ), (bf16*)(ws + WS_TMP)}; pg8::gemm_phase(ring, 512, S, E); }
        { pg8::Sched2 S{(const bf16*)(ws + WS_YRET), (const bf16*)(ws + WS_WRETO), T / 256, 4, nullptr, nullptr, 0, 1, F.G, F.bid, 1024};
          Epi5b E{(const bf16*)(ws + WS_PROJ), (const bf16*)(ws + WS_TMP), (bf16*)(ws + WS_MERGED)}; pg8::gemm_phase(ring, 1024, S, E); }
    }); SEAM(4);

    PHASE(5, {
        pg8::Sched2 S{(const bf16*)(ws + WS_MERGED), (const bf16*)(ws + WS_WMIX), T / 256, 4, nullptr, nullptr, 0, 1, F.G, F.bid, 1024};
        EpiRes<true> E{inp(F, I_X), (bf16*)(ws + WS_XN2U), (float*)(ws + WS_SLOTS)}; pg8::gemm_phase(ring, 1024, S, E);
    }); SEAM(5);

    PHASE(6, {
        pg8::Sched2 S{(const bf16*)(ws + WS_XN2U), (const bf16*)(ws + WS_WCQ), T / 256, 4, nullptr, nullptr, 0, 1, F.G, F.bid, 1024};
        Epi7 E{(const float*)(ws + WS_SLOTS), (bf16*)(ws + WS_QX)}; pg8::gemm_phase(ring, 1024, S, E);
    }); LAUNDER();

    PHASE(7, { for (int L = F.bid; L < 256; L += F.G) { int pm_, pn_; pg8::map_unit(L, 256, 64, 4, pm_, pn_); xa_unit(F, pm_ >> 3, pn_, pm_ & 7); } }); SEAM(7);

    PHASE(8, {
        pg8::Sched2 S{(const bf16*)(ws + WS_OX), (const bf16*)(ws + WS_WCO), T / 256, 4, nullptr, nullptr, 0, 1, F.G, F.bid, 1024};
        EpiRes<false> E{(const void*)(ws + WS_XN2U), (bf16*)(ws + WS_XN3U), nullptr}; pg8::gemm_phase(ring, 1024, S, E);
    }); SEAM(8);

    PHASE(9, { for (int tb = F.bid; tb < T / 64; tb += F.G) route_a(F, tb); }); SEAM(9);
    PHASE(10, { for (int tb = F.bid; tb < T / 64; tb += F.G) route_b(F, tb); }); SEAM(10);

    PHASE(11, {
        const int* BLKE = (const int*)(ws + WS_SMALL + SM_BLKE); const int nblk = __builtin_amdgcn_readfirstlane(__hip_atomic_load(BLKE + MAXBLK, RLX_AGENT));
        pg8::SchedMoE S{ws + WS_XG, ws + WS_WE1, BLKE, nblk, 8, F.G, F.bid, 1024, (size_t)2048 * 1024, WGM_MOE};
        Epi12 E{(const float*)(ws + WS_SMALL + SM_RSCALE), inp(F, I_BE1), ws + WS_ACT}; pg8::gemm_phase(ring, 1024, S, E);
    }); SEAM(11);

    PHASE(12, {
        const int* BLKE = (const int*)(ws + WS_SMALL + SM_BLKE); const int nblk = __builtin_amdgcn_readfirstlane(__hip_atomic_load(BLKE + MAXBLK, RLX_AGENT));
        pg8::SchedMoE S{ws + WS_ACT, ws + WS_WE2, BLKE, nblk, 4, F.G, F.bid, 1024, (size_t)1024 * 1024, WGM_MOE};
        Epi13 E{(const float*)(ws + WS_SMALL + SM_RGATE), inp(F, I_BE2), (bf16*)(ws + WS_YROWS)}; pg8::gemm_phase(ring, 1024, S, E);
    }); SEAM(12);

    PHASE(13, { combine_final(F); });
#undef IN
#undef SEAM
}

#if MK_DEBUG
DI unsigned hsh(unsigned x) { x ^= x >> 16; x *= 0x7feb352du; x ^= x >> 15; x *= 0x846ca68bu; x ^= x >> 16; return x; }
DI void chk_report(unsigned char* ws, int phase, float got, float ref, float atol) {
    float e = fabsf(got - ref) / (fabsf(ref) + atol); if (!(e == e)) e = 1.0e9f; if (e > 1.0e9f) e = 1.0e9f;
    atomicMax((unsigned*)(ws + WS_CTL) + CW_CHK + phase, __float_as_uint(e));
}
DI float dbg_bf(const bf16* p, size_t i) { return bf2f(p[i]); }
DI float dbg_f8(const unsigned char* p, size_t i) { const unsigned b = p[i]; const int e = (b >> 3) & 15, m = b & 7; const float v = e ? (1.0f + m * 0.125f) * exp2f((float)(e - 7)) : m * 0.125f * 0.015625f; return (b & 128) ? -v : v; }
DI float dbg_sigm(float x) { return 1.0f / (1.0f + expf(-x)); }
DI float dbg_rope(const float* rope, int pos, int i, bool sn) { return rope[(sn ? SEQ * 32 : 0) + pos * 32 + i]; }
DI float dbg_rot(const bf16* row, const float* rope, int pos, int d) {
    const int i = d & 31; const float x1 = bf2f(row[i]), x2 = bf2f(row[32 + i]); const float c = dbg_rope(rope, pos, i, false), s = dbg_rope(rope, pos, i, true);
    return d < 32 ? x1 * c - x2 * s : x1 * s + x2 * c;
}
__global__ void __launch_bounds__(64) dbg_kernel(Args a, int phase) {
    const unsigned sid = blockIdx.x * 64 + threadIdx.x; unsigned char* ws = a.ws;
    const unsigned r0 = hsh(sid * 4 + 1 + phase * 7919), r1 = hsh(sid * 4 + 2 + phase * 104729), r2 = hsh(sid * 4 + 3 + phase * 31), r3 = hsh(sid * 4 + 4 + phase * 17);
    const float* rope = (const float*)(ws + WS_ROPE);
    const bf16* PROJ = (const bf16*)(ws + WS_PROJ);
    if (phase == 0) {
        const int which = sid % 12;
        if (which == 7 || which == 8) {   } else if (which < 9) {
            const float* W; const bf16* WT; int K, N; int e = 0;
            switch (which) { case 0: W = a.in[I_WIN]; WT = (const bf16*)(ws + WS_WIN); K = 1024; N = NPROJ; break; case 1: W = a.in[I_WSBO]; WT = (const bf16*)(ws + WS_WSBO); K = 512; N = 1024; break;
                case 2: W = a.in[I_WRETO]; WT = (const bf16*)(ws + WS_WRETO); K = 1024; N = 1024; break; case 3: W = a.in[I_WMIX]; WT = (const bf16*)(ws + WS_WMIX); K = 1024; N = 1024; break;
                case 4: W = a.in[I_WCQ]; WT = (const bf16*)(ws + WS_WCQ); K = 1024; N = 1024; break; case 5: W = a.in[I_WCKV]; WT = (const bf16*)(ws + WS_WCKV); K = 1024; N = 2048; break;
                case 6: W = a.in[I_WCO]; WT = (const bf16*)(ws + WS_WCO); K = 1024; N = 1024; break;
                case 7: e = r2 % 32; W = a.in[I_WE1] + (size_t)e * 1024 * 2048; WT = (const bf16*)(ws + WS_WE1 + (size_t)e * 2048 * 1024); K = 1024; N = 2048; break;
                default: e = r2 % 32; W = a.in[I_WE2] + (size_t)e * 1024 * 1024; WT = (const bf16*)(ws + WS_WE2 + (size_t)e * 1024 * 1024); K = 1024; N = 1024; break; }
            const int k = r0 % K, n = r1 % N; int nr = n; if (which == 7) nr = n < 1024 ? 256 * (n >> 7) + (n & 127) : 256 * ((n - 1024) >> 7) + 128 + ((n - 1024) & 127);
            if (which >= 7) chk_report(ws, 0, dbg_f8((const unsigned char*)WT, (size_t)nr * K + k), W[(size_t)k * N + n] * 64.0f, 0.5f);
            else { const float ref = bf2f((bf16)(cvtpk(W[(size_t)k * N + n], 0.f) & 0xffffu)); chk_report(ws, 0, dbg_bf(WT, (size_t)nr * K + k), ref, 1e-6f); }
        } else if (which < 11) {
            const bool isx = which == 9; const int row = isx ? r0 % T : r0 % (BATCH * MEML), col = r1 % DM;
            const float* xr = (isx ? a.in[I_X] : a.in[I_MEM]) + (size_t)row * DM; double ss = 0; for (int k = 0; k < DM; ++k) ss += (double)xr[k] * xr[k];
            const float ref = xr[col] * (float)(1.0 / sqrt(ss / DM + 1e-5)) * (isx ? a.in[I_GMIX] : a.in[I_GMEM])[col];
            chk_report(ws, 0, dbg_bf((const bf16*)(ws + (isx ? WS_XN1 : WS_MEMN)), (size_t)row * DM + col), ref, 0.5f);
        } else { const int pos = r0 % SEQ, i = r1 % 32; const double inv = exp2(-(double)i * 13.287712379549449 / 32.0); const float angf = (float)pos * (float)inv; double an = (double)angf; an -= 6.283185307179586 * rint(an / 6.283185307179586);
            const float rev = (float)(an / 6.283185307179586); chk_report(ws, 0, dbg_rope(rope, pos, i, false), __builtin_amdgcn_cosf(rev), 0.5f); chk_report(ws, 0, dbg_rope(rope, pos, i, true), __builtin_amdgcn_sinf(rev), 0.5f); }
    } else if (phase == 1) {
        if (sid % 3 == 2) {
            const int e = r2 % 32; const bool w1 = (sid & 4) != 0; const int K = 1024, N = w1 ? 2048 : 1024; const float* W = (w1 ? a.in[I_WE1] : a.in[I_WE2]) + (size_t)e * K * N; const unsigned char* WT = ws + (w1 ? WS_WE1 : WS_WE2) + (size_t)e * N * K;
            const int k = r0 % K, n = r1 % N; int nr = n; if (w1) nr = n < 1024 ? 256 * (n >> 7) + (n & 127) : 256 * ((n - 1024) >> 7) + 128 + ((n - 1024) & 127);
            chk_report(ws, 1, dbg_f8(WT, (size_t)nr * K + k), W[(size_t)k * N + n] * 64.0f, 0.5f);
        } else if (sid & 1) { const int row = r0 % T, col = r1 % NPROJ; const bf16* xr = (const bf16*)(ws + WS_XN1) + (size_t)row * DM; const float* W = a.in[I_WIN]; double s = 0; for (int k = 0; k < DM; ++k) s += (double)bf2f(xr[k]) * W[(size_t)k * NPROJ + col];
            const float sc = col < 512 ? SBQ_SCALE : ((col >= C_RK && col < C_RV) ? 0.125f : 1.0f); chk_report(ws, 1, dbg_bf(PROJ, (size_t)row * NPROJ + col), (float)s * sc, sc); }
        else { const int row = r0 % (BATCH * MEML), col = r1 % 2048; const bf16* xr = (const bf16*)(ws + WS_MEMN) + (size_t)row * DM; const float* W = a.in[I_WCKV]; double s = 0; for (int k = 0; k < DM; ++k) s += (double)bf2f(xr[k]) * W[(size_t)k * 2048 + col];
            chk_report(ws, 1, dbg_bf((const bf16*)(ws + WS_KVMEM), (size_t)row * 2048 + col), (float)s, 1.0f); }
    } else if (phase == 2) {
        if (sid & 1) {
            const int b = r0 % BATCH, h = r1 % 8, t = (sid & 2) ? r2 % SEQ : r2 % 300, d = r3 % 64; const bf16* Pb = PROJ + (size_t)b * SEQ * NPROJ; const bf16* qrow = Pb + (size_t)t * NPROJ + C_SBQ + h * 64;
            double o = 0, between = 0;
            for (int s = t - 1; s >= 0; --s) { const bf16* krow = Pb + (size_t)s * NPROJ + C_SBK + h * 64; double zl = 0; for (int k = 0; k < 64; ++k) zl += (double)bf2f(qrow[k]) * bf2f(krow[k]);
                const double z = zl / 1.4426950408889634; const double lsp = z > 0 ? z + log1p(exp(-z)) : log1p(exp(z));
                const double w = exp(z - lsp + between); between -= lsp; o += w * bf2f(Pb[(size_t)s * NPROJ + C_SBV + h * 64 + d]); if (between < -200.0) break; }
            chk_report(ws, 2, dbg_bf((const bf16*)(ws + WS_YSB), (size_t)(b * SEQ + t) * 512 + h * 64 + d), (float)o, 0.5f);
        } else {
            const int b = r0 % BATCH, h = r1 % 8, g = r2 % 3, dk = r3 % 64, dv = (r3 >> 8) % 128; const double gam = 1.0 - exp2(-5.0 - h); double s = 0;
            for (int p = 0; p < 512; ++p) { const int pos = g * 512 + p; const bf16* row = PROJ + (size_t)(b * SEQ + pos) * NPROJ; s += pow(gam, 511 - p) * dbg_rot(row + C_RK + h * 64, rope, pos, dk) * bf2f(row[C_RV + h * 128 + dv]); }
            chk_report(ws, 2, ((const float*)(ws + WS_GTOT))[(size_t)((b * 8 + h) * 4 + g) * 8192 + dk * 128 + dv], (float)s, 0.5f);
        }
    } else if (phase == 3) {
        const int b = r0 % BATCH, h = r1 % 8, t = (sid & 1) ? r2 % SEQ : r2 % 200; const double gam = 1.0 - exp2(-5.0 - h); const bf16* Pb = PROJ + (size_t)b * SEQ * NPROJ;
        float q[64];
#pragma unroll
        for (int d = 0; d < 64; ++d) q[d] = dbg_rot(Pb + (size_t)t * NPROJ + C_RQ + h * 64, rope, t, d);
        float o[128];
#pragma unroll
        for (int e = 0; e < 128; ++e) o[e] = 0.f;
        for (int s = 0; s <= t; ++s) { const bf16* row = Pb + (size_t)s * NPROJ; float dot = 0.f;
#pragma unroll
            for (int d = 0; d < 64; ++d) dot += q[d] * dbg_rot(row + C_RK + h * 64, rope, s, d);
            const float w = dot * (float)pow(gam, t - s);
#pragma unroll
            for (int e = 0; e < 128; ++e) o[e] += w * bf2f(row[C_RV + h * 128 + e]); }
        float mu = 0.f;
#pragma unroll
        for (int e = 0; e < 128; ++e) mu += o[e];
        mu *= (1.f / 128.f); float var = 0.f;
#pragma unroll
        for (int e = 0; e < 128; ++e) var += (o[e] - mu) * (o[e] - mu);
        const float rstd = 1.0f / sqrtf(var * (1.f / 128.f) + 1e-5f);
#pragma unroll
        for (int e = 0; e < 128; ++e) { const float gv = bf2f(Pb[(size_t)t * NPROJ + C_RG + h * 128 + e]); chk_report(ws, 3, dbg_bf((const bf16*)(ws + WS_YRET), (size_t)(b * SEQ + t) * DM + h * 128 + e), gv * dbg_sigm(gv) * (o[e] - mu) * rstd, 1.0f); }
    } else if (phase == 4) {
        const int row = r0 % T, col = r1 % DM; const bf16* ys = (const bf16*)(ws + WS_YSB) + (size_t)row * 512; const bf16* yr = (const bf16*)(ws + WS_YRET) + (size_t)row * DM; double s1 = 0, s2 = 0;
        for (int k = 0; k < 512; ++k) s1 += (double)bf2f(ys[k]) * a.in[I_WSBO][(size_t)k * DM + col]; for (int k = 0; k < DM; ++k) s2 += (double)bf2f(yr[k]) * a.in[I_WRETO][(size_t)k * DM + col];
        const float ref = dbg_sigm(bf2f(PROJ[(size_t)row * NPROJ + C_GSB + col])) * (float)s1 + dbg_sigm(bf2f(PROJ[(size_t)row * NPROJ + C_GRET + col])) * (float)s2;
        chk_report(ws, 4, dbg_bf((const bf16*)(ws + WS_MERGED), (size_t)row * DM + col), ref, 0.5f);
    } else if (phase == 5 || phase == 8) {
        const bool p5 = phase == 5; const int row = r0 % T, col = r1 % DM; const bf16* ar = (const bf16*)(ws + (p5 ? WS_MERGED : WS_OX)) + (size_t)row * DM; const float* W = p5 ? a.in[I_WMIX] : a.in[I_WCO];
        double s = 0; for (int k = 0; k < DM; ++k) s += (double)bf2f(ar[k]) * W[(size_t)k * DM + col];
        const float xi = p5 ? a.in[I_X][(size_t)row * DM + col] : dbg_bf((const bf16*)(ws + WS_XN2U), (size_t)row * DM + col); const float ref = xi + (float)s; const float got = dbg_bf((const bf16*)(ws + (p5 ? WS_XN2U : WS_XN3U)), (size_t)row * DM + col);
        chk_report(ws, phase, got, ref, 1.0f);
        if (p5) { const bf16* xr = (const bf16*)(ws + WS_XN2U) + (size_t)row * DM; double ss = 0; for (int k = 0; k < DM; ++k) ss += (double)bf2f(xr[k]) * bf2f(xr[k]); float sl = 0; for (int k = 0; k < 16; ++k) sl += ((const float*)(ws + WS_SLOTS))[(size_t)row * 16 + k]; chk_report(ws, 5, sl, (float)ss, 100.0f); }
    } else if (phase == 6) {
        const int row = r0 % T, col = r1 % DM; const bf16* ar = (const bf16*)(ws + WS_XN2U) + (size_t)row * DM; double s = 0, ss = 0; for (int k = 0; k < DM; ++k) { const double x = bf2f(ar[k]); s += x * a.in[I_GXATTN][k] * a.in[I_WCQ][(size_t)k * DM + col]; ss += x * x; }
        chk_report(ws, 6, dbg_bf((const bf16*)(ws + WS_QX), (size_t)row * DM + col), (float)(s / sqrt(ss / DM + 1e-5)) * XQ_SCALE, XQ_SCALE);
    } else if (phase == 7) {
        const int b = r0 % BATCH, t = r1 % SEQ, hx = r2 % 4, d = r3 % 256; const bf16* qrow = (const bf16*)(ws + WS_QX) + (size_t)(b * SEQ + t) * DM + hx * 256; const bf16* KV = (const bf16*)(ws + WS_KVMEM) + (size_t)(b * MEML) * 2048;
        double mx = -1e30; for (int m = 0; m < MEML; ++m) { double z = 0; for (int k = 0; k < 256; ++k) z += (double)bf2f(qrow[k]) * bf2f(KV[(size_t)m * 2048 + hx * 256 + k]); if (z > mx) mx = z; }
        double l = 0, o = 0; for (int m = 0; m < MEML; ++m) { double z = 0; for (int k = 0; k < 256; ++k) z += (double)bf2f(qrow[k]) * bf2f(KV[(size_t)m * 2048 + hx * 256 + k]); const double p = exp2(z - mx); l += p; o += p * bf2f(KV[(size_t)m * 2048 + 1024 + hx * 256 + d]); }
        chk_report(ws, 7, dbg_bf((const bf16*)(ws + WS_OX), (size_t)(b * SEQ + t) * DM + hx * 256 + d), (float)(o / l), 0.1f);
    } else if (phase == 9) {
        const int tok = r0 % T; const bf16* xr = (const bf16*)(ws + WS_XN3U) + (size_t)tok * DM; double ss = 0; for (int k = 0; k < DM; ++k) ss += (double)bf2f(xr[k]) * bf2f(xr[k]); const double rstd = 1.0 / sqrt(ss / DM + 1e-5);
        chk_report(ws, 9, ((const float*)(ws + WS_SMALL + SM_RSTD3))[tok], (float)rstd, 1e-3f);
        double v0 = -1e30, v1 = -1e30, v2 = -1e30, v3 = -1e30, v4 = -1e30; int i0 = -1, i1 = -1, i2 = -1, i3 = -1;
        for (int e = 0; e < 32; ++e) { double s = 0; for (int k = 0; k < DM; ++k) s += (double)bf2f(xr[k]) * a.in[I_GMOE][k] * a.in[I_WROUTER][k * 32 + e]; s = s * rstd + a.in[I_BROUTER][e];
            if (s > v0) { v4 = v3; v3 = v2; i3 = i2; v2 = v1; i2 = i1; v1 = v0; i1 = i0; v0 = s; i0 = e; } else if (s > v1) { v4 = v3; v3 = v2; i3 = i2; v2 = v1; i2 = i1; v1 = s; i1 = e; }
            else if (s > v2) { v4 = v3; v3 = v2; i3 = i2; v2 = s; i2 = e; } else if (s > v3) { v4 = v3; v3 = s; i3 = e; } else if (s > v4) v4 = s; }
        const int* te = (const int*)(ws + WS_SMALL + SM_TOPE) + tok * 4; const float* tg = (const float*)(ws + WS_SMALL + SM_GATE) + tok * 4;
        const bool close = (v0 - v1 < 1e-4) || (v1 - v2 < 1e-4) || (v2 - v3 < 1e-4) || (v3 - v4 < 1e-4);
        if (!close) { chk_report(ws, 9, (te[0] == i0 && te[1] == i1 && te[2] == i2 && te[3] == i3) ? 0.f : 1.f, 0.f, 1.0f);
            const double e1 = exp(v1 - v0), e2 = exp(v2 - v0), e3 = exp(v3 - v0), sm = 1.0 + e1 + e2 + e3; chk_report(ws, 9, tg[0], (float)(1.0 / sm), 0.01f); chk_report(ws, 9, tg[3], (float)(e3 / sm), 0.01f); }
    } else if (phase == 10) {
        const int tok = r0 % T, k = r1 % 4, col = r2 % DM; const int row = ((const int*)(ws + WS_SMALL + SM_AROW))[tok * 4 + k], e = ((const int*)(ws + WS_SMALL + SM_TOPE))[tok * 4 + k]; const int* BLKE = (const int*)(ws + WS_SMALL + SM_BLKE);
        const bool okr = row >= 0 && row < BLKE[MAXBLK] * 256; chk_report(ws, 10, okr ? 0.f : 1.f, 0.f, 1.0f);
        if (okr) { chk_report(ws, 10, BLKE[row >> 8] == e ? 0.f : 1.f, 0.f, 1.0f); chk_report(ws, 10, dbg_f8(ws + WS_XG, (size_t)row * DM + col), dbg_bf((const bf16*)(ws + WS_XN3U), (size_t)tok * DM + col) * a.in[I_GMOE][col], 0.5f);
            chk_report(ws, 10, ((const float*)(ws + WS_SMALL + SM_RSCALE))[row], ((const float*)(ws + WS_SMALL + SM_RSTD3))[tok], 1e-6f); chk_report(ws, 10, ((const float*)(ws + WS_SMALL + SM_RGATE))[row], ((const float*)(ws + WS_SMALL + SM_GATE))[tok * 4 + k], 1e-6f);
 }
    } else if (phase == 11) {
        const int tok = r0 % T, k = r1 % 4, col = r2 % DFF; const int row = ((const int*)(ws + WS_SMALL + SM_AROW))[tok * 4 + k], e = ((const int*)(ws + WS_SMALL + SM_TOPE))[tok * 4 + k];
        const unsigned char* xr = ws + WS_XG + (size_t)row * DM; const unsigned char* W = ws + WS_WE1 + (size_t)e * 2048 * 1024; const int rg = 256 * (col >> 7) + (col & 127), rl = rg + 128; double sg = 0, sl = 0;
        for (int kk = 0; kk < DM; ++kk) { const double x = dbg_f8(xr, kk); sg += x * dbg_f8(W, (size_t)rg * 1024 + kk); sl += x * dbg_f8(W, (size_t)rl * 1024 + kk); }
        sg *= (1.0 / 64.0); sl *= (1.0 / 64.0);
        const float rs = ((const float*)(ws + WS_SMALL + SM_RSTD3))[tok]; float gl = (float)sg * rs + a.in[I_BE1][e * 2048 + col], li = (float)sl * rs + a.in[I_BE1][e * 2048 + 1024 + col]; gl = fminf(gl, 7.f); li = fminf(fmaxf(li, -7.f), 7.f);
        chk_report(ws, 11, dbg_f8(ws + WS_ACT, (size_t)row * DFF + col), gl * dbg_sigm(1.702f * gl) * (li + 1.0f), 0.5f);
    } else if (phase == 12) {
        const int tok = r0 % T, k = r1 % 4, col = r2 % DM; const int row = ((const int*)(ws + WS_SMALL + SM_AROW))[tok * 4 + k], e = ((const int*)(ws + WS_SMALL + SM_TOPE))[tok * 4 + k];
        const unsigned char* ar = ws + WS_ACT + (size_t)row * DFF; const unsigned char* W = ws + WS_WE2 + (size_t)e * 1024 * 1024; double s = 0; for (int kk = 0; kk < DFF; ++kk) s += (double)dbg_f8(ar, kk) * dbg_f8(W, (size_t)col * 1024 + kk);
        s *= (1.0 / 64.0);
        chk_report(ws, 12, dbg_bf((const bf16*)(ws + WS_YROWS), (size_t)row * DM + col), ((float)s + a.in[I_BE2][e * 1024 + col]) * ((const float*)(ws + WS_SMALL + SM_GATE))[tok * 4 + k], 0.1f);
    }
}
__global__ void dbg_rows_a(Args a) { const int i = blockIdx.x * 256 + threadIdx.x; if (i < T * 4) atomicAdd((int*)(a.ws + WS_E + 64 * MB) + ((const int*)(a.ws + WS_SMALL + SM_AROW))[i], 1); }
__global__ void dbg_rows_b(Args a) { const int i = blockIdx.x * 256 + threadIdx.x; if (i < PROWS) { const int c = ((const int*)(a.ws + WS_E + 64 * MB))[i]; if (c > 1) atomicMax((unsigned*)(a.ws + WS_CTL) + CW_CHK + 10, __float_as_uint(100.0f + c)); } }
__global__ void dbg_verdict(Args a) {
    const unsigned* chk = (const unsigned*)(a.ws + WS_CTL) + CW_CHK; int code = 0;
    for (int p = 0; p < NPHASE; ++p) if (code == 0 && __uint_as_float(chk[p]) > 0.08f) code = p + 1;
    if (code) { const float sc = 1.0f + (float)code; for (size_t i = (size_t)blockIdx.x * 256 + threadIdx.x; i < (size_t)T * DM; i += (size_t)gridDim.x * 256) a.out[i] *= sc; }
}
static void dbg_check(int p, const Args& a, hipStream_t stream) {
    if (p == 13) { hipLaunchKernelGGL(dbg_verdict, dim3(1024), dim3(256), 0, stream, a); return; }
    if (p == 10) { (void)hipMemsetAsync(a.ws + WS_E + 64 * MB, 0, (size_t)PROWS * 4, stream); hipLaunchKernelGGL(dbg_rows_a, dim3(T * 4 / 256), dim3(256), 0, stream, a); hipLaunchKernelGGL(dbg_rows_b, dim3(PROWS / 256), dim3(256), 0, stream, a); }
    hipLaunchKernelGGL(dbg_kernel, dim3(p == 3 ? 2 : 16), dim3(64), 0, stream, a, p);
}
#endif

extern "C" void kernel_launch(void* const* d_in, const int* in_sizes, int n_in, void* d_out, int out_size, void* d_ws, size_t ws_size, hipStream_t stream) {
    static int grid = 0;
    if (grid == 0) {
        if (n_in != 20 || in_sizes[0] != T * DM || out_size != T * DM || ws_size < WS_END) { fprintf(stderr, "kernel_launch: unexpected problem shape (n_in %d, in0 %d, out %d, ws %zu < %zu)\n", n_in, n_in > 0 ? in_sizes[0] : -1, out_size, ws_size, (size_t)WS_END); grid = -1; return; }
        int dev = 0, cus = 0;
        if (hipGetDevice(&dev) != hipSuccess || hipDeviceGetAttribute(&cus, hipDeviceAttributeMultiprocessorCount, dev) != hipSuccess) { grid = -1; return; }
        if (hipFuncSetAttribute((const void*)mega_fwd, hipFuncAttributeMaxDynamicSharedMemorySize, LDS_BYTES) != hipSuccess) { fprintf(stderr, "kernel_launch: hipFuncSetAttribute failed\n"); grid = -1; return; }
        grid = cus;
    }
    if (grid < 0) return;
    (void)hipMemsetAsync((char*)d_ws + WS_CTL, 0, CTL_BYTES, stream);
    Args a{};
    for (int i = 0; i < 20; ++i) a.in[i] = (const float*)d_in[i];
    a.out = (float*)d_out; a.ws = (unsigned char*)d_ws;
#if MK_DEBUG
    for (int p = 0; p < NPHASE; ++p) { a.ph_lo = p; a.ph_hi = p + 1; hipLaunchKernelGGL(mega_fwd, dim3(grid), dim3(NWAVES * 64), LDS_BYTES, stream, a); dbg_check(p, a, stream); }
#else
    a.ph_lo = 0; a.ph_hi = NPHASE;
    hipLaunchKernelGGL(mega_fwd, dim3(grid), dim3(NWAVES * 64), LDS_BYTES, stream, a);
#endif
}
```

```cpp
#include <hip/hip_runtime.h>
#include <cstdio>
#include <cstdint>

#ifndef MK_DEBUG
#define MK_DEBUG 0
#endif

#define LAS __attribute__((address_space(3)))
#define GAS __attribute__((address_space(1)))
typedef unsigned short bf16;
typedef short bf16x8 __attribute__((ext_vector_type(8)));
typedef short s16x4 __attribute__((ext_vector_type(4)));
typedef short v4i16_t __attribute__((ext_vector_type(4)));
typedef float f32x2 __attribute__((ext_vector_type(2)));
typedef float f32x4 __attribute__((ext_vector_type(4)));
typedef float f32x16 __attribute__((ext_vector_type(16)));
typedef unsigned u32x2 __attribute__((ext_vector_type(2)));
typedef unsigned u32x4 __attribute__((ext_vector_type(4)));
typedef __bf16 bf16x2_t __attribute__((ext_vector_type(2)));
typedef GAS unsigned gu32;
#define RLX_AGENT __ATOMIC_RELAXED, __HIP_MEMORY_SCOPE_AGENT
#define LDS_WAIT() asm volatile("s_waitcnt lgkmcnt(0)" ::: "memory")
#define VM_WAIT() asm volatile("s_waitcnt vmcnt(0)" ::: "memory")
#define DI __device__ __forceinline__

DI unsigned cvtpk(float lo, float hi) { f32x2 v = {lo, hi}; bf16x2_t b = __builtin_convertvector(v, bf16x2_t); return __builtin_bit_cast(unsigned, b); }
DI float bflo(unsigned w) { return __uint_as_float(w << 16); }
DI float bfhi(unsigned w) { return __uint_as_float(w & 0xffff0000u); }
DI float bf2f(bf16 u) { return __uint_as_float((unsigned)u << 16); }
DI float fexp2(float x) { return __builtin_amdgcn_exp2f(x); }
DI float flog2(float x) { return __builtin_amdgcn_logf(x); }
DI float frcp(float x) { return __builtin_amdgcn_rcpf(x); }
DI float sigmoidf_(float x) { return frcp(1.0f + fexp2(-1.4426950408889634f * x)); }
DI int crow(int r, int hi) { return (r & 3) + 8 * (r >> 2) + 4 * hi; }
DI s16x4 vtr(const LAS char* p) { return __builtin_bit_cast(s16x4, __builtin_amdgcn_ds_read_tr16_b64_v4i16((LAS v4i16_t*)p)); }
#define MFMA32(a, b, c) __builtin_amdgcn_mfma_f32_32x32x16_bf16((a), (b), (c), 0, 0, 0)

constexpr int BATCH = 8, SEQ = 2048, DM = 1024, T = BATCH * SEQ, NPROJ = 6656, MEML = 256;
constexpr int C_SBQ = 0, C_SBK = 512, C_SBV = 1024, C_RQ = 1536, C_RK = 2048, C_RV = 2560, C_RG = 3584, C_GSB = 4608, C_GRET = 5632;
constexpr int NEXP = 32, TOPK = 4, DFF = 1024;
constexpr int MAXBLK = 288, PROWS = MAXBLK * 256;
constexpr float NORM_EPS = 1e-5f;
constexpr float LOG2E = 1.4426950408889634f;
constexpr float SBQ_SCALE = 0.125f * LOG2E;
constexpr float XQ_SCALE = 0.0625f * LOG2E;
constexpr float SB_THR = 150.0f;

namespace pg8 {
constexpr int BM = 256, BK = 64, HALF = 128, HTB = HALF * BK * 2, STAGE_BYTES = 8 * HTB, NXCD = 8;
__host__ __device__ __forceinline__ int lds_byte(int r, int c) { const int st = (r >> 4) * 2 + (c >> 5), rr = r & 15, cc = c & 31, ob = rr * 64 + cc * 2; return st * 1024 + (ob ^ (((ob >> 9) & 1) << 5)); }
__host__ __device__ __forceinline__ void stage_rc(int b, int& R, int& C) { const int st = b / 1024, sb = b % 1024, swz = sb ^ (((sb >> 9) & 1) << 5); R = (st >> 1) * 16 + swz / 64; C = (st & 1) * 32 + (swz % 64) / 2; }
__host__ __device__ __forceinline__ int perm32(int rho) { const int n = rho >> 4, i = rho & 15; return 8 * (i >> 2) + 4 * n + (i & 3); }

typedef int v8i_t __attribute__((ext_vector_type(8)));
typedef int v4i_t __attribute__((ext_vector_type(4)));
DI v8i_t cat8(bf16x8 a, bf16x8 b) { const v4i_t x = __builtin_bit_cast(v4i_t, a), y = __builtin_bit_cast(v4i_t, b); return __builtin_shufflevector(x, y, 0, 1, 2, 3, 4, 5, 6, 7); }
DI bf16x8 lo8(v8i_t v) { return __builtin_bit_cast(bf16x8, (v4i_t)__builtin_shufflevector(v, v, 0, 1, 2, 3)); }
DI bf16x8 hi8(v8i_t v) { return __builtin_bit_cast(bf16x8, (v4i_t)__builtin_shufflevector(v, v, 4, 5, 6, 7)); }
struct Unit { int pm, pn; const char* A; const char* B; int tag, e; };

DI void map_unit(int L, int nwg, int nM, int nN, int& pm, int& pn, const int WGM = 4) {
    int wgid = L; { const int q = nwg / NXCD, r = nwg % NXCD, xcd = wgid % NXCD, off = wgid / NXCD; wgid = (xcd < r ? xcd * (q + 1) : r * (q + 1) + (xcd - r) * q) + off; }
    const int nig = WGM * nN, gid = wgid / nig, fm = gid * WGM, gsz = (nM - fm) < WGM ? (nM - fm) : WGM;
    pm = fm + ((wgid % nig) % gsz); pn = (wgid % nig) / gsz;
}
struct Sched2 {
    const bf16* A0; const bf16* B0; int nM0, nN0; const bf16* A1; const bf16* B1; int nM1, nN1; int G, c, K; int wgm = 4;
    DI bool next(int i, Unit& u) const {
        const int n0 = nM0 * nN0, n1 = nM1 * nN1; const long L = (long)i * G + c; if (L >= n0 + n1) return false;
        const bool first = L < n0; int pm, pn; map_unit(first ? (int)L : (int)L - n0, first ? n0 : n1, first ? nM0 : nM1, first ? nN0 : nN1, pm, pn, wgm);
        u.pm = pm; u.pn = pn; u.tag = first ? 0 : 1; u.e = 0;
        u.A = (const char*)(first ? A0 : A1) + (size_t)pm * BM * K * 2; u.B = (const char*)(first ? B0 : B1) + (size_t)pn * BM * K * 2; return true;
    }
};
struct SchedMoE {
    const unsigned char* A; const unsigned char* Wt; const int* blk_e; int nblk, nN, G, c, K; size_t estride; int wgm = 4;
    DI bool next(int i, Unit& u) const {
        const int nwg = nblk * nN; const long L = (long)i * G + c; if (L >= nwg) return false;
        int pm, pn; map_unit((int)L, nwg, nblk, nN, pm, pn, wgm);
        const int e = __builtin_amdgcn_readfirstlane(__hip_atomic_load(blk_e + pm, RLX_AGENT));
        u.pm = pm; u.pn = pn; u.tag = 0; u.e = e;
        u.A = (const char*)A + (size_t)pm * BM * K; u.B = (const char*)Wt + ((size_t)e * estride + (size_t)pn * BM * K); return true;
    }
};

template <class Epi, class Sched>
DI void gemm_phase(LAS unsigned char* lds, const int K, const Sched& S, const Epi& E) {
    const int tid = threadIdx.x, wid = __builtin_amdgcn_readfirstlane(tid >> 6), lane = tid & 63, wr = wid >> 2, wc = wid & 3, fr = lane & 15, fq = lane >> 4;
    constexpr int ESZ = Epi::FP8 ? 1 : 2;
    int nt = K * ESZ / 128; asm volatile("" : "+s"(nt));
    unsigned voffA[2], voffB[2];
#pragma unroll
    for (int i = 0; i < 2; ++i) { int R, C; stage_rc(tid * 16 + i * 8192, R, C); const int Rb = Epi::PERM ? ((R & ~31) + perm32(R & 31)) : R;
        voffA[i] = (unsigned)(R * K * ESZ + 2 * C); voffB[i] = (unsigned)(Rb * K * ESZ + 2 * C); }
    const size_t kstep = (size_t)(BK * 2);
    const size_t hstep = (size_t)HALF * K * ESZ;
    const unsigned ldsw = (unsigned)wid * 1024u;
    const int aoff = lds_byte(wr * 64 + fr, fq * 8), boff = lds_byte(wc * 32 + fr, fq * 8);
#define PG8_SA(b, h) (((b) * 2 + (h)) * HTB)
#define PG8_SB(b, h) ((4 + (b) * 2 + (h)) * HTB)
#define PG8_STAGE(bufoff, gbase, voff) do { _Pragma("unroll") for (int _i = 0; _i < 2; ++_i) \
        __builtin_amdgcn_global_load_lds((const unsigned*)((const char*)(gbase) + (voff)[_i]), (LAS unsigned*)(lds + (bufoff) + ldsw + _i * 8192), 16, 0, 0); } while (0)
#define PG8_LDA(dst, b, h) do { _Pragma("unroll") for (int m = 0; m < 4; ++m) dst[m] = cat8(*(const LAS bf16x8*)(lds + PG8_SA(b, h) + aoff + m * 2048), *(const LAS bf16x8*)(lds + PG8_SA(b, h) + aoff + m * 2048 + 1024)); } while (0)
#define PG8_LDB(dst, b, h) do { _Pragma("unroll") for (int n = 0; n < 2; ++n) dst[n] = cat8(*(const LAS bf16x8*)(lds + PG8_SB(b, h) + boff + n * 2048), *(const LAS bf16x8*)(lds + PG8_SB(b, h) + boff + n * 2048 + 1024)); } while (0)
#define PG8_MMA(ai, bj, At, Bt) do { __builtin_amdgcn_s_setprio(1); _Pragma("unroll") for (int m = 0; m < 4; ++m) _Pragma("unroll") for (int n = 0; n < 2; ++n) { \
        if constexpr (Epi::FP8) { asm volatile("v_mfma_scale_f32_16x16x128_f8f6f4 %0, %1, %2, %0, %3, %4 op_sel_hi:[0,0,0]" : "+v"(acc[ai][bj][m][n]) : "v"(Bt[n]), "v"(At[m]), "v"(sc_w), "v"(sc_a)); } \
        else { acc[ai][bj][m][n] = __builtin_amdgcn_mfma_f32_16x16x32_bf16(lo8(Bt[n]), lo8(At[m]), acc[ai][bj][m][n], 0, 0, 0); acc[ai][bj][m][n] = __builtin_amdgcn_mfma_f32_16x16x32_bf16(hi8(Bt[n]), hi8(At[m]), acc[ai][bj][m][n], 0, 0, 0); } } \
        __builtin_amdgcn_s_setprio(0); } while (0)
#define PG8_WAIT_V(n) asm volatile("s_waitcnt vmcnt(" #n ")" ::: "memory")
#define PG8_WAIT_L(n) asm volatile("s_waitcnt lgkmcnt(" #n ")" ::: "memory")
#define PG8_BAR __builtin_amdgcn_s_barrier()
#define PG8_SCHED __builtin_amdgcn_sched_barrier(0)
    Unit cur, nxt; int ui = 0;
    if (S.next(0, cur)) {
    f32x4 acc[2][2][4][2];
#pragma unroll
    for (int a = 0; a < 2; ++a)
#pragma unroll
        for (int b = 0; b < 2; ++b)
#pragma unroll
            for (int m = 0; m < 4; ++m)
#pragma unroll
                for (int n = 0; n < 2; ++n) acc[a][b][m][n] = (f32x4){0.f, 0.f, 0.f, 0.f};
    v8i_t At[4], B0[2], B1[2];
    int sc_w = 0, sc_a = 0; if constexpr (Epi::FP8) { sc_w = Epi::SCALE_W; sc_a = Epi::SCALE_A; asm volatile("" : "+v"(sc_w), "+v"(sc_a)); }
    (void)sc_w; (void)sc_a;
    const char* cA = cur.A; const char* cB = cur.B;
    PG8_STAGE(PG8_SB(0, 0), cB, voffB); PG8_STAGE(PG8_SB(0, 1), cB + hstep, voffB); PG8_STAGE(PG8_SA(0, 0), cA, voffA); PG8_STAGE(PG8_SA(0, 1), cA + hstep, voffA);
    if (wr == 1) PG8_BAR;
    PG8_WAIT_V(2); PG8_BAR;
    PG8_STAGE(PG8_SB(1, 0), cB + kstep, voffB); PG8_STAGE(PG8_SA(1, 0), cA + kstep, voffA); PG8_STAGE(PG8_SB(1, 1), cB + hstep + kstep, voffB);
    PG8_WAIT_V(6); PG8_BAR;
    for (;;) {
        const bool has_next = S.next(ui + 1, nxt);
        const char* nA = has_next ? nxt.A : cA; const char* nB = has_next ? nxt.B : cB;
#pragma nounroll
        for (int t = 0; t < nt; t += 2) {
            const bool last = (t == nt - 2);
            const char* a1 = cA + (size_t)(t + 1) * kstep;
            const char* a2 = last ? nA : cA + (size_t)(t + 2) * kstep; const char* b2 = last ? nB : cB + (size_t)(t + 2) * kstep;
            const char* a3 = a2 + kstep; const char* b3 = b2 + kstep;
            PG8_LDB(B0, 0, 0); PG8_LDB(B1, 0, 1); PG8_SCHED; PG8_LDA(At, 0, 0); PG8_STAGE(PG8_SA(1, 1), a1 + hstep, voffA);
            PG8_WAIT_V(8); PG8_WAIT_L(0); PG8_BAR; PG8_MMA(0, 0, At, B0); PG8_MMA(0, 1, At, B1); PG8_BAR; PG8_SCHED;
            PG8_LDA(At, 0, 1); PG8_STAGE(PG8_SB(0, 0), b2, voffB); PG8_STAGE(PG8_SB(0, 1), b2 + hstep, voffB); PG8_STAGE(PG8_SA(0, 0), a2, voffA);
            PG8_WAIT_V(8); PG8_WAIT_L(0); PG8_BAR; PG8_MMA(1, 0, At, B0); PG8_MMA(1, 1, At, B1); PG8_BAR; PG8_SCHED;
            PG8_LDB(B0, 1, 0); PG8_LDB(B1, 1, 1); PG8_SCHED; PG8_LDA(At, 1, 0); PG8_STAGE(PG8_SA(0, 1), a2 + hstep, voffA);
            PG8_WAIT_V(8); PG8_WAIT_L(0); PG8_BAR; PG8_MMA(0, 0, At, B0); PG8_MMA(0, 1, At, B1); PG8_BAR; PG8_SCHED;
            PG8_LDA(At, 1, 1); PG8_STAGE(PG8_SB(1, 0), b3, voffB); PG8_STAGE(PG8_SB(1, 1), b3 + hstep, voffB); PG8_STAGE(PG8_SA(1, 0), a3, voffA);
            PG8_WAIT_V(8); PG8_WAIT_L(0); PG8_BAR; PG8_MMA(1, 0, At, B0); PG8_MMA(1, 1, At, B1); PG8_BAR; PG8_SCHED;
        }
        if (wr == 0) PG8_BAR;
        if constexpr (Epi::FP8) { asm volatile("s_nop 15\n\ts_nop 3" ::: "memory"); _Pragma("unroll") for (int i_ = 0; i_ < 32; ++i_) asm volatile("" : "+v"(((f32x4*)acc)[i_])); }
        E(acc, cur, wr, wc, fr, fq);
        if (!has_next) break;
#pragma unroll
        for (int a = 0; a < 2; ++a)
#pragma unroll
            for (int b = 0; b < 2; ++b)
#pragma unroll
                for (int m = 0; m < 4; ++m)
#pragma unroll
                    for (int n = 0; n < 2; ++n) acc[a][b][m][n] = (f32x4){0.f, 0.f, 0.f, 0.f};
        cur = nxt; cA = nA; cB = nB; ++ui;
        if (wr == 1) PG8_BAR;
    }
    PG8_WAIT_V(0);
    PG8_BAR;
    }
    __syncthreads();
#undef PG8_SA
#undef PG8_SB
#undef PG8_STAGE
#undef PG8_LDA
#undef PG8_LDB
#undef PG8_MMA
#undef PG8_WAIT_V
#undef PG8_WAIT_L
#undef PG8_BAR
#undef PG8_SCHED
}
}

#define XB_TMO      128
#define XB_XCNT(j)  (256  + 64 * (j))
#define XB_XSUB(j)  (1280 + 64 * (j))
#define XB_XGEN(j)  (2304 + 64 * (j))
#define XB_TOP      3328
#define XB_TOPGEN   3392
#define XCD_BAR_WORDS 3456
#define XB_SPIN_CAP (1u << 18)
DI unsigned xb_ld(unsigned* p)              { return __hip_atomic_load(p, __ATOMIC_RELAXED, __HIP_MEMORY_SCOPE_AGENT); }
DI unsigned xb_add(unsigned* p, unsigned v) { return __hip_atomic_fetch_add(p, v, __ATOMIC_RELAXED, __HIP_MEMORY_SCOPE_AGENT); }
DI unsigned xb_xcc_id() { return (unsigned)__builtin_amdgcn_s_getreg((3 << 11) | 20) & 0xFu; }
#define XB_SPIN(cond, bar) do { unsigned _sp = 0; while (cond) { __builtin_amdgcn_s_sleep(1); \
    if ((++_sp & 255u) == 0u) { if (xb_ld(&(bar)[XB_TMO])) break; if (_sp > XB_SPIN_CAP) { atomicAdd(&(bar)[XB_TMO], 1u); break; } } } } while (0)
struct XcdBarrier { unsigned* bar; unsigned x; volatile LAS unsigned* st; };
DI XcdBarrier xcd_barrier_post(unsigned* bar, volatile LAS unsigned* st) {
    XcdBarrier b; b.bar = bar; b.x = xb_xcc_id(); b.st = st;
    if (threadIdx.x == 0) (void)xb_add(&bar[XB_XCNT(b.x)], 1u);
    return b;
}
DI void xcd_barrier_complete(unsigned* bar, unsigned x, unsigned& nloc, unsigned& nx) {
    const unsigned G = gridDim.x * gridDim.y * gridDim.z;
    unsigned sum, cnt, mine, sp = 0u;
    for (;;) {
        sum = 0u; cnt = 0u; mine = 0u;
#pragma unroll
        for (unsigned j = 0; j < 16; ++j) { const unsigned c = xb_ld(&bar[XB_XCNT(j)]); sum += c; cnt += (c > 0u) ? 1u : 0u; mine = (j == x) ? c : mine; }
        if (sum == G) break;
        __builtin_amdgcn_s_sleep(1);
        if ((++sp & 255u) == 0u) { if (xb_ld(&bar[XB_TMO])) break; if (sp > XB_SPIN_CAP) { atomicAdd(&bar[XB_TMO], 1u); break; } }
    }
    nloc = mine > 0u ? mine : 1u; nx = cnt > 0u ? cnt : 1u;
}
DI void xcd_barrier(const XcdBarrier& b) {
    asm volatile("s_waitcnt vmcnt(0)" ::: "memory");
    __syncthreads();
    if (threadIdx.x == 0) {
        unsigned* bar = b.bar;
        __builtin_amdgcn_s_waitcnt(0);
        unsigned nloc = b.st[0], nx = b.st[1];
        if (nloc == 0u) { xcd_barrier_complete(bar, b.x, nloc, nx); b.st[0] = nloc; b.st[1] = nx; }
        const unsigned old = xb_add(&bar[XB_XSUB(b.x)], 1u);
        const unsigned gen = old / nloc;
        if (old + 1u == (gen + 1u) * nloc) {
            __builtin_amdgcn_fence(__ATOMIC_RELEASE, "agent");
            asm volatile("s_waitcnt vmcnt(0)" ::: "memory");
            const unsigned og = xb_add(&bar[XB_TOP], 1u);
            const unsigned tg = og / nx;
            if (og + 1u == (tg + 1u) * nx) xb_add(&bar[XB_TOPGEN], 1u);
            else XB_SPIN(xb_ld(&bar[XB_TOPGEN]) == tg, bar);
            __builtin_amdgcn_fence(__ATOMIC_ACQUIRE, "agent");
            xb_add(&bar[XB_XGEN(b.x)], 1u);
            asm volatile("s_waitcnt vmcnt(0)" ::: "memory");
        } else {
            XB_SPIN(xb_ld(&bar[XB_XGEN(b.x)]) == gen, bar);
            __builtin_amdgcn_fence(__ATOMIC_ACQUIRE, "agent");
            asm volatile("s_waitcnt vmcnt(0)" ::: "memory");
        }
    }
    __syncthreads();
}

constexpr size_t MB = 1024 * 1024;
constexpr size_t WS_CTL    = 0;
constexpr size_t CTL_BYTES = 256 * 1024;
constexpr int    CW_BAR = 4096;
constexpr int    CW_CHK = 32768;
constexpr size_t WS_ROPE   = WS_CTL + CTL_BYTES;
constexpr size_t WS_WIN    = WS_ROPE + 512 * 1024;
constexpr size_t WS_WSBO   = WS_WIN + (size_t)NPROJ * DM * 2;
constexpr size_t WS_WRETO  = WS_WSBO + 1 * MB;
constexpr size_t WS_WMIX   = WS_WRETO + 2 * MB;
constexpr size_t WS_WCQ    = WS_WMIX + 2 * MB;
constexpr size_t WS_WCKV   = WS_WCQ + 2 * MB;
constexpr size_t WS_WCO    = WS_WCKV + 4 * MB;
constexpr size_t WS_WE1    = WS_WCO + 2 * MB;
constexpr size_t WS_WE2    = WS_WE1 + 128 * MB;
constexpr size_t WS_SMALL  = WS_WE2 + 64 * MB;
constexpr size_t WS_MEMN   = WS_SMALL + 4 * MB;
constexpr size_t WS_KVMEM  = WS_MEMN + 4 * MB;
constexpr size_t WS_GTOT   = WS_KVMEM + 8 * MB;
constexpr size_t WS_SLOTS  = WS_GTOT + 8 * MB;
constexpr size_t WS_A      = WS_SLOTS + 1 * MB;
constexpr size_t WS_B      = WS_A + 208 * MB;
constexpr size_t WS_C      = WS_B + 32 * MB;
constexpr size_t WS_D      = WS_C + 64 * MB;
constexpr size_t WS_E      = WS_D + 144 * MB;
constexpr size_t WS_END    = WS_E + 144 * MB;
static_assert((size_t)T * NPROJ * 2 <= 208 * MB && (size_t)PROWS * 1024 * 2 <= 144 * MB, "arena sizes");
constexpr size_t WS_PROJ = WS_A, WS_XG = WS_A, WS_XN1 = WS_B, WS_YRET = WS_B, WS_XN3U = WS_B, WS_TMP = WS_C, WS_X2 = WS_C;
constexpr size_t WS_YSB = WS_D, WS_MERGED = WS_D + 16 * MB, WS_XN2U = WS_D + 48 * MB  , WS_QX = WS_D + 80 * MB, WS_OX = WS_D + 112 * MB, WS_ACT = WS_D;
constexpr size_t WS_X1 = WS_E, WS_YROWS = WS_E;
constexpr size_t SM_TOPE = 0;
constexpr size_t SM_GATE = SM_TOPE + T * 16;
constexpr size_t SM_LRANK = SM_GATE + T * 16;
constexpr size_t SM_AROW = SM_LRANK + T * 16;
constexpr size_t SM_RSTD3 = SM_AROW + T * 16;
constexpr size_t SM_CNT = SM_RSTD3 + T * 4;
constexpr size_t SM_RSCALE = SM_CNT + 256 * 32 * 4;
constexpr size_t SM_RGATE = SM_RSCALE + PROWS * 4;
constexpr size_t SM_BLKE = SM_RGATE + PROWS * 4;
constexpr size_t SM_END = SM_BLKE + 4096;
static_assert(SM_END <= 4 * MB, "small tables");

constexpr int RING_OFF = 0, RING_BYTES = 131072;
constexpr int XTRA_OFF = RING_BYTES, XTRA_BYTES = 12288;
constexpr int LDSCTL_OFF = XTRA_OFF + XTRA_BYTES;
constexpr int LDS_BYTES = 147456;
static_assert(LDSCTL_OFF + 256 <= LDS_BYTES, "LDS map");
constexpr int NWAVES = 8;

struct Args { const float* in[20]; float* out; unsigned char* ws; int ph_lo, ph_hi; };

typedef const __attribute__((address_space(4))) unsigned char* kptr_t;
struct Frame {
    LAS unsigned char* lds;
    unsigned char* ws;
    int tid, lane, wave, G, bid;
    kptr_t kp;
    float* out;
};
DI const float* inp(const Frame& F, int i) { return *(const float* const __attribute__((address_space(4)))*)(F.kp + 8 * i); }
enum { I_X = 0, I_MEM, I_GMIX, I_WIN, I_WSBO, I_WRETO, I_WMIX, I_GXATTN, I_GMEM, I_WCQ, I_WCKV, I_WCO, I_GMOE, I_WROUTER, I_BROUTER, I_WE1, I_BE1, I_WE2, I_BE2, I_GFINAL };

DI float wave_sum(float v) {
#pragma unroll
    for (int o = 1; o < 64; o <<= 1) v += __shfl_xor(v, o);
    return v;
}

DI void p0_tr_item(const float* W, int N, int K, bf16* dst, LAS float* scr, int k0, int n0, int lane, const float* rowscale = nullptr) {
#pragma unroll 8
    for (int i = 0; i < 32; ++i) { const int kk = 2 * i + (lane >> 5); scr[kk * 33 + (lane & 31)] = W[(size_t)(k0 + kk) * N + n0 + (lane & 31)] * (rowscale ? rowscale[k0 + kk] : 1.0f); }
    LDS_WAIT(); asm volatile("" ::: "memory");
    const int c = lane & 7;
#pragma unroll
    for (int j = 0; j < 4; ++j) { const int n = (lane >> 3) + 8 * j; const LAS float* s = scr + (8 * c) * 33 + n;
        u32x4 o; o.x = cvtpk(s[0 * 33], s[1 * 33]); o.y = cvtpk(s[2 * 33], s[3 * 33]); o.z = cvtpk(s[4 * 33], s[5 * 33]); o.w = cvtpk(s[6 * 33], s[7 * 33]);
        *(u32x4*)(dst + (size_t)n * K + k0 + 8 * c) = o; }
    LDS_WAIT(); asm volatile("" ::: "memory");
}
DI unsigned cvt4_fp8(float a, float b, float c, float d) { int w = __builtin_amdgcn_cvt_pk_fp8_f32(a, b, 0, false); w = __builtin_amdgcn_cvt_pk_fp8_f32(c, d, w, true); return (unsigned)w; }
DI void p0_tr_item_fp8(const float* W, int N, int K, unsigned char* dst, LAS float* scr, int k0, int n0, int lane) {
#pragma unroll 8
    for (int i = 0; i < 32; ++i) { const int kk = 2 * i + (lane >> 5); scr[kk * 33 + (lane & 31)] = W[(size_t)(k0 + kk) * N + n0 + (lane & 31)] * 64.0f; }
    LDS_WAIT(); asm volatile("" ::: "memory");
    const int c = lane & 7;
#pragma unroll
    for (int j = 0; j < 4; ++j) { const int n = (lane >> 3) + 8 * j; const LAS float* s = scr + (8 * c) * 33 + n;
        u32x2 o; o.x = cvt4_fp8(s[0 * 33], s[1 * 33], s[2 * 33], s[3 * 33]); o.y = cvt4_fp8(s[4 * 33], s[5 * 33], s[6 * 33], s[7 * 33]);
        *(u32x2*)(dst + (size_t)n * K + k0 + 8 * c) = o; }
    LDS_WAIT(); asm volatile("" ::: "memory");
}
DI void rms_row_to_bf16(const float* xrow, const float* g, bf16* orow, int lane) {
    const f32x4* xr = (const f32x4*)xrow + lane; const f32x4* gr = (const f32x4*)g + lane;
    f32x4 v[4]; float s = 0.f;
#pragma unroll
    for (int j = 0; j < 4; ++j) { v[j] = xr[64 * j]; s += (v[j].x * v[j].x + v[j].y * v[j].y) + (v[j].z * v[j].z + v[j].w * v[j].w); }
    const float rstd = 1.0f / sqrtf(wave_sum(s) * (1.f / DM) + NORM_EPS);
    u32x2* o8 = (u32x2*)orow + lane;
#pragma unroll
    for (int j = 0; j < 4; ++j) { const f32x4 gg = gr[64 * j]; u32x2 w; w.x = cvtpk(v[j].x * rstd * gg.x, v[j].y * rstd * gg.y); w.y = cvtpk(v[j].z * rstd * gg.z, v[j].w * rstd * gg.w); o8[64 * j] = w; }
}
constexpr int P0_IE1 = 32 * 16 * 64, P0_IE2 = 32 * 16 * 32;
DI void p0_experts(Frame& F, int vg  , int nvg) {
    LAS float* scr = (LAS float*)(F.lds + RING_OFF + F.wave * 16384);
    constexpr int P0_BASE = 2048 * 22; const bool light = (F.G == 256) && (F.bid >= 192); const int nlv = 64 * NWAVES, lv = (F.bid - 192) * NWAVES + F.wave;
    const int n_mine = (F.G == 256) ? 22 + (light ? 8 : 0) : (P0_IE1 + P0_IE2 + nvg - 1) / nvg;
    for (int j = 0; j < n_mine; ++j) {
        int it; if (F.G != 256) { it = vg + j * nvg; if (it >= P0_IE1 + P0_IE2) break; } else if (j < 22) it = vg + j * nvg; else it = P0_BASE + lv + (j - 22) * nlv;
        int r = it;
        if (r < P0_IE1) { const int e = r / 1024, q = r % 1024, kb = q / 64, nb = q % 64, n0 = 32 * nb;
            const int drow = n0 < 1024 ? 256 * (n0 >> 7) + (n0 & 127) : 256 * ((n0 - 1024) >> 7) + 128 + ((n0 - 1024) & 127);
            p0_tr_item_fp8(inp(F, I_WE1) + (size_t)e * 1024 * 2048, 2048, 1024, F.ws + WS_WE1 + ((size_t)e * 2048 + drow) * 1024, scr, 64 * kb, n0, F.lane); continue; }
        r -= P0_IE1;
        { const int e = r / 512, q = r % 512, kb = q / 32, nb = q % 32;
            p0_tr_item_fp8(inp(F, I_WE2) + (size_t)e * 1024 * 1024, 1024, 1024, F.ws + WS_WE2 + ((size_t)e * 1024 + 32 * nb) * 1024, scr, 64 * kb, 32 * nb, F.lane); }
    }
}


DI void p0_prologue(Frame& F) {
    LAS float* scr = (LAS float*)(F.lds + RING_OFF + F.wave * 16384);
    const int gw = F.bid * NWAVES + F.wave, NGW = F.G * NWAVES;
    constexpr int I0 = 16 * 208, I1 = 8 * 32, I2 = 16 * 32, I5 = 16 * 64;
    constexpr int NITEMS = I0 + I1 + 4 * I2 + I5;
    for (int it = gw; it < NITEMS; it += NGW) {
        int r = it;
        if (r < I0) { const int kb = r / 208, nb = r % 208; p0_tr_item(inp(F, I_WIN), NPROJ, 1024, (bf16*)(F.ws + WS_WIN) + (size_t)(32 * nb) * 1024, scr, 64 * kb, 32 * nb, F.lane); continue; } r -= I0;
        if (r < I1) { const int kb = r / 32, nb = r % 32; p0_tr_item(inp(F, I_WSBO), 1024, 512, (bf16*)(F.ws + WS_WSBO) + (size_t)(32 * nb) * 512, scr, 64 * kb, 32 * nb, F.lane); continue; } r -= I1;
        if (r < I2) { const int kb = r / 32, nb = r % 32; p0_tr_item(inp(F, I_WRETO), 1024, 1024, (bf16*)(F.ws + WS_WRETO) + (size_t)(32 * nb) * 1024, scr, 64 * kb, 32 * nb, F.lane); continue; } r -= I2;
        if (r < I2) { const int kb = r / 32, nb = r % 32; p0_tr_item(inp(F, I_WMIX), 1024, 1024, (bf16*)(F.ws + WS_WMIX) + (size_t)(32 * nb) * 1024, scr, 64 * kb, 32 * nb, F.lane); continue; } r -= I2;
        if (r < I2) { const int kb = r / 32, nb = r % 32; p0_tr_item(inp(F, I_WCQ), 1024, 1024, (bf16*)(F.ws + WS_WCQ) + (size_t)(32 * nb) * 1024, scr, 64 * kb, 32 * nb, F.lane, inp(F, I_GXATTN)); continue; }   r -= I2;
        if (r < I5) { const int kb = r / 64, nb = r % 64; p0_tr_item(inp(F, I_WCKV), 2048, 1024, (bf16*)(F.ws + WS_WCKV) + (size_t)(32 * nb) * 1024, scr, 64 * kb, 32 * nb, F.lane); continue; } r -= I5;
        { const int kb = r / 32, nb = r % 32; p0_tr_item(inp(F, I_WCO), 1024, 1024, (bf16*)(F.ws + WS_WCO) + (size_t)(32 * nb) * 1024, scr, 64 * kb, 32 * nb, F.lane); }
    }
    for (int m = gw; m < T + BATCH * MEML; m += NGW) {
        if (m < T) rms_row_to_bf16(inp(F, I_X) + (size_t)m * DM, inp(F, I_GMIX), (bf16*)(F.ws + WS_XN1) + (size_t)m * DM, F.lane);
        else rms_row_to_bf16(inp(F, I_MEM) + (size_t)(m - T) * DM, inp(F, I_GMEM), (bf16*)(F.ws + WS_MEMN) + (size_t)(m - T) * DM, F.lane);
    }
    { float* ct = (float*)(F.ws + WS_ROPE); float* st = ct + SEQ * 32;
      for (int i = F.bid * 512 + F.tid; i < SEQ * 32; i += F.G * 512) { const int pos = i >> 5, k = i & 31;
          const float inv = fexp2(-(float)k * (13.287712379549449f / 32.0f)); const float ang = (float)pos * inv;
          const float n = rintf(ang * 0.15915494309189535f); float r = fmaf(-n, 6.2831854820251465f, ang); r = fmaf(-n, -1.7484555e-7f, r);
          const float rev = r * 0.15915494309189535f; ct[i] = __builtin_amdgcn_cosf(rev); st[i] = __builtin_amdgcn_sinf(rev); } }
}

typedef f32x4 AccT[2][2][4][2];
#define EPI_ROWS_BEGIN _Pragma("unroll") for (int ai = 0; ai < 2; ++ai) _Pragma("unroll") for (int m = 0; m < 4; ++m) { const int rloc = ai * 128 + wr * 64 + m * 16 + fr; const size_t row = (size_t)u.pm * 256 + rloc; (void)row;
#define EPI_ROWS_END }
DI u32x4 pack8(f32x4 a, f32x4 b) { u32x4 w; w.x = cvtpk(a[0], a[1]); w.y = cvtpk(a[2], a[3]); w.z = cvtpk(b[0], b[1]); w.w = cvtpk(b[2], b[3]); return w; }
DI void unpack8(u32x4 w, f32x4& a, f32x4& b) { a = (f32x4){bflo(w.x), bfhi(w.x), bflo(w.y), bfhi(w.y)}; b = (f32x4){bflo(w.z), bfhi(w.z), bflo(w.w), bfhi(w.w)}; }
DI f32x4 sig4(f32x4 g) { return (f32x4){sigmoidf_(g[0]), sigmoidf_(g[1]), sigmoidf_(g[2]), sigmoidf_(g[3])}; }

struct Epi1 { static constexpr bool PERM = true, FP8 = false; bf16* proj; bf16* kvmem;
    DI void operator()(const AccT& acc, const pg8::Unit& u, int wr, int wc, int fr, int fq) const {
        bf16* base; int ldc; float sc = 1.f;
        if (u.tag == 0) { base = proj; ldc = NPROJ; if (u.pn < 2) sc = SBQ_SCALE; else if (u.pn == 8 || u.pn == 9) sc = 0.125f; } else { base = kvmem; ldc = 2048; }
        const int col0 = u.pn * 256 + wc * 32 + 8 * fq;
        EPI_ROWS_BEGIN
            bf16* rowp = base + row * ldc + col0;
#pragma unroll
            for (int bj = 0; bj < 2; ++bj) *(u32x4*)(rowp + bj * 128) = pack8(acc[ai][bj][m][0] * sc, acc[ai][bj][m][1] * sc);
        EPI_ROWS_END
    }
};
struct Epi5a { static constexpr bool PERM = true, FP8 = false; const bf16* proj; bf16* tmp;
    DI void operator()(const AccT& acc, const pg8::Unit& u, int wr, int wc, int fr, int fq) const {
        const int col0 = u.pn * 256 + wc * 32 + 8 * fq;
        EPI_ROWS_BEGIN
#pragma unroll
            for (int bj = 0; bj < 2; ++bj) { f32x4 g0, g1; unpack8(*(const u32x4*)(proj + row * NPROJ + C_GSB + col0 + bj * 128), g0, g1);
                *(u32x4*)(tmp + row * DM + col0 + bj * 128) = pack8(sig4(g0) * acc[ai][bj][m][0], sig4(g1) * acc[ai][bj][m][1]); }
        EPI_ROWS_END
    }
};
struct Epi5b { static constexpr bool PERM = true, FP8 = false; const bf16* proj; const bf16* tmp; bf16* merged;
    DI void operator()(const AccT& acc, const pg8::Unit& u, int wr, int wc, int fr, int fq) const {
        const int col0 = u.pn * 256 + wc * 32 + 8 * fq;
        EPI_ROWS_BEGIN
#pragma unroll
            for (int bj = 0; bj < 2; ++bj) { f32x4 g0, g1; unpack8(*(const u32x4*)(proj + row * NPROJ + C_GRET + col0 + bj * 128), g0, g1);
                f32x4 t0, t1; unpack8(*(const u32x4*)(tmp + row * DM + col0 + bj * 128), t0, t1);
                *(u32x4*)(merged + row * DM + col0 + bj * 128) = pack8(t0 + sig4(g0) * acc[ai][bj][m][0], t1 + sig4(g1) * acc[ai][bj][m][1]); }
        EPI_ROWS_END
    }
};
template <bool FIRST> struct EpiRes { static constexpr bool PERM = true, FP8 = false; const void* xi; bf16* xo; float* slots;
    DI void operator()(const AccT& acc, const pg8::Unit& u, int wr, int wc, int fr, int fq) const {
        const int col0 = u.pn * 256 + wc * 32 + 8 * fq;
        EPI_ROWS_BEGIN
            float ss = 0.f;
#pragma unroll
            for (int bj = 0; bj < 2; ++bj) { const size_t off = row * DM + col0 + bj * 128; f32x4 a, b;
                if (FIRST) { a = *(const f32x4*)((const float*)xi + off); b = *(const f32x4*)((const float*)xi + off + 4); } else unpack8(*(const u32x4*)((const bf16*)xi + off), a, b);
                a += acc[ai][bj][m][0]; b += acc[ai][bj][m][1];
                *(u32x4*)(xo + off) = pack8(a, b);
                if (FIRST) ss += (a[0] * a[0] + a[1] * a[1]) + (a[2] * a[2] + a[3] * a[3]) + (b[0] * b[0] + b[1] * b[1]) + (b[2] * b[2] + b[3] * b[3]); }
            if (FIRST) { ss += __shfl_xor(ss, 16); ss += __shfl_xor(ss, 32); if (fq == 0) slots[row * 16 + u.pn * 4 + wc] = ss; }
        EPI_ROWS_END
    }
};
struct Epi7 { static constexpr bool PERM = true, FP8 = false; const float* slots; bf16* qx;
    DI void operator()(const AccT& acc, const pg8::Unit& u, int wr, int wc, int fr, int fq) const {
        const int col0 = u.pn * 256 + wc * 32 + 8 * fq;
        EPI_ROWS_BEGIN
            const f32x4 s4 = *(const f32x4*)(slots + row * 16 + 4 * fq); float ss = (s4[0] + s4[1]) + (s4[2] + s4[3]); ss += __shfl_xor(ss, 16); ss += __shfl_xor(ss, 32);
            const float sc = XQ_SCALE / sqrtf(ss * (1.f / DM) + NORM_EPS);
#pragma unroll
            for (int bj = 0; bj < 2; ++bj) *(u32x4*)(qx + row * DM + col0 + bj * 128) = pack8(acc[ai][bj][m][0] * sc, acc[ai][bj][m][1] * sc);
        EPI_ROWS_END
    }
};
struct Epi12 { static constexpr bool PERM = true, FP8 = true; static constexpr int SCALE_W = 0x79797979, SCALE_A = 0x7f7f7f7f;   const float* rscale; const float* b1; unsigned char* act;
    DI void operator()(const AccT& acc, const pg8::Unit& u, int wr, int wc, int fr, int fq) const {
        const int ac0 = u.pn * 128 + wc * 32 + 8 * fq; const float* bb = b1 + (size_t)u.e * 2048;
        const f32x4 bg0 = *(const f32x4*)(bb + ac0), bg1 = *(const f32x4*)(bb + ac0 + 4), bl0 = *(const f32x4*)(bb + 1024 + ac0), bl1 = *(const f32x4*)(bb + 1024 + ac0 + 4);
        EPI_ROWS_BEGIN
            const float rs = rscale[row];
            f32x4 o[2];
#pragma unroll
            for (int n = 0; n < 2; ++n) { const f32x4 gl = acc[ai][0][m][n] * rs + (n ? bg1 : bg0), li = acc[ai][1][m][n] * rs + (n ? bl1 : bl0);
#pragma unroll
                for (int i = 0; i < 4; ++i) { const float gg = fminf(gl[i], 7.0f), ll = fminf(fmaxf(li[i], -7.0f), 7.0f); o[n][i] = gg * frcp(1.0f + fexp2(-1.702f * LOG2E * gg)) * (ll + 1.0f); } }
            { u32x2 w; w.x = cvt4_fp8(o[0][0], o[0][1], o[0][2], o[0][3]); w.y = cvt4_fp8(o[1][0], o[1][1], o[1][2], o[1][3]); *(u32x2*)(act + row * DFF + ac0) = w; }
        EPI_ROWS_END
    }
};
struct Epi13 { static constexpr bool PERM = true, FP8 = true; static constexpr int SCALE_W = 0x79797979, SCALE_A = 0x7f7f7f7f; const float* rgate; const float* b2; bf16* yrows;
    DI void operator()(const AccT& acc, const pg8::Unit& u, int wr, int wc, int fr, int fq) const {
        const int col0 = u.pn * 256 + wc * 32 + 8 * fq; const float* bb = b2 + (size_t)u.e * 1024 + col0;
        f32x4 bv[2][2];
#pragma unroll
        for (int bj = 0; bj < 2; ++bj) { bv[bj][0] = *(const f32x4*)(bb + bj * 128); bv[bj][1] = *(const f32x4*)(bb + bj * 128 + 4); }
        EPI_ROWS_BEGIN
            const float gt = rgate[row];
#pragma unroll
            for (int bj = 0; bj < 2; ++bj) *(u32x4*)(yrows + row * DM + col0 + bj * 128) = pack8((acc[ai][bj][m][0] + bv[bj][0]) * gt, (acc[ai][bj][m][1] + bv[bj][1]) * gt);
        EPI_ROWS_END
    }
};

DI void lds_barrier() { asm volatile("s_waitcnt lgkmcnt(0)" ::: "memory"); __builtin_amdgcn_s_barrier(); asm volatile("" ::: "memory"); }

constexpr int SB_K = 0, SB_V = 8192;
DI void sb_unit(Frame& F, int b, int h, int qb) {
    const int lane = F.lane, r32 = lane & 31, hi = lane >> 5, wid = F.wave;
    LAS char* lds = (LAS char*)F.lds;
    const bf16* Pj = (const bf16*)(F.ws + WS_PROJ) + (size_t)b * SEQ * NPROJ;
    const int qw0 = qb * 256 + wid * 32, q = qw0 + r32;
    bf16x8 qr[4];
#pragma unroll
    for (int d0 = 0; d0 < 4; ++d0) qr[d0] = *(const bf16x8*)(Pj + (size_t)q * NPROJ + C_SBQ + h * 64 + d0 * 16 + hi * 8);
    f32x16 o0, o1;
#pragma unroll
    for (int r = 0; r < 16; ++r) { o0[r] = 0.f; o1[r] = 0.f; }
    float carry = 0.f;
    const bf16* ksrc = Pj + (size_t)lane * NPROJ + C_SBK + h * 64 + wid * 8;
    const bf16* vsrc = Pj + (size_t)(16 * (wid & 3) + (lane >> 2)) * NPROJ + C_SBV + h * 64 + (wid >> 2) * 32 + (lane & 3) * 8;
    LAS char* kdst = lds + SB_K + wid * 1024 + lane * 16; LAS char* vdst = lds + SB_V + wid * 1024 + lane * 16;
    const LAS char* kp0 = lds + SB_K + hi * 1024 + r32 * 16;
    const LAS char* vp0 = lds + SB_V + ((lane >> 4) & 1) * 32 + (lane & 3) * 8 + (4 * hi + ((lane & 15) >> 2)) * 64;
    int kt = 4 * qb + 3, par = 0;
    volatile LAS int* flg = (volatile LAS int*)(lds + XTRA_OFF + 1024);
    u32x4 kreg = *(const u32x4*)(ksrc + (size_t)kt * 64 * NPROJ), vreg = *(const u32x4*)(vsrc + (size_t)kt * 64 * NPROJ);
    for (;;) {
        *(LAS u32x4*)kdst = kreg; *(LAS u32x4*)vdst = vreg;
        __syncthreads();
        if (kt > 0) { kreg = *(const u32x4*)(ksrc + (size_t)(kt - 1) * 64 * NPROJ); vreg = *(const u32x4*)(vsrc + (size_t)(kt - 1) * 64 * NPROJ); }
        const int k0 = kt * 64;
        const bool active = (k0 < qw0 + 31) && !__all(carry >= SB_THR);
        if (active) {
            f32x16 p0, p1;
#pragma unroll
            for (int r = 0; r < 16; ++r) { p0[r] = 0.f; p1[r] = 0.f; }
#pragma unroll
            for (int d0 = 0; d0 < 4; ++d0) { const bf16x8 a0 = *(const LAS bf16x8*)(kp0 + d0 * 2048), a1 = *(const LAS bf16x8*)(kp0 + d0 * 2048 + 512);
                p0 = MFMA32(a0, qr[d0], p0); p1 = MFMA32(a1, qr[d0], p1); }
            const bool mask = (k0 + 63 >= qw0);
            float sp[8][4], Mj[8];
#pragma unroll
            for (int j = 0; j < 8; ++j) { float s = 0.f;
#pragma unroll
                for (int i = 0; i < 4; ++i) { const float zl = (j < 4) ? p0[4 * (j & 3) + i] : p1[4 * (j & 3) + i];
                    float v = fmaxf(zl, 0.f) + flog2(1.0f + fexp2(-fabsf(zl)));
                    if (mask) { const int key = k0 + 32 * (j >> 2) + 8 * (j & 3) + 4 * hi + i; v = (key < q) ? v : 0.f; }
                    sp[j][i] = v; s += v; }
                Mj[j] = s; }
            float ps = 0.f; u32x4 pw[4];
#pragma unroll
            for (int j = 7; j >= 0; --j) {
                const auto rr = __builtin_amdgcn_permlane32_swap(__float_as_uint(Mj[j]), __float_as_uint(Mj[j]), false, false);
                const float Pp = __uint_as_float(hi ? rr[0] : rr[1]);
                float C = carry + ps + (hi ? 0.f : Pp);
                float w[4];
#pragma unroll
                for (int i = 3; i >= 0; --i) { const float zl = (j < 4) ? p0[4 * (j & 3) + i] : p1[4 * (j & 3) + i];
                    C += sp[j][i]; float wv = fexp2(zl - C);
                    if (mask) { const int key = k0 + 32 * (j >> 2) + 8 * (j & 3) + 4 * hi + i; wv = (key < q) ? wv : 0.f; }
                    w[i] = wv; }
                pw[j >> 1][2 * (j & 1)] = cvtpk(w[0], w[1]); pw[j >> 1][2 * (j & 1) + 1] = cvtpk(w[2], w[3]);
                ps += Mj[j] + Pp; }
            carry += ps;
#pragma unroll
            for (int ks = 0; ks < 4; ++ks) {
                const s16x4 l0 = vtr(vp0 + ks * 1024), h0 = vtr(vp0 + ks * 1024 + 512), l1 = vtr(vp0 + 4096 + ks * 1024), h1 = vtr(vp0 + 4096 + ks * 1024 + 512);
                const bf16x8 pa = __builtin_bit_cast(bf16x8, pw[ks]);
                o0 = MFMA32(pa, ((bf16x8){l0[0], l0[1], l0[2], l0[3], h0[0], h0[1], h0[2], h0[3]}), o0);
                o1 = MFMA32(pa, ((bf16x8){l1[0], l1[1], l1[2], l1[3], h1[0], h1[1], h1[2], h1[3]}), o1); }
        }
        const int need = (kt > 0) && !__all(carry >= SB_THR);
        if (lane == 0) flg[par * 8 + wid] = need;
        __syncthreads();
        const int any = (flg[par * 8] | flg[par * 8 + 1]) | (flg[par * 8 + 2] | flg[par * 8 + 3]) | (flg[par * 8 + 4] | flg[par * 8 + 5]) | (flg[par * 8 + 6] | flg[par * 8 + 7]);
        par ^= 1;
        if (!any) break;
        --kt;
    }
    bf16* Y = (bf16*)(F.ws + WS_YSB) + (size_t)(b * SEQ + qw0) * 512 + h * 64 + r32;
#pragma unroll
    for (int r = 0; r < 16; ++r) { const int rw = crow(r, hi); Y[(size_t)rw * 512] = (bf16)(cvtpk(o0[r], 0.f) & 0xffffu); Y[(size_t)rw * 512 + 32] = (bf16)(cvtpk(o1[r], 0.f) & 0xffffu); }
}

DI float ret_log2g(int h) { const float x = fexp2(-(float)(5 + h)); return -LOG2E * (x * (1.0f + x * (0.5f + x * (0.33333334f + x * (0.25f + x * 0.2f))))); }
DI int vlay(int tok, int col) { return (col >> 5) * 4096 + (tok >> 4) * 1024 + (tok & 15) * 64 + (col & 31) * 2; }
struct RotRegs { u32x4 a, b; f32x4 c0, c1, s0, s1; };
DI void rot_load(RotRegs& R, const bf16* row  , const float* rope, int pos, int c) {
    R.a = *(const u32x4*)(row + 8 * c); R.b = *(const u32x4*)(row + 32 + 8 * c);
    const float* ct = rope + pos * 32 + 8 * c; const float* st = ct + SEQ * 32;
    R.c0 = *(const f32x4*)ct; R.c1 = *(const f32x4*)(ct + 4); R.s0 = *(const f32x4*)st; R.s1 = *(const f32x4*)(st + 4);
}
DI void rot_apply(const RotRegs& R, f32x4& y1a, f32x4& y1b, f32x4& y2a, f32x4& y2b) {
    f32x4 x1a, x1b, x2a, x2b; unpack8(R.a, x1a, x1b); unpack8(R.b, x2a, x2b);
    y1a = x1a * R.c0 - x2a * R.s0; y1b = x1b * R.c1 - x2b * R.s1; y2a = x1a * R.s0 + x2a * R.c0; y2b = x1b * R.s1 + x2b * R.c1;
}

constexpr int RT_KD = 16384, RT_V = 24576;
DI void rt_unit(Frame& F, int b, int h, int g) {
    const int lane = F.lane, r32 = lane & 31, hi = lane >> 5, wid = F.wave, tid = F.tid, di = wid >> 2, dj = wid & 3;
    LAS char* lds = (LAS char*)F.lds;
    const bf16* Pj = (const bf16*)(F.ws + WS_PROJ) + (size_t)(b * SEQ + g * 512) * NPROJ;
    const float* rope = (const float*)(F.ws + WS_ROPE);
    const float lg = ret_log2g(h);
    f32x16 acc;
#pragma unroll
    for (int r = 0; r < 16; ++r) acc[r] = 0.f;
    const int ktok = tid >> 2, kc = tid & 3;
    RotRegs R; u32x4 v0, v1;
    const int vt0 = tid >> 4, vc0 = tid & 15, vt1 = (tid + 512) >> 4;
#define RT_LOADS(step_) do { const bf16* base_ = Pj + (size_t)((step_) * 64) * NPROJ; \
        if (tid < 256) rot_load(R, base_ + (size_t)ktok * NPROJ + C_RK + h * 64, rope, g * 512 + (step_) * 64 + ktok, kc); \
        v0 = *(const u32x4*)(base_ + (size_t)vt0 * NPROJ + C_RV + h * 128 + 8 * vc0); v1 = *(const u32x4*)(base_ + (size_t)vt1 * NPROJ + C_RV + h * 128 + 8 * vc0); } while (0)
    RT_LOADS(0);
    const LAS char* trb = lds + ((lane >> 4) & 1) * 32 + (lane & 3) * 8 + (4 * hi + ((lane & 15) >> 2)) * 64;
    for (int step = 0; step < 8; ++step) {
        if (tid < 256) { f32x4 y1a, y1b, y2a, y2b; rot_apply(R, y1a, y1b, y2a, y2b); const float dec = fexp2(lg * (float)(511 - (step * 64 + ktok)));
            *(LAS u32x4*)(lds + RT_KD + vlay(ktok, 8 * kc)) = pack8(y1a * dec, y1b * dec); *(LAS u32x4*)(lds + RT_KD + vlay(ktok, 32 + 8 * kc)) = pack8(y2a * dec, y2b * dec); }
        *(LAS u32x4*)(lds + RT_V + vlay(vt0, 8 * vc0)) = v0; *(LAS u32x4*)(lds + RT_V + vlay(vt1, 8 * vc0)) = v1;
        __syncthreads();
        if (step < 7) RT_LOADS(step + 1);
#pragma unroll
        for (int ks = 0; ks < 4; ++ks) {
            const s16x4 al = vtr(trb + RT_KD + di * 4096 + ks * 1024), ah = vtr(trb + RT_KD + di * 4096 + ks * 1024 + 512);
            const s16x4 bl = vtr(trb + RT_V + dj * 4096 + ks * 1024), bh = vtr(trb + RT_V + dj * 4096 + ks * 1024 + 512);
            acc = MFMA32(((bf16x8){al[0], al[1], al[2], al[3], ah[0], ah[1], ah[2], ah[3]}), ((bf16x8){bl[0], bl[1], bl[2], bl[3], bh[0], bh[1], bh[2], bh[3]}), acc); }
        __syncthreads();
    }
    float* G = (float*)(F.ws + WS_GTOT) + (size_t)((b * 8 + h) * 4 + g) * 8192 + dj * 32 + r32;
#pragma unroll
    for (int r = 0; r < 16; ++r) G[(di * 32 + crow(r, hi)) * 128] = acc[r];
}

constexpr int RO_QD = 0, RO_KI = 8192, RO_KD = 16384, RO_V = 24576, RO_SS = 40960, RO_OST = 57344;
DI void ro_unit(Frame& F, int b, int h, int g) {
    const int lane = F.lane, r32 = lane & 31, hi = lane >> 5, wid = F.wave, tid = F.tid, ci = wid >> 2, dj = wid & 3;
    LAS char* lds = (LAS char*)F.lds;
    const bf16* Pg = (const bf16*)(F.ws + WS_PROJ) + (size_t)(b * SEQ + g * 512) * NPROJ;
    const float* rope = (const float*)(F.ws + WS_ROPE);
    const float lg = ret_log2g(h);
    f32x16 st;
#pragma unroll
    for (int r = 0; r < 16; ++r) st[r] = 0.f;
    for (int gp = 0; gp < g; ++gp) { const float coef = fexp2(lg * (float)(512 * (g - 1 - gp)));
        const float* G = (const float*)(F.ws + WS_GTOT) + (size_t)((b * 8 + h) * 4 + gp) * 8192 + dj * 32 + r32;
#pragma unroll
        for (int r = 0; r < 16; ++r) st[r] += coef * G[(ci * 32 + crow(r, hi)) * 128]; }
    const float dec64 = fexp2(lg * 64.0f);
    const bool isq = tid < 256; const int rtok = (tid & 255) >> 2, rc = tid & 3;
    RotRegs R; u32x4 v0, v1, gn0, gn1, gc0, gc1;
    const int vt0 = tid >> 4, vc0 = tid & 15, vt1 = (tid + 512) >> 4;
    const int grow = tid >> 3, gseg = tid & 7;
#define RO_LOADS(n_) do { const bf16* base_ = Pg + (size_t)((n_) * 64) * NPROJ; \
        rot_load(R, base_ + (size_t)rtok * NPROJ + (isq ? C_RQ : C_RK) + h * 64, rope, g * 512 + (n_) * 64 + rtok, rc); \
        v0 = *(const u32x4*)(base_ + (size_t)vt0 * NPROJ + C_RV + h * 128 + 8 * vc0); v1 = *(const u32x4*)(base_ + (size_t)vt1 * NPROJ + C_RV + h * 128 + 8 * vc0); \
        gn0 = *(const u32x4*)(base_ + (size_t)grow * NPROJ + C_RG + h * 128 + gseg * 16); gn1 = *(const u32x4*)(base_ + (size_t)grow * NPROJ + C_RG + h * 128 + gseg * 16 + 8); } while (0)
    RO_LOADS(0);
    const LAS char* trv = lds + ((lane >> 4) & 1) * 32 + (lane & 3) * 8 + (4 * hi + ((lane & 15) >> 2)) * 64;
    const LAS char* trs = lds + ((lane >> 4) & 1) * 32 + (lane & 3) * 8 + (8 * hi + ((lane & 15) >> 2)) * 64;
    for (int n = 0; n < 8; ++n) {
        lds_barrier();
        gc0 = gn0; gc1 = gn1;
        { f32x4 y1a, y1b, y2a, y2b; rot_apply(R, y1a, y1b, y2a, y2b);
          if (isq) { const float s = fexp2(lg * (float)(rtok + 1));
              *(LAS u32x4*)(lds + RO_QD + rc * 1024 + rtok * 16) = pack8(y1a * s, y1b * s); *(LAS u32x4*)(lds + RO_QD + (rc + 4) * 1024 + rtok * 16) = pack8(y2a * s, y2b * s); }
          else { const float si = fexp2(-lg * (float)(rtok + 1)), sd = fexp2(lg * (float)(63 - rtok));
              *(LAS u32x4*)(lds + RO_KI + rc * 1024 + rtok * 16) = pack8(y1a * si, y1b * si); *(LAS u32x4*)(lds + RO_KI + (rc + 4) * 1024 + rtok * 16) = pack8(y2a * si, y2b * si);
              *(LAS u32x4*)(lds + RO_KD + vlay(rtok, 8 * rc)) = pack8(y1a * sd, y1b * sd); *(LAS u32x4*)(lds + RO_KD + vlay(rtok, 32 + 8 * rc)) = pack8(y2a * sd, y2b * sd); } }
        *(LAS u32x4*)(lds + RO_V + vlay(vt0, 8 * vc0)) = v0; *(LAS u32x4*)(lds + RO_V + vlay(vt1, 8 * vc0)) = v1;
#pragma unroll
        for (int r = 0; r < 16; ++r) *(LAS bf16*)(lds + RO_SS + vlay(ci * 32 + crow(r, hi), dj * 32 + r32)) = (bf16)(cvtpk(st[r], 0.f) & 0xffffu);
        lds_barrier();
        if (n < 7) RO_LOADS(n + 1);
        bf16x8 qf[4];
#pragma unroll
        for (int d0 = 0; d0 < 4; ++d0) qf[d0] = *(const LAS bf16x8*)(lds + RO_QD + (2 * d0 + hi) * 1024 + (ci * 32 + r32) * 16);
        f32x16 p0, p1, o;
#pragma unroll
        for (int r = 0; r < 16; ++r) { p0[r] = 0.f; p1[r] = 0.f; o[r] = 0.f; }
#pragma unroll
        for (int d0 = 0; d0 < 4; ++d0) { p0 = MFMA32(*(const LAS bf16x8*)(lds + RO_KI + (2 * d0 + hi) * 1024 + r32 * 16), qf[d0], p0);
            if (ci) p1 = MFMA32(*(const LAS bf16x8*)(lds + RO_KI + (2 * d0 + hi) * 1024 + 512 + r32 * 16), qf[d0], p1); }
        const int ql = ci * 32 + r32;
        u32x4 pw[4];
#pragma unroll
        for (int j = 0; j < 8; ++j) { float w[4];
#pragma unroll
            for (int i = 0; i < 4; ++i) { const float z = (j < 4) ? p0[4 * (j & 3) + i] : p1[4 * (j & 3) + i]; const int key = 32 * (j >> 2) + 8 * (j & 3) + 4 * hi + i; w[i] = (key <= ql) ? z : 0.f; }
            pw[j >> 1][2 * (j & 1)] = cvtpk(w[0], w[1]); pw[j >> 1][2 * (j & 1) + 1] = cvtpk(w[2], w[3]); }
#pragma unroll
        for (int r = 0; r < 16; ++r) st[r] *= dec64;
#pragma unroll
        for (int ks = 0; ks < 4; ++ks) {
            const s16x4 bl = vtr(trv + RO_V + dj * 4096 + ks * 1024), bh = vtr(trv + RO_V + dj * 4096 + ks * 1024 + 512);
            const bf16x8 vf = (bf16x8){bl[0], bl[1], bl[2], bl[3], bh[0], bh[1], bh[2], bh[3]};
            if (ks < 2 || ci) o = MFMA32(__builtin_bit_cast(bf16x8, pw[ks]), vf, o);
            const s16x4 al = vtr(trv + RO_KD + ci * 4096 + ks * 1024), ah = vtr(trv + RO_KD + ci * 4096 + ks * 1024 + 512);
            st = MFMA32(((bf16x8){al[0], al[1], al[2], al[3], ah[0], ah[1], ah[2], ah[3]}), vf, st); }
#pragma unroll
        for (int d0 = 0; d0 < 4; ++d0) { const s16x4 sl = vtr(trs + RO_SS + dj * 4096 + d0 * 1024), sh = vtr(trs + RO_SS + dj * 4096 + d0 * 1024 + 256);
            o = MFMA32(qf[d0], ((bf16x8){sl[0], sl[1], sl[2], sl[3], sh[0], sh[1], sh[2], sh[3]}), o); }
#pragma unroll
        for (int r = 0; r < 16; ++r) *(LAS float*)(lds + RO_OST + ((ci * 32 + crow(r, hi)) * 132 + dj * 32 + r32) * 4) = o[r];
        lds_barrier();
        { const LAS float* orow = (const LAS float*)(lds + RO_OST) + grow * 132 + gseg * 16; f32x4 x[4]; float s = 0.f;
#pragma unroll
          for (int k = 0; k < 4; ++k) { x[k] = *(const LAS f32x4*)(orow + 4 * k); s += (x[k][0] + x[k][1]) + (x[k][2] + x[k][3]); }
          s += __shfl_xor(s, 1); s += __shfl_xor(s, 2); s += __shfl_xor(s, 4);
          const float mu = s * (1.f / 128.f); float qv = 0.f;
#pragma unroll
          for (int k = 0; k < 4; ++k) { x[k] = x[k] - mu; qv += (x[k][0] * x[k][0] + x[k][1] * x[k][1]) + (x[k][2] * x[k][2] + x[k][3] * x[k][3]); }
          qv += __shfl_xor(qv, 1); qv += __shfl_xor(qv, 2); qv += __shfl_xor(qv, 4);
          const float rstd = 1.0f / sqrtf(qv * (1.f / 128.f) + NORM_EPS);
          const size_t trow = (size_t)(b * SEQ + g * 512 + n * 64 + grow);
          f32x4 g0, g1, g2, g3; unpack8(gc0, g0, g1); unpack8(gc1, g2, g3);
          bf16* yo = (bf16*)(F.ws + WS_YRET) + trow * DM + h * 128 + gseg * 16;
          *(u32x4*)yo = pack8(g0 * sig4(g0) * x[0] * rstd, g1 * sig4(g1) * x[1] * rstd); *(u32x4*)(yo + 8) = pack8(g2 * sig4(g2) * x[2] * rstd, g3 * sig4(g3) * x[3] * rstd); }
    }
}

DI void xa_unit(Frame& F, int b, int hx, int qb) {
    const int lane = F.lane, r32 = lane & 31, hi = lane >> 5, wid = F.wave, tid = F.tid;
    LAS char* lds = (LAS char*)F.lds;
    const int qw0 = qb * 256 + wid * 32;
    const bf16* Q = (const bf16*)(F.ws + WS_QX) + (size_t)(b * SEQ + qw0 + r32) * DM + hx * 256 + hi * 8;
    const bf16* KV = (const bf16*)(F.ws + WS_KVMEM) + (size_t)(b * MEML) * 2048 + hx * 256;
    bf16x8 qr[16];
#pragma unroll
    for (int d0 = 0; d0 < 16; ++d0) qr[d0] = *(const bf16x8*)(Q + d0 * 16);
    __syncthreads();
#pragma unroll 4
    for (int j = 0; j < 16; ++j) { const int i = tid + 512 * j, c = i & 31, key = i >> 5;
        *(LAS u32x4*)(lds + (key >> 6) * 32768 + c * 1024 + (key & 63) * 16) = *(const u32x4*)(KV + (size_t)key * 2048 + 8 * c); }
    __syncthreads();
    f32x16 sc[8];
#pragma unroll
    for (int t = 0; t < 8; ++t)
#pragma unroll
        for (int r = 0; r < 16; ++r) sc[t][r] = 0.f;
#pragma unroll
    for (int kt = 0; kt < 4; ++kt)
#pragma unroll
        for (int d0 = 0; d0 < 16; ++d0) { const LAS char* kp = lds + kt * 32768 + (2 * d0 + hi) * 1024 + r32 * 16;
            sc[2 * kt] = MFMA32(*(const LAS bf16x8*)kp, qr[d0], sc[2 * kt]); sc[2 * kt + 1] = MFMA32(*(const LAS bf16x8*)(kp + 512), qr[d0], sc[2 * kt + 1]); }
    float mx = -3.0e38f;
#pragma unroll
    for (int t = 0; t < 8; ++t)
#pragma unroll
        for (int r = 0; r < 16; ++r) mx = fmaxf(mx, sc[t][r]);
    { const auto rr = __builtin_amdgcn_permlane32_swap(__float_as_uint(mx), __float_as_uint(mx), false, false); mx = fmaxf(__uint_as_float(rr[0]), __uint_as_float(rr[1])); }
    float l = 0.f; u32x4 pa[16];
#pragma unroll
    for (int t = 0; t < 8; ++t)
#pragma unroll
        for (int r2 = 0; r2 < 8; ++r2) { const float e0 = fexp2(sc[t][2 * r2] - mx), e1 = fexp2(sc[t][2 * r2 + 1] - mx); l += e0 + e1; pa[2 * t + (r2 >> 2)][r2 & 3] = cvtpk(e0, e1); }
    { const auto rr = __builtin_amdgcn_permlane32_swap(__float_as_uint(l), __float_as_uint(l), false, false); l = __uint_as_float(rr[0]) + __uint_as_float(rr[1]); }
    LAS float* wsf = (LAS float*)(lds + XTRA_OFF) + wid * 32;
    if (hi == 0) wsf[r32] = 1.0f / l;
    __syncthreads();
#pragma unroll 4
    for (int j = 0; j < 16; ++j) { const int i = tid + 512 * j, c = i & 31, key = i >> 5;
        *(LAS u32x4*)(lds + (key >> 6) * 32768 + (c >> 2) * 4096 + ((key & 63) >> 4) * 1024 + (key & 15) * 64 + (c & 3) * 16) = *(const u32x4*)(KV + (size_t)key * 2048 + 1024 + 8 * c); }
    __syncthreads();
    f32x16 o[8];
#pragma unroll
    for (int t = 0; t < 8; ++t)
#pragma unroll
        for (int r = 0; r < 16; ++r) o[t][r] = 0.f;
    const LAS char* vp0 = lds + ((lane >> 4) & 1) * 32 + (lane & 3) * 8 + (4 * hi + ((lane & 15) >> 2)) * 64;
#pragma unroll
    for (int vt = 0; vt < 4; ++vt)
#pragma unroll
        for (int ks = 0; ks < 4; ++ks) { const bf16x8 pf = __builtin_bit_cast(bf16x8, pa[4 * vt + ks]);
#pragma unroll
            for (int d0 = 0; d0 < 8; ++d0) { const s16x4 lo = vtr(vp0 + vt * 32768 + d0 * 4096 + ks * 1024), hh = vtr(vp0 + vt * 32768 + d0 * 4096 + ks * 1024 + 512);
                o[d0] = MFMA32(pf, ((bf16x8){lo[0], lo[1], lo[2], lo[3], hh[0], hh[1], hh[2], hh[3]}), o[d0]); } }
    bf16* O = (bf16*)(F.ws + WS_OX) + (size_t)(b * SEQ + qw0) * DM + hx * 256 + r32;
#pragma unroll
    for (int r = 0; r < 16; ++r) { const int rw = crow(r, hi); const float il = wsf[rw];
#pragma unroll
        for (int d0 = 0; d0 < 8; ++d0) O[(size_t)rw * DM + d0 * 32] = (bf16)(cvtpk(o[d0][r] * il, 0.f) & 0xffffu); }
}

DI void route_a(Frame& F, int tb) {
    const int lane = F.lane, wid = F.wave, tid = F.tid, tg = wid >> 2, kq = wid & 3, hi = lane >> 5, e31 = lane & 31;
    LAS char* lds = (LAS char*)F.lds;
    const float* wr = inp(F, I_WROUTER); const float* gm = inp(F, I_GMOE); const bf16* x2 = (const bf16*)(F.ws + WS_XN3U);
    unsigned char* sm = F.ws + WS_SMALL;
    __syncthreads();
#pragma unroll 4
    for (int j = 0; j < 16; ++j) { const int i = tid + 512 * j, k = i >> 3, e4 = (i & 7) * 4; *(LAS f32x4*)(lds + (k * 32 + e4) * 4) = *(const f32x4*)(wr + k * 32 + e4) * gm[k]; }
    __syncthreads();
    const int tok = tb * 64 + tg * 32 + e31;
    const bf16* xr = x2 + (size_t)tok * DM + kq * 256 + 4 * hi;
    f32x16 acc;
#pragma unroll
    for (int r = 0; r < 16; ++r) acc[r] = 0.f;
    float ss = 0.f;
    const LAS float* WR = (const LAS float*)lds + (kq * 256 + 4 * hi) * 32 + e31;
    u32x2 xv[32];
#pragma unroll
    for (int m = 0; m < 32; ++m) xv[m] = *(const u32x2*)(xr + 8 * m);
#pragma unroll
    for (int m = 0; m < 32; ++m) { const f32x4 x4 = (f32x4){bflo(xv[m].x), bfhi(xv[m].x), bflo(xv[m].y), bfhi(xv[m].y)}; ss += (x4[0] * x4[0] + x4[1] * x4[1]) + (x4[2] * x4[2] + x4[3] * x4[3]);
#pragma unroll
        for (int t = 0; t < 4; ++t) acc = __builtin_amdgcn_mfma_f32_32x32x2f32(x4[t], WR[(8 * m + t) * 32], acc, 0, 0, 0); }
    ss += __shfl_xor(ss, 32);
    __syncthreads();
    LAS float* PL = (LAS float*)lds;
    LAS float* SSP = (LAS float*)(lds + 32768);
    LAS float* LG = (LAS float*)(lds + 36864);
    LAS int* SEL = (LAS int*)(lds + 49152);
#pragma unroll
    for (int r = 0; r < 16; ++r) PL[(kq * 64 + tg * 32 + crow(r, hi)) * 32 + e31] = acc[r];
    if (hi == 0) SSP[kq * 64 + tg * 32 + e31] = ss;
    __syncthreads();
#pragma unroll
    for (int j = 0; j < 4; ++j) { const int idx = tid + 512 * j, tl = idx >> 5, e = idx & 31;
        const float rstd = 1.0f / sqrtf(((SSP[tl] + SSP[64 + tl]) + (SSP[128 + tl] + SSP[192 + tl])) * (1.f / DM) + NORM_EPS);
        LG[tl * 33 + e] = rstd * ((PL[tl * 32 + e] + PL[(64 + tl) * 32 + e]) + (PL[(128 + tl) * 32 + e] + PL[(192 + tl) * 32 + e])) + inp(F, I_BROUTER)[e];
        if (e == 0) ((float*)(sm + SM_RSTD3))[tb * 64 + tl] = rstd; }
    __syncthreads();
    if (tid < 64) {
        int sel[4]; float val[4];
#pragma unroll
        for (int k = 0; k < 4; ++k) { float best = -3.0e38f; int bi = 0;
            for (int e = 0; e < 32; ++e) { const float v = LG[tid * 33 + e]; bool taken = false;
#pragma unroll
                for (int k2 = 0; k2 < 4; ++k2) if (k2 < k) taken = taken || (sel[k2] == e);
                if (!taken && v > best) { best = v; bi = e; } }
            sel[k] = bi; val[k] = best; }
        float ex[4], sum = 0.f;
#pragma unroll
        for (int k = 0; k < 4; ++k) { ex[k] = fexp2((val[k] - val[0]) * LOG2E); sum += ex[k]; }
        const float inv = 1.0f / sum; const int tk = tb * 64 + tid;
#pragma unroll
        for (int k = 0; k < 4; ++k) { ((int*)(sm + SM_TOPE))[tk * 4 + k] = sel[k]; ((float*)(sm + SM_GATE))[tk * 4 + k] = ex[k] * inv; SEL[tid * 4 + k] = sel[k]; }
    }
    __syncthreads();
    LAS int* WC = (LAS int*)(lds + 51200);
    int e_my = 0, rank_w = 0;
    if (tid < 256) { e_my = SEL[tid]; const unsigned long long lt = (1ull << lane) - 1ull;
        for (int ex = 0; ex < 32; ++ex) { const unsigned long long m = __ballot(e_my == ex); if (e_my == ex) rank_w = __popcll(m & lt); if (lane == ex) WC[wid * 32 + ex] = __popcll(m); } }
    __syncthreads();
    if (tid < 256) { int rank = rank_w; for (int w = 0; w < wid; ++w) rank += WC[w * 32 + e_my]; ((int*)(sm + SM_LRANK))[(tb * 64 + (tid >> 2)) * 4 + (tid & 3)] = rank; }
    else if (tid < 288) { const int e = tid - 256; ((int*)(sm + SM_CNT))[tb * 32 + e] = (WC[e] + WC[32 + e]) + (WC[64 + e] + WC[96 + e]); }
}

DI void route_b(Frame& F, int tb) {
    const int lane = F.lane, wid = F.wave, tid = F.tid;
    LAS int* L = (LAS int*)F.lds;
    unsigned char* sm = F.ws + WS_SMALL;
    const int* CNT = (const int*)(sm + SM_CNT);
    u32x4 xv[8][2];
#pragma unroll
    for (int j = 0; j < 8; ++j) { const u32x4* sp = (const u32x4*)((const bf16*)(F.ws + WS_XN3U) + (size_t)(tb * 64 + wid * 8 + j) * DM) + 2 * lane; xv[j][0] = sp[0]; xv[j][1] = sp[1]; }
    __syncthreads();
    { const int e = tid & 31, seg = tid >> 5; int t = 0, p = 0;
      for (int w = seg * 16; w < seg * 16 + 16; ++w) { const int c = CNT[w * 32 + e]; t += c; p += (w < tb) ? c : 0; }
      L[seg * 32 + e] = t; L[512 + seg * 32 + e] = p; }
    __syncthreads();
    if (tid < 32) { int t = 0, p = 0; for (int s = 0; s < 16; ++s) { t += L[s * 32 + tid]; p += L[512 + s * 32 + tid]; } L[1024 + tid] = t; L[1056 + tid] = p; }
    __syncthreads();
    if (tid == 0) { int run = 0; for (int e = 0; e < 32; ++e) { L[1088 + e] = run; run += ((L[1024 + e] + 255) >> 8) << 8; } L[1120] = run >> 8; }
    __syncthreads();
    if (tid < 256) { const int tok = tb * 64 + (tid >> 2), a = tok * 4 + (tid & 3); const int e = ((const int*)(sm + SM_TOPE))[a];
        const int row = L[1088 + e] + L[1056 + e] + ((const int*)(sm + SM_LRANK))[a];
        ((int*)(sm + SM_AROW))[a] = row; ((float*)(sm + SM_RSCALE))[row] = ((const float*)(sm + SM_RSTD3))[tok]; ((float*)(sm + SM_RGATE))[row] = ((const float*)(sm + SM_GATE))[a]; L[1152 + tid] = row; }
    if (tb == 0 && tid >= 256 && tid < 288) { const int e = tid - 256, nb = (L[1024 + e] + 255) >> 8, b0 = L[1088 + e] >> 8; int* BLKE = (int*)(sm + SM_BLKE);
        for (int i = 0; i < nb; ++i) BLKE[b0 + i] = e; if (e == 0) BLKE[MAXBLK] = L[1120]; }
    __syncthreads();
    unsigned char* XG = F.ws + WS_XG;
    f32x4 gm[4];
#pragma unroll
    for (int k = 0; k < 4; ++k) gm[k] = *((const f32x4*)inp(F, I_GMOE) + 4 * lane + k);
#pragma unroll
    for (int j = 0; j < 8; ++j) { const u32x4 v0 = xv[j][0], v1 = xv[j][1]; u32x4 o;
        o.x = cvt4_fp8(bflo(v0.x) * gm[0][0], bfhi(v0.x) * gm[0][1], bflo(v0.y) * gm[0][2], bfhi(v0.y) * gm[0][3]); o.y = cvt4_fp8(bflo(v0.z) * gm[1][0], bfhi(v0.z) * gm[1][1], bflo(v0.w) * gm[1][2], bfhi(v0.w) * gm[1][3]);
        o.z = cvt4_fp8(bflo(v1.x) * gm[2][0], bfhi(v1.x) * gm[2][1], bflo(v1.y) * gm[2][2], bfhi(v1.y) * gm[2][3]); o.w = cvt4_fp8(bflo(v1.z) * gm[3][0], bfhi(v1.z) * gm[3][1], bflo(v1.w) * gm[3][2], bfhi(v1.w) * gm[3][3]);
#pragma unroll
        for (int k = 0; k < 4; ++k) *((u32x4*)(XG + (size_t)L[1152 + (wid * 8 + j) * 4 + k] * DM) + lane) = o; }
}

DI void combine_final(Frame& F) {
    const int gw = F.bid * NWAVES + F.wave, NGW = F.G * NWAVES, lane = F.lane;
    const bf16* x2 = (const bf16*)(F.ws + WS_XN3U); const bf16* Y = (const bf16*)(F.ws + WS_YROWS); const int* AROW = (const int*)(F.ws + WS_SMALL + SM_AROW);
    const f32x4* gf = (const f32x4*)inp(F, I_GFINAL) + lane;
    for (int tok = gw; tok < T; tok += NGW) {
        const u32x2* xr = (const u32x2*)(x2 + (size_t)tok * DM) + lane; f32x4 v[4];
#pragma unroll
        for (int j = 0; j < 4; ++j) { const u32x2 w = xr[64 * j]; v[j] = (f32x4){bflo(w.x), bfhi(w.x), bflo(w.y), bfhi(w.y)}; }
#pragma unroll
        for (int k = 0; k < 4; ++k) { const int row = AROW[tok * 4 + k]; const u32x2* yr = (const u32x2*)(Y + (size_t)row * DM) + lane;
#pragma unroll
            for (int j = 0; j < 4; ++j) { const u32x2 w = yr[64 * j]; v[j] += (f32x4){bflo(w.x), bfhi(w.x), bflo(w.y), bfhi(w.y)}; } }
        float s = 0.f;
#pragma unroll
        for (int j = 0; j < 4; ++j) s += (v[j][0] * v[j][0] + v[j][1] * v[j][1]) + (v[j][2] * v[j][2] + v[j][3] * v[j][3]);
        const float rstd = 1.0f / sqrtf(wave_sum(s) * (1.f / DM) + NORM_EPS);
        f32x4* o = (f32x4*)(F.out + (size_t)tok * DM) + lane;
#pragma unroll
        for (int j = 0; j < 4; ++j) o[64 * j] = v[j] * rstd * gf[64 * j];
    }
}

constexpr int NPHASE = 14;
#ifndef WGM_P1
#define WGM_P1 2
#endif
#ifndef WGM_MOE
#define WGM_MOE 4
#endif
__global__ void __launch_bounds__(NWAVES * 64, 2) mega_fwd(Args args) {
    extern __shared__ __attribute__((aligned(16))) unsigned char lds_raw[];
    Frame F;
    F.lds = (LAS unsigned char*)lds_raw; F.ws = args.ws; F.out = args.out;
    F.tid = threadIdx.x; F.lane = F.tid & 63; F.wave = __builtin_amdgcn_readfirstlane(F.tid >> 6); F.G = gridDim.x; F.bid = blockIdx.x;
    F.kp = (kptr_t)__builtin_amdgcn_kernarg_segment_ptr();
    if (F.tid < 64) ((LAS unsigned*)(F.lds + LDSCTL_OFF))[F.tid] = 0u;
    __syncthreads();
    const int lo = args.ph_lo, hi = args.ph_hi;
    XcdBarrier bar; bar.bar = (unsigned*)(F.ws + WS_CTL) + CW_BAR; bar.x = 0; bar.st = nullptr;
    if (hi - lo > 1) bar = xcd_barrier_post((unsigned*)(F.ws + WS_CTL) + CW_BAR, (volatile LAS unsigned*)(F.lds + LDSCTL_OFF) + 8);
#ifndef PHASE_MASK
#define PHASE_MASK 0xFFFF
#endif
#define IN(k) (((PHASE_MASK >> (k)) & 1) && lo <= (k) && (k) < hi)
#ifndef PROBE_MASK
#define PROBE_MASK 0
#endif
#define REP(k) (((PROBE_MASK >> (k)) & 1) ? 2 : 1)
#define LAUNDER() do { asm volatile("" : "+s"(F.kp), "+s"(F.ws), "+s"(F.out), "+v"(F.tid), "+s"(F.bid), "+s"(F.G)); F.lane = F.tid & 63; F.wave = __builtin_amdgcn_readfirstlane(F.tid >> 6); ws = F.ws; } while (0)
#define PHASE(k, ...) do { if (IN(k)) { __VA_ARGS__ if (REP(k) == 2) { xcd_barrier(bar); LAUNDER(); __VA_ARGS__ } } } while (0)
#ifdef DOUBLE_BAR
#define SEAM(k) do { if (IN(k) && IN((k) + 1)) { xcd_barrier(bar); xcd_barrier(bar); } LAUNDER(); } while (0)
#else
#define SEAM(k) do { if (IN(k) && IN((k) + 1)) xcd_barrier(bar); LAUNDER(); } while (0)
#endif
    unsigned char* ws = F.ws;
    LAS unsigned char* ring = F.lds + RING_OFF;

    PHASE(0, { p0_prologue(F); }); SEAM(0);

    PHASE(1, {
        const bool conv_first = (F.bid & 1) != 0;
        if (conv_first) { p0_experts(F, F.bid * NWAVES + F.wave, F.G * NWAVES); __syncthreads(); }
        pg8::Sched2 S{(const bf16*)(ws + WS_XN1), (const bf16*)(ws + WS_WIN), T / 256, NPROJ / 256, (const bf16*)(ws + WS_MEMN), (const bf16*)(ws + WS_WCKV), (BATCH * MEML) / 256, 2048 / 256, F.G, F.bid, 1024, WGM_P1};
        Epi1 E{(bf16*)(ws + WS_PROJ), (bf16*)(ws + WS_KVMEM)};
        pg8::gemm_phase(ring, 1024, S, E);
        if (!conv_first) { p0_experts(F, F.bid * NWAVES + F.wave, F.G * NWAVES); }
    }); SEAM(1);

    PHASE(2, {
        for (int L = F.bid; L < 512 + 192; L += F.G) {
            if (L < 512) sb_unit(F, L >> 6, (L >> 3) & 7, L & 7);
            else { const int q = L - 512; rt_unit(F, (q / 3) >> 3, (q / 3) & 7, q % 3); }
        }
    }); SEAM(2);

    PHASE(3, { for (int L = F.bid; L < 256; L += F.G) ro_unit(F, L >> 5, (L >> 2) & 7, L & 3); }); SEAM(3);

    PHASE(4, {
        { pg8::Sched2 S{(const bf16*)(ws + WS_YSB), (const bf16*)(ws + WS_WSBO), T / 256, 4, nullptr, nullptr, 0, 1, F.G, F.bid, 512};
          Epi5a E{(const bf16*)(ws + WS_PROJ), (bf16*)(ws + WS_TMP)}; pg8::gemm_phase(ring, 512, S, E); }
        { pg8::Sched2 S{(const bf16*)(ws + WS_YRET), (const bf16*)(ws + WS_WRETO), T / 256, 4, nullptr, nullptr, 0, 1, F.G, F.bid, 1024};
          Epi5b E{(const bf16*)(ws + WS_PROJ), (const bf16*)(ws + WS_TMP), (bf16*)(ws + WS_MERGED)}; pg8::gemm_phase(ring, 1024, S, E); }
    }); SEAM(4);

    PHASE(5, {
        pg8::Sched2 S{(const bf16*)(ws + WS_MERGED), (const bf16*)(ws + WS_WMIX), T / 256, 4, nullptr, nullptr, 0, 1, F.G, F.bid, 1024};
        EpiRes<true> E{inp(F, I_X), (bf16*)(ws + WS_XN2U), (float*)(ws + WS_SLOTS)}; pg8::gemm_phase(ring, 1024, S, E);
    }); SEAM(5);

    PHASE(6, {
        pg8::Sched2 S{(const bf16*)(ws + WS_XN2U), (const bf16*)(ws + WS_WCQ), T / 256, 4, nullptr, nullptr, 0, 1, F.G, F.bid, 1024};
        Epi7 E{(const float*)(ws + WS_SLOTS), (bf16*)(ws + WS_QX)}; pg8::gemm_phase(ring, 1024, S, E);
    }); LAUNDER();

    PHASE(7, { for (int L = F.bid; L < 256; L += F.G) { int pm_, pn_; pg8::map_unit(L, 256, 64, 4, pm_, pn_); xa_unit(F, pm_ >> 3, pn_, pm_ & 7); } }); SEAM(7);

    PHASE(8, {
        pg8::Sched2 S{(const bf16*)(ws + WS_OX), (const bf16*)(ws + WS_WCO), T / 256, 4, nullptr, nullptr, 0, 1, F.G, F.bid, 1024};
        EpiRes<false> E{(const void*)(ws + WS_XN2U), (bf16*)(ws + WS_XN3U), nullptr}; pg8::gemm_phase(ring, 1024, S, E);
    }); SEAM(8);

    PHASE(9, { for (int tb = F.bid; tb < T / 64; tb += F.G) route_a(F, tb); }); SEAM(9);
    PHASE(10, { for (int tb = F.bid; tb < T / 64; tb += F.G) route_b(F, tb); }); SEAM(10);

    PHASE(11, {
        const int* BLKE = (const int*)(ws + WS_SMALL + SM_BLKE); const int nblk = __builtin_amdgcn_readfirstlane(__hip_atomic_load(BLKE + MAXBLK, RLX_AGENT));
        pg8::SchedMoE S{ws + WS_XG, ws + WS_WE1, BLKE, nblk, 8, F.G, F.bid, 1024, (size_t)2048 * 1024, WGM_MOE};
        Epi12 E{(const float*)(ws + WS_SMALL + SM_RSCALE), inp(F, I_BE1), ws + WS_ACT}; pg8::gemm_phase(ring, 1024, S, E);
    }); SEAM(11);

    PHASE(12, {
        const int* BLKE = (const int*)(ws + WS_SMALL + SM_BLKE); const int nblk = __builtin_amdgcn_readfirstlane(__hip_atomic_load(BLKE + MAXBLK, RLX_AGENT));
        pg8::SchedMoE S{ws + WS_ACT, ws + WS_WE2, BLKE, nblk, 4, F.G, F.bid, 1024, (size_t)1024 * 1024, WGM_MOE};
        Epi13 E{(const float*)(ws + WS_SMALL + SM_RGATE), inp(F, I_BE2), (bf16*)(ws + WS_YROWS)}; pg8::gemm_phase(ring, 1024, S, E);
    }); SEAM(12);

    PHASE(13, { combine_final(F); });
#undef IN
#undef SEAM
}

#if MK_DEBUG
DI unsigned hsh(unsigned x) { x ^= x >> 16; x *= 0x7feb352du; x ^= x >> 15; x *= 0x846ca68bu; x ^= x >> 16; return x; }
DI void chk_report(unsigned char* ws, int phase, float got, float ref, float atol) {
    float e = fabsf(got - ref) / (fabsf(ref) + atol); if (!(e == e)) e = 1.0e9f; if (e > 1.0e9f) e = 1.0e9f;
    atomicMax((unsigned*)(ws + WS_CTL) + CW_CHK + phase, __float_as_uint(e));
}
DI float dbg_bf(const bf16* p, size_t i) { return bf2f(p[i]); }
DI float dbg_f8(const unsigned char* p, size_t i) { const unsigned b = p[i]; const int e = (b >> 3) & 15, m = b & 7; const float v = e ? (1.0f + m * 0.125f) * exp2f((float)(e - 7)) : m * 0.125f * 0.015625f; return (b & 128) ? -v : v; }
DI float dbg_sigm(float x) { return 1.0f / (1.0f + expf(-x)); }
DI float dbg_rope(const float* rope, int pos, int i, bool sn) { return rope[(sn ? SEQ * 32 : 0) + pos * 32 + i]; }
DI float dbg_rot(const bf16* row, const float* rope, int pos, int d) {
    const int i = d & 31; const float x1 = bf2f(row[i]), x2 = bf2f(row[32 + i]); const float c = dbg_rope(rope, pos, i, false), s = dbg_rope(rope, pos, i, true);
    return d < 32 ? x1 * c - x2 * s : x1 * s + x2 * c;
}
__global__ void __launch_bounds__(64) dbg_kernel(Args a, int phase) {
    const unsigned sid = blockIdx.x * 64 + threadIdx.x; unsigned char* ws = a.ws;
    const unsigned r0 = hsh(sid * 4 + 1 + phase * 7919), r1 = hsh(sid * 4 + 2 + phase * 104729), r2 = hsh(sid * 4 + 3 + phase * 31), r3 = hsh(sid * 4 + 4 + phase * 17);
    const float* rope = (const float*)(ws + WS_ROPE);
    const bf16* PROJ = (const bf16*)(ws + WS_PROJ);
    if (phase == 0) {
        const int which = sid % 12;
        if (which == 7 || which == 8) {   } else if (which < 9) {
            const float* W; const bf16* WT; int K, N; int e = 0;
            switch (which) { case 0: W = a.in[I_WIN]; WT = (const bf16*)(ws + WS_WIN); K = 1024; N = NPROJ; break; case 1: W = a.in[I_WSBO]; WT = (const bf16*)(ws + WS_WSBO); K = 512; N = 1024; break;
                case 2: W = a.in[I_WRETO]; WT = (const bf16*)(ws + WS_WRETO); K = 1024; N = 1024; break; case 3: W = a.in[I_WMIX]; WT = (const bf16*)(ws + WS_WMIX); K = 1024; N = 1024; break;
                case 4: W = a.in[I_WCQ]; WT = (const bf16*)(ws + WS_WCQ); K = 1024; N = 1024; break; case 5: W = a.in[I_WCKV]; WT = (const bf16*)(ws + WS_WCKV); K = 1024; N = 2048; break;
                case 6: W = a.in[I_WCO]; WT = (const bf16*)(ws + WS_WCO); K = 1024; N = 1024; break;
                case 7: e = r2 % 32; W = a.in[I_WE1] + (size_t)e * 1024 * 2048; WT = (const bf16*)(ws + WS_WE1 + (size_t)e * 2048 * 1024); K = 1024; N = 2048; break;
                default: e = r2 % 32; W = a.in[I_WE2] + (size_t)e * 1024 * 1024; WT = (const bf16*)(ws + WS_WE2 + (size_t)e * 1024 * 1024); K = 1024; N = 1024; break; }
            const int k = r0 % K, n = r1 % N; int nr = n; if (which == 7) nr = n < 1024 ? 256 * (n >> 7) + (n & 127) : 256 * ((n - 1024) >> 7) + 128 + ((n - 1024) & 127);
            if (which >= 7) chk_report(ws, 0, dbg_f8((const unsigned char*)WT, (size_t)nr * K + k), W[(size_t)k * N + n] * 64.0f, 0.5f);
            else { const float ref = bf2f((bf16)(cvtpk(W[(size_t)k * N + n], 0.f) & 0xffffu)); chk_report(ws, 0, dbg_bf(WT, (size_t)nr * K + k), ref, 1e-6f); }
        } else if (which < 11) {
            const bool isx = which == 9; const int row = isx ? r0 % T : r0 % (BATCH * MEML), col = r1 % DM;
            const float* xr = (isx ? a.in[I_X] : a.in[I_MEM]) + (size_t)row * DM; double ss = 0; for (int k = 0; k < DM; ++k) ss += (double)xr[k] * xr[k];
            const float ref = xr[col] * (float)(1.0 / sqrt(ss / DM + 1e-5)) * (isx ? a.in[I_GMIX] : a.in[I_GMEM])[col];
            chk_report(ws, 0, dbg_bf((const bf16*)(ws + (isx ? WS_XN1 : WS_MEMN)), (size_t)row * DM + col), ref, 0.5f);
        } else { const int pos = r0 % SEQ, i = r1 % 32; const double inv = exp2(-(double)i * 13.287712379549449 / 32.0); const float angf = (float)pos * (float)inv; double an = (double)angf; an -= 6.283185307179586 * rint(an / 6.283185307179586);
            const float rev = (float)(an / 6.283185307179586); chk_report(ws, 0, dbg_rope(rope, pos, i, false), __builtin_amdgcn_cosf(rev), 0.5f); chk_report(ws, 0, dbg_rope(rope, pos, i, true), __builtin_amdgcn_sinf(rev), 0.5f); }
    } else if (phase == 1) {
        if (sid % 3 == 2) {
            const int e = r2 % 32; const bool w1 = (sid & 4) != 0; const int K = 1024, N = w1 ? 2048 : 1024; const float* W = (w1 ? a.in[I_WE1] : a.in[I_WE2]) + (size_t)e * K * N; const unsigned char* WT = ws + (w1 ? WS_WE1 : WS_WE2) + (size_t)e * N * K;
            const int k = r0 % K, n = r1 % N; int nr = n; if (w1) nr = n < 1024 ? 256 * (n >> 7) + (n & 127) : 256 * ((n - 1024) >> 7) + 128 + ((n - 1024) & 127);
            chk_report(ws, 1, dbg_f8(WT, (size_t)nr * K + k), W[(size_t)k * N + n] * 64.0f, 0.5f);
        } else if (sid & 1) { const int row = r0 % T, col = r1 % NPROJ; const bf16* xr = (const bf16*)(ws + WS_XN1) + (size_t)row * DM; const float* W = a.in[I_WIN]; double s = 0; for (int k = 0; k < DM; ++k) s += (double)bf2f(xr[k]) * W[(size_t)k * NPROJ + col];
            const float sc = col < 512 ? SBQ_SCALE : ((col >= C_RK && col < C_RV) ? 0.125f : 1.0f); chk_report(ws, 1, dbg_bf(PROJ, (size_t)row * NPROJ + col), (float)s * sc, sc); }
        else { const int row = r0 % (BATCH * MEML), col = r1 % 2048; const bf16* xr = (const bf16*)(ws + WS_MEMN) + (size_t)row * DM; const float* W = a.in[I_WCKV]; double s = 0; for (int k = 0; k < DM; ++k) s += (double)bf2f(xr[k]) * W[(size_t)k * 2048 + col];
            chk_report(ws, 1, dbg_bf((const bf16*)(ws + WS_KVMEM), (size_t)row * 2048 + col), (float)s, 1.0f); }
    } else if (phase == 2) {
        if (sid & 1) {
            const int b = r0 % BATCH, h = r1 % 8, t = (sid & 2) ? r2 % SEQ : r2 % 300, d = r3 % 64; const bf16* Pb = PROJ + (size_t)b * SEQ * NPROJ; const bf16* qrow = Pb + (size_t)t * NPROJ + C_SBQ + h * 64;
            double o = 0, between = 0;
            for (int s = t - 1; s >= 0; --s) { const bf16* krow = Pb + (size_t)s * NPROJ + C_SBK + h * 64; double zl = 0; for (int k = 0; k < 64; ++k) zl += (double)bf2f(qrow[k]) * bf2f(krow[k]);
                const double z = zl / 1.4426950408889634; const double lsp = z > 0 ? z + log1p(exp(-z)) : log1p(exp(z));
                const double w = exp(z - lsp + between); between -= lsp; o += w * bf2f(Pb[(size_t)s * NPROJ + C_SBV + h * 64 + d]); if (between < -200.0) break; }
            chk_report(ws, 2, dbg_bf((const bf16*)(ws + WS_YSB), (size_t)(b * SEQ + t) * 512 + h * 64 + d), (float)o, 0.5f);
        } else {
            const int b = r0 % BATCH, h = r1 % 8, g = r2 % 3, dk = r3 % 64, dv = (r3 >> 8) % 128; const double gam = 1.0 - exp2(-5.0 - h); double s = 0;
            for (int p = 0; p < 512; ++p) { const int pos = g * 512 + p; const bf16* row = PROJ + (size_t)(b * SEQ + pos) * NPROJ; s += pow(gam, 511 - p) * dbg_rot(row + C_RK + h * 64, rope, pos, dk) * bf2f(row[C_RV + h * 128 + dv]); }
            chk_report(ws, 2, ((const float*)(ws + WS_GTOT))[(size_t)((b * 8 + h) * 4 + g) * 8192 + dk * 128 + dv], (float)s, 0.5f);
        }
    } else if (phase == 3) {
        const int b = r0 % BATCH, h = r1 % 8, t = (sid & 1) ? r2 % SEQ : r2 % 200; const double gam = 1.0 - exp2(-5.0 - h); const bf16* Pb = PROJ + (size_t)b * SEQ * NPROJ;
        float q[64];
#pragma unroll
        for (int d = 0; d < 64; ++d) q[d] = dbg_rot(Pb + (size_t)t * NPROJ + C_RQ + h * 64, rope, t, d);
        float o[128];
#pragma unroll
        for (int e = 0; e < 128; ++e) o[e] = 0.f;
        for (int s = 0; s <= t; ++s) { const bf16* row = Pb + (size_t)s * NPROJ; float dot = 0.f;
#pragma unroll
            for (int d = 0; d < 64; ++d) dot += q[d] * dbg_rot(row + C_RK + h * 64, rope, s, d);
            const float w = dot * (float)pow(gam, t - s);
#pragma unroll
            for (int e = 0; e < 128; ++e) o[e] += w * bf2f(row[C_RV + h * 128 + e]); }
        float mu = 0.f;
#pragma unroll
        for (int e = 0; e < 128; ++e) mu += o[e];
        mu *= (1.f / 128.f); float var = 0.f;
#pragma unroll
        for (int e = 0; e < 128; ++e) var += (o[e] - mu) * (o[e] - mu);
        const float rstd = 1.0f / sqrtf(var * (1.f / 128.f) + 1e-5f);
#pragma unroll
        for (int e = 0; e < 128; ++e) { const float gv = bf2f(Pb[(size_t)t * NPROJ + C_RG + h * 128 + e]); chk_report(ws, 3, dbg_bf((const bf16*)(ws + WS_YRET), (size_t)(b * SEQ + t) * DM + h * 128 + e), gv * dbg_sigm(gv) * (o[e] - mu) * rstd, 1.0f); }
    } else if (phase == 4) {
        const int row = r0 % T, col = r1 % DM; const bf16* ys = (const bf16*)(ws + WS_YSB) + (size_t)row * 512; const bf16* yr = (const bf16*)(ws + WS_YRET) + (size_t)row * DM; double s1 = 0, s2 = 0;
        for (int k = 0; k < 512; ++k) s1 += (double)bf2f(ys[k]) * a.in[I_WSBO][(size_t)k * DM + col]; for (int k = 0; k < DM; ++k) s2 += (double)bf2f(yr[k]) * a.in[I_WRETO][(size_t)k * DM + col];
        const float ref = dbg_sigm(bf2f(PROJ[(size_t)row * NPROJ + C_GSB + col])) * (float)s1 + dbg_sigm(bf2f(PROJ[(size_t)row * NPROJ + C_GRET + col])) * (float)s2;
        chk_report(ws, 4, dbg_bf((const bf16*)(ws + WS_MERGED), (size_t)row * DM + col), ref, 0.5f);
    } else if (phase == 5 || phase == 8) {
        const bool p5 = phase == 5; const int row = r0 % T, col = r1 % DM; const bf16* ar = (const bf16*)(ws + (p5 ? WS_MERGED : WS_OX)) + (size_t)row * DM; const float* W = p5 ? a.in[I_WMIX] : a.in[I_WCO];
        double s = 0; for (int k = 0; k < DM; ++k) s += (double)bf2f(ar[k]) * W[(size_t)k * DM + col];
        const float xi = p5 ? a.in[I_X][(size_t)row * DM + col] : dbg_bf((const bf16*)(ws + WS_XN2U), (size_t)row * DM + col); const float ref = xi + (float)s; const float got = dbg_bf((const bf16*)(ws + (p5 ? WS_XN2U : WS_XN3U)), (size_t)row * DM + col);
        chk_report(ws, phase, got, ref, 1.0f);
        if (p5) { const bf16* xr = (const bf16*)(ws + WS_XN2U) + (size_t)row * DM; double ss = 0; for (int k = 0; k < DM; ++k) ss += (double)bf2f(xr[k]) * bf2f(xr[k]); float sl = 0; for (int k = 0; k < 16; ++k) sl += ((const float*)(ws + WS_SLOTS))[(size_t)row * 16 + k]; chk_report(ws, 5, sl, (float)ss, 100.0f); }
    } else if (phase == 6) {
        const int row = r0 % T, col = r1 % DM; const bf16* ar = (const bf16*)(ws + WS_XN2U) + (size_t)row * DM; double s = 0, ss = 0; for (int k = 0; k < DM; ++k) { const double x = bf2f(ar[k]); s += x * a.in[I_GXATTN][k] * a.in[I_WCQ][(size_t)k * DM + col]; ss += x * x; }
        chk_report(ws, 6, dbg_bf((const bf16*)(ws + WS_QX), (size_t)row * DM + col), (float)(s / sqrt(ss / DM + 1e-5)) * XQ_SCALE, XQ_SCALE);
    } else if (phase == 7) {
        const int b = r0 % BATCH, t = r1 % SEQ, hx = r2 % 4, d = r3 % 256; const bf16* qrow = (const bf16*)(ws + WS_QX) + (size_t)(b * SEQ + t) * DM + hx * 256; const bf16* KV = (const bf16*)(ws + WS_KVMEM) + (size_t)(b * MEML) * 2048;
        double mx = -1e30; for (int m = 0; m < MEML; ++m) { double z = 0; for (int k = 0; k < 256; ++k) z += (double)bf2f(qrow[k]) * bf2f(KV[(size_t)m * 2048 + hx * 256 + k]); if (z > mx) mx = z; }
        double l = 0, o = 0; for (int m = 0; m < MEML; ++m) { double z = 0; for (int k = 0; k < 256; ++k) z += (double)bf2f(qrow[k]) * bf2f(KV[(size_t)m * 2048 + hx * 256 + k]); const double p = exp2(z - mx); l += p; o += p * bf2f(KV[(size_t)m * 2048 + 1024 + hx * 256 + d]); }
        chk_report(ws, 7, dbg_bf((const bf16*)(ws + WS_OX), (size_t)(b * SEQ + t) * DM + hx * 256 + d), (float)(o / l), 0.1f);
    } else if (phase == 9) {
        const int tok = r0 % T; const bf16* xr = (const bf16*)(ws + WS_XN3U) + (size_t)tok * DM; double ss = 0; for (int k = 0; k < DM; ++k) ss += (double)bf2f(xr[k]) * bf2f(xr[k]); const double rstd = 1.0 / sqrt(ss / DM + 1e-5);
        chk_report(ws, 9, ((const float*)(ws + WS_SMALL + SM_RSTD3))[tok], (float)rstd, 1e-3f);
        double v0 = -1e30, v1 = -1e30, v2 = -1e30, v3 = -1e30, v4 = -1e30; int i0 = -1, i1 = -1, i2 = -1, i3 = -1;
        for (int e = 0; e < 32; ++e) { double s = 0; for (int k = 0; k < DM; ++k) s += (double)bf2f(xr[k]) * a.in[I_GMOE][k] * a.in[I_WROUTER][k * 32 + e]; s = s * rstd + a.in[I_BROUTER][e];
            if (s > v0) { v4 = v3; v3 = v2; i3 = i2; v2 = v1; i2 = i1; v1 = v0; i1 = i0; v0 = s; i0 = e; } else if (s > v1) { v4 = v3; v3 = v2; i3 = i2; v2 = v1; i2 = i1; v1 = s; i1 = e; }
            else if (s > v2) { v4 = v3; v3 = v2; i3 = i2; v2 = s; i2 = e; } else if (s > v3) { v4 = v3; v3 = s; i3 = e; } else if (s > v4) v4 = s; }
        const int* te = (const int*)(ws + WS_SMALL + SM_TOPE) + tok * 4; const float* tg = (const float*)(ws + WS_SMALL + SM_GATE) + tok * 4;
        const bool close = (v0 - v1 < 1e-4) || (v1 - v2 < 1e-4) || (v2 - v3 < 1e-4) || (v3 - v4 < 1e-4);
        if (!close) { chk_report(ws, 9, (te[0] == i0 && te[1] == i1 && te[2] == i2 && te[3] == i3) ? 0.f : 1.f, 0.f, 1.0f);
            const double e1 = exp(v1 - v0), e2 = exp(v2 - v0), e3 = exp(v3 - v0), sm = 1.0 + e1 + e2 + e3; chk_report(ws, 9, tg[0], (float)(1.0 / sm), 0.01f); chk_report(ws, 9, tg[3], (float)(e3 / sm), 0.01f); }
    } else if (phase == 10) {
        const int tok = r0 % T, k = r1 % 4, col = r2 % DM; const int row = ((const int*)(ws + WS_SMALL + SM_AROW))[tok * 4 + k], e = ((const int*)(ws + WS_SMALL + SM_TOPE))[tok * 4 + k]; const int* BLKE = (const int*)(ws + WS_SMALL + SM_BLKE);
        const bool okr = row >= 0 && row < BLKE[MAXBLK] * 256; chk_report(ws, 10, okr ? 0.f : 1.f, 0.f, 1.0f);
        if (okr) { chk_report(ws, 10, BLKE[row >> 8] == e ? 0.f : 1.f, 0.f, 1.0f); chk_report(ws, 10, dbg_f8(ws + WS_XG, (size_t)row * DM + col), dbg_bf((const bf16*)(ws + WS_XN3U), (size_t)tok * DM + col) * a.in[I_GMOE][col], 0.5f);
            chk_report(ws, 10, ((const float*)(ws + WS_SMALL + SM_RSCALE))[row], ((const float*)(ws + WS_SMALL + SM_RSTD3))[tok], 1e-6f); chk_report(ws, 10, ((const float*)(ws + WS_SMALL + SM_RGATE))[row], ((const float*)(ws + WS_SMALL + SM_GATE))[tok * 4 + k], 1e-6f);
 }
    } else if (phase == 11) {
        const int tok = r0 % T, k = r1 % 4, col = r2 % DFF; const int row = ((const int*)(ws + WS_SMALL + SM_AROW))[tok * 4 + k], e = ((const int*)(ws + WS_SMALL + SM_TOPE))[tok * 4 + k];
        const unsigned char* xr = ws + WS_XG + (size_t)row * DM; const unsigned char* W = ws + WS_WE1 + (size_t)e * 2048 * 1024; const int rg = 256 * (col >> 7) + (col & 127), rl = rg + 128; double sg = 0, sl = 0;
        for (int kk = 0; kk < DM; ++kk) { const double x = dbg_f8(xr, kk); sg += x * dbg_f8(W, (size_t)rg * 1024 + kk); sl += x * dbg_f8(W, (size_t)rl * 1024 + kk); }
        sg *= (1.0 / 64.0); sl *= (1.0 / 64.0);
        const float rs = ((const float*)(ws + WS_SMALL + SM_RSTD3))[tok]; float gl = (float)sg * rs + a.in[I_BE1][e * 2048 + col], li = (float)sl * rs + a.in[I_BE1][e * 2048 + 1024 + col]; gl = fminf(gl, 7.f); li = fminf(fmaxf(li, -7.f), 7.f);
        chk_report(ws, 11, dbg_f8(ws + WS_ACT, (size_t)row * DFF + col), gl * dbg_sigm(1.702f * gl) * (li + 1.0f), 0.5f);
    } else if (phase == 12) {
        const int tok = r0 % T, k = r1 % 4, col = r2 % DM; const int row = ((const int*)(ws + WS_SMALL + SM_AROW))[tok * 4 + k], e = ((const int*)(ws + WS_SMALL + SM_TOPE))[tok * 4 + k];
        const unsigned char* ar = ws + WS_ACT + (size_t)row * DFF; const unsigned char* W = ws + WS_WE2 + (size_t)e * 1024 * 1024; double s = 0; for (int kk = 0; kk < DFF; ++kk) s += (double)dbg_f8(ar, kk) * dbg_f8(W, (size_t)col * 1024 + kk);
        s *= (1.0 / 64.0);
        chk_report(ws, 12, dbg_bf((const bf16*)(ws + WS_YROWS), (size_t)row * DM + col), ((float)s + a.in[I_BE2][e * 1024 + col]) * ((const float*)(ws + WS_SMALL + SM_GATE))[tok * 4 + k], 0.1f);
    }
}
__global__ void dbg_rows_a(Args a) { const int i = blockIdx.x * 256 + threadIdx.x; if (i < T * 4) atomicAdd((int*)(a.ws + WS_E + 64 * MB) + ((const int*)(a.ws + WS_SMALL + SM_AROW))[i], 1); }
__global__ void dbg_rows_b(Args a) { const int i = blockIdx.x * 256 + threadIdx.x; if (i < PROWS) { const int c = ((const int*)(a.ws + WS_E + 64 * MB))[i]; if (c > 1) atomicMax((unsigned*)(a.ws + WS_CTL) + CW_CHK + 10, __float_as_uint(100.0f + c)); } }
__global__ void dbg_verdict(Args a) {
    const unsigned* chk = (const unsigned*)(a.ws + WS_CTL) + CW_CHK; int code = 0;
    for (int p = 0; p < NPHASE; ++p) if (code == 0 && __uint_as_float(chk[p]) > 0.08f) code = p + 1;
    if (code) { const float sc = 1.0f + (float)code; for (size_t i = (size_t)blockIdx.x * 256 + threadIdx.x; i < (size_t)T * DM; i += (size_t)gridDim.x * 256) a.out[i] *= sc; }
}
static void dbg_check(int p, const Args& a, hipStream_t stream) {
    if (p == 13) { hipLaunchKernelGGL(dbg_verdict, dim3(1024), dim3(256), 0, stream, a); return; }
    if (p == 10) { (void)hipMemsetAsync(a.ws + WS_E + 64 * MB, 0, (size_t)PROWS * 4, stream); hipLaunchKernelGGL(dbg_rows_a, dim3(T * 4 / 256), dim3(256), 0, stream, a); hipLaunchKernelGGL(dbg_rows_b, dim3(PROWS / 256), dim3(256), 0, stream, a); }
    hipLaunchKernelGGL(dbg_kernel, dim3(p == 3 ? 2 : 16), dim3(64), 0, stream, a, p);
}
#endif

extern "C" void kernel_launch(void* const* d_in, const int* in_sizes, int n_in, void* d_out, int out_size, void* d_ws, size_t ws_size, hipStream_t stream) {
    static int grid = 0;
    if (grid == 0) {
        if (n_in != 20 || in_sizes[0] != T * DM || out_size != T * DM || ws_size < WS_END) { fprintf(stderr, "kernel_launch: unexpected problem shape (n_in %d, in0 %d, out %d, ws %zu < %zu)\n", n_in, n_in > 0 ? in_sizes[0] : -1, out_size, ws_size, (size_t)WS_END); grid = -1; return; }
        int dev = 0, cus = 0;
        if (hipGetDevice(&dev) != hipSuccess || hipDeviceGetAttribute(&cus, hipDeviceAttributeMultiprocessorCount, dev) != hipSuccess) { grid = -1; return; }
        if (hipFuncSetAttribute((const void*)mega_fwd, hipFuncAttributeMaxDynamicSharedMemorySize, LDS_BYTES) != hipSuccess) { fprintf(stderr, "kernel_launch: hipFuncSetAttribute failed\n"); grid = -1; return; }
        grid = cus;
    }
    if (grid < 0) return;
    (void)hipMemsetAsync((char*)d_ws + WS_CTL, 0, CTL_BYTES, stream);
    Args a{};
    for (int i = 0; i < 20; ++i) a.in[i] = (const float*)d_in[i];
    a.out = (float*)d_out; a.ws = (unsigned char*)d_ws;
#if MK_DEBUG
    for (int p = 0; p < NPHASE; ++p) { a.ph_lo = p; a.ph_hi = p + 1; hipLaunchKernelGGL(mega_fwd, dim3(grid), dim3(NWAVES * 64), LDS_BYTES, stream, a); dbg_check(p, a, stream); }
#else
    a.ph_lo = 0; a.ph_hi = NPHASE;
    hipLaunchKernelGGL(mega_fwd, dim3(grid), dim3(NWAVES * 64), LDS_BYTES, stream, a);
#endif
}
```

```cpp
#include <hip/hip_runtime.h>
#include <cstdio>
#include <cstdint>

#ifndef MK_DEBUG
#define MK_DEBUG 0
#endif

#define LAS __attribute__((address_space(3)))
#define GAS __attribute__((address_space(1)))
typedef unsigned short bf16;
typedef short bf16x8 __attribute__((ext_vector_type(8)));
typedef short s16x4 __attribute__((ext_vector_type(4)));
typedef short v4i16_t __attribute__((ext_vector_type(4)));
typedef float f32x2 __attribute__((ext_vector_type(2)));
typedef float f32x4 __attribute__((ext_vector_type(4)));
typedef float f32x16 __attribute__((ext_vector_type(16)));
typedef unsigned u32x2 __attribute__((ext_vector_type(2)));
typedef unsigned u32x4 __attribute__((ext_vector_type(4)));
typedef __bf16 bf16x2_t __attribute__((ext_vector_type(2)));
typedef GAS unsigned gu32;
#define RLX_AGENT __ATOMIC_RELAXED, __HIP_MEMORY_SCOPE_AGENT
#define LDS_WAIT() asm volatile("s_waitcnt lgkmcnt(0)" ::: "memory")
#define VM_WAIT() asm volatile("s_waitcnt vmcnt(0)" ::: "memory")
#define DI __device__ __forceinline__

DI unsigned cvtpk(float lo, float hi) { f32x2 v = {lo, hi}; bf16x2_t b = __builtin_convertvector(v, bf16x2_t); return __builtin_bit_cast(unsigned, b); }
DI float bflo(unsigned w) { return __uint_as_float(w << 16); }
DI float bfhi(unsigned w) { return __uint_as_float(w & 0xffff0000u); }
DI float bf2f(bf16 u) { return __uint_as_float((unsigned)u << 16); }
DI float fexp2(float x) { return __builtin_amdgcn_exp2f(x); }
DI float flog2(float x) { return __builtin_amdgcn_logf(x); }
DI float frcp(float x) { return __builtin_amdgcn_rcpf(x); }
DI float sigmoidf_(float x) { return frcp(1.0f + fexp2(-1.4426950408889634f * x)); }
DI int crow(int r, int hi) { return (r & 3) + 8 * (r >> 2) + 4 * hi; }
DI s16x4 vtr(const LAS char* p) { return __builtin_bit_cast(s16x4, __builtin_amdgcn_ds_read_tr16_b64_v4i16((LAS v4i16_t*)p)); }
#define MFMA32(a, b, c) __builtin_amdgcn_mfma_f32_32x32x16_bf16((a), (b), (c), 0, 0, 0)

constexpr int BATCH = 8, SEQ = 2048, DM = 1024, T = BATCH * SEQ, NPROJ = 6656, MEML = 256;
constexpr int C_SBQ = 0, C_SBK = 512, C_SBV = 1024, C_RQ = 1536, C_RK = 2048, C_RV = 2560, C_RG = 3584, C_GSB = 4608, C_GRET = 5632;
constexpr int NEXP = 32, TOPK = 4, DFF = 1024;
constexpr int MAXBLK = 288, PROWS = MAXBLK * 256;
constexpr float NORM_EPS = 1e-5f;
constexpr float LOG2E = 1.4426950408889634f;
constexpr float SBQ_SCALE = 0.125f * LOG2E;
constexpr float XQ_SCALE = 0.0625f * LOG2E;
constexpr float SB_THR = 150.0f;

namespace pg8 {
constexpr int BM = 256, BK = 64, HALF = 128, HTB = HALF * BK * 2, STAGE_BYTES = 8 * HTB, NXCD = 8;
__host__ __device__ __forceinline__ int lds_byte(int r, int c) { const int st = (r >> 4) * 2 + (c >> 5), rr = r & 15, cc = c & 31, ob = rr * 64 + cc * 2; return st * 1024 + (ob ^ (((ob >> 9) & 1) << 5)); }
__host__ __device__ __forceinline__ void stage_rc(int b, int& R, int& C) { const int st = b / 1024, sb = b % 1024, swz = sb ^ (((sb >> 9) & 1) << 5); R = (st >> 1) * 16 + swz / 64; C = (st & 1) * 32 + (swz % 64) / 2; }
__host__ __device__ __forceinline__ int perm32(int rho) { const int n = rho >> 4, i = rho & 15; return 8 * (i >> 2) + 4 * n + (i & 3); }

typedef int v8i_t __attribute__((ext_vector_type(8)));
typedef int v4i_t __attribute__((ext_vector_type(4)));
DI v8i_t cat8(bf16x8 a, bf16x8 b) { const v4i_t x = __builtin_bit_cast(v4i_t, a), y = __builtin_bit_cast(v4i_t, b); return __builtin_shufflevector(x, y, 0, 1, 2, 3, 4, 5, 6, 7); }
DI bf16x8 lo8(v8i_t v) { return __builtin_bit_cast(bf16x8, (v4i_t)__builtin_shufflevector(v, v, 0, 1, 2, 3)); }
DI bf16x8 hi8(v8i_t v) { return __builtin_bit_cast(bf16x8, (v4i_t)__builtin_shufflevector(v, v, 4, 5, 6, 7)); }
struct Unit { int pm, pn; const char* A; const char* B; int tag, e; };

DI void map_unit(int L, int nwg, int nM, int nN, int& pm, int& pn, const int WGM = 4) {
    int wgid = L; { const int q = nwg / NXCD, r = nwg % NXCD, xcd = wgid % NXCD, off = wgid / NXCD; wgid = (xcd < r ? xcd * (q + 1) : r * (q + 1) + (xcd - r) * q) + off; }
    const int nig = WGM * nN, gid = wgid / nig, fm = gid * WGM, gsz = (nM - fm) < WGM ? (nM - fm) : WGM;
    pm = fm + ((wgid % nig) % gsz); pn = (wgid % nig) / gsz;
}
struct Sched2 {
    const bf16* A0; const bf16* B0; int nM0, nN0; const bf16* A1; const bf16* B1; int nM1, nN1; int G, c, K; int wgm = 4;
    DI bool next(int i, Unit& u) const {
        const int n0 = nM0 * nN0, n1 = nM1 * nN1; const long L = (long)i * G + c; if (L >= n0 + n1) return false;
        const bool first = L < n0; int pm, pn; map_unit(first ? (int)L : (int)L - n0, first ? n0 : n1, first ? nM0 : nM1, first ? nN0 : nN1, pm, pn, wgm);
        u.pm = pm; u.pn = pn; u.tag = first ? 0 : 1; u.e = 0;
        u.A = (const char*)(first ? A0 : A1) + (size_t)pm * BM * K * 2; u.B = (const char*)(first ? B0 : B1) + (size_t)pn * BM * K * 2; return true;
    }
};
struct SchedMoE {
    const unsigned char* A; const unsigned char* Wt; const int* blk_e; int nblk, nN, G, c, K; size_t estride; int wgm = 4;
    DI bool next(int i, Unit& u) const {
        const int nwg = nblk * nN; const long L = (long)i * G + c; if (L >= nwg) return false;
        int pm, pn; map_unit((int)L, nwg, nblk, nN, pm, pn, wgm);
        const int e = __builtin_amdgcn_readfirstlane(__hip_atomic_load(blk_e + pm, RLX_AGENT));
        u.pm = pm; u.pn = pn; u.tag = 0; u.e = e;
        u.A = (const char*)A + (size_t)pm * BM * K; u.B = (const char*)Wt + ((size_t)e * estride + (size_t)pn * BM * K); return true;
    }
};

template <class Epi, class Sched>
DI void gemm_phase(LAS unsigned char* lds, const int K, const Sched& S, const Epi& E) {
    const int tid = threadIdx.x, wid = __builtin_amdgcn_readfirstlane(tid >> 6), lane = tid & 63, wr = wid >> 2, wc = wid & 3, fr = lane & 15, fq = lane >> 4;
    constexpr int ESZ = Epi::FP8 ? 1 : 2;
    int nt = K * ESZ / 128; asm volatile("" : "+s"(nt));
    unsigned voffA[2], voffB[2];
#pragma unroll
    for (int i = 0; i < 2; ++i) { int R, C; stage_rc(tid * 16 + i * 8192, R, C); const int Rb = Epi::PERM ? ((R & ~31) + perm32(R & 31)) : R;
        voffA[i] = (unsigned)(R * K * ESZ + 2 * C); voffB[i] = (unsigned)(Rb * K * ESZ + 2 * C); }
    const size_t kstep = (size_t)(BK * 2);
    const size_t hstep = (size_t)HALF * K * ESZ;
    const unsigned ldsw = (unsigned)wid * 1024u;
    const int aoff = lds_byte(wr * 64 + fr, fq * 8), boff = lds_byte(wc * 32 + fr, fq * 8);
#define PG8_SA(b, h) (((b) * 2 + (h)) * HTB)
#define PG8_SB(b, h) ((4 + (b) * 2 + (h)) * HTB)
#define PG8_STAGE(bufoff, gbase, voff) do { _Pragma("unroll") for (int _i = 0; _i < 2; ++_i) \
        __builtin_amdgcn_global_load_lds((const unsigned*)((const char*)(gbase) + (voff)[_i]), (LAS unsigned*)(lds + (bufoff) + ldsw + _i * 8192), 16, 0, 0); } while (0)
#define PG8_LDA(dst, b, h) do { _Pragma("unroll") for (int m = 0; m < 4; ++m) dst[m] = cat8(*(const LAS bf16x8*)(lds + PG8_SA(b, h) + aoff + m * 2048), *(const LAS bf16x8*)(lds + PG8_SA(b, h) + aoff + m * 2048 + 1024)); } while (0)
#define PG8_LDB(dst, b, h) do { _Pragma("unroll") for (int n = 0; n < 2; ++n) dst[n] = cat8(*(const LAS bf16x8*)(lds + PG8_SB(b, h) + boff + n * 2048), *(const LAS bf16x8*)(lds + PG8_SB(b, h) + boff + n * 2048 + 1024)); } while (0)
#define PG8_MMA(ai, bj, At, Bt) do { __builtin_amdgcn_s_setprio(1); _Pragma("unroll") for (int m = 0; m < 4; ++m) _Pragma("unroll") for (int n = 0; n < 2; ++n) { \
        if constexpr (Epi::FP8) { asm volatile("v_mfma_scale_f32_16x16x128_f8f6f4 %0, %1, %2, %0, %3, %4 op_sel_hi:[0,0,0]" : "+v"(acc[ai][bj][m][n]) : "v"(Bt[n]), "v"(At[m]), "v"(sc_w), "v"(sc_a)); } \
        else { acc[ai][bj][m][n] = __builtin_amdgcn_mfma_f32_16x16x32_bf16(lo8(Bt[n]), lo8(At[m]), acc[ai][bj][m][n], 0, 0, 0); acc[ai][bj][m][n] = __builtin_amdgcn_mfma_f32_16x16x32_bf16(hi8(Bt[n]), hi8(At[m]), acc[ai][bj][m][n], 0, 0, 0); } } \
        __builtin_amdgcn_s_setprio(0); } while (0)
#define PG8_WAIT_V(n) asm volatile("s_waitcnt vmcnt(" #n ")" ::: "memory")
#define PG8_WAIT_L(n) asm volatile("s_waitcnt lgkmcnt(" #n ")" ::: "memory")
#define PG8_BAR __builtin_amdgcn_s_barrier()
#define PG8_SCHED __builtin_amdgcn_sched_barrier(0)
    Unit cur, nxt; int ui = 0;
    if (S.next(0, cur)) {
    f32x4 acc[2][2][4][2];
#pragma unroll
    for (int a = 0; a < 2; ++a)
#pragma unroll
        for (int b = 0; b < 2; ++b)
#pragma unroll
            for (int m = 0; m < 4; ++m)
#pragma unroll
                for (int n = 0; n < 2; ++n) acc[a][b][m][n] = (f32x4){0.f, 0.f, 0.f, 0.f};
    v8i_t At[4], B0[2], B1[2];
    int sc_w = 0, sc_a = 0; if constexpr (Epi::FP8) { sc_w = Epi::SCALE_W; sc_a = Epi::SCALE_A; asm volatile("" : "+v"(sc_w), "+v"(sc_a)); }
    (void)sc_w; (void)sc_a;
    const char* cA = cur.A; const char* cB = cur.B;
    PG8_STAGE(PG8_SB(0, 0), cB, voffB); PG8_STAGE(PG8_SB(0, 1), cB + hstep, voffB); PG8_STAGE(PG8_SA(0, 0), cA, voffA); PG8_STAGE(PG8_SA(0, 1), cA + hstep, voffA);
    if (wr == 1) PG8_BAR;
    PG8_WAIT_V(2); PG8_BAR;
    PG8_STAGE(PG8_SB(1, 0), cB + kstep, voffB); PG8_STAGE(PG8_SA(1, 0), cA + kstep, voffA); PG8_STAGE(PG8_SB(1, 1), cB + hstep + kstep, voffB);
    PG8_WAIT_V(6); PG8_BAR;
    for (;;) {
        const bool has_next = S.next(ui + 1, nxt);
        const char* nA = has_next ? nxt.A : cA; const char* nB = has_next ? nxt.B : cB;
#pragma nounroll
        for (int t = 0; t < nt; t += 2) {
            const bool last = (t == nt - 2);
            const char* a1 = cA + (size_t)(t + 1) * kstep;
            const char* a2 = last ? nA : cA + (size_t)(t + 2) * kstep; const char* b2 = last ? nB : cB + (size_t)(t + 2) * kstep;
            const char* a3 = a2 + kstep; const char* b3 = b2 + kstep;
            PG8_LDB(B0, 0, 0); PG8_LDB(B1, 0, 1); PG8_SCHED; PG8_LDA(At, 0, 0); PG8_STAGE(PG8_SA(1, 1), a1 + hstep, voffA);
            PG8_WAIT_V(8); PG8_WAIT_L(0); PG8_BAR; PG8_MMA(0, 0, At, B0); PG8_MMA(0, 1, At, B1); PG8_BAR; PG8_SCHED;
            PG8_LDA(At, 0, 1); PG8_STAGE(PG8_SB(0, 0), b2, voffB); PG8_STAGE(PG8_SB(0, 1), b2 + hstep, voffB); PG8_STAGE(PG8_SA(0, 0), a2, voffA);
            PG8_WAIT_V(8); PG8_WAIT_L(0); PG8_BAR; PG8_MMA(1, 0, At, B0); PG8_MMA(1, 1, At, B1); PG8_BAR; PG8_SCHED;
            PG8_LDB(B0, 1, 0); PG8_LDB(B1, 1, 1); PG8_SCHED; PG8_LDA(At, 1, 0); PG8_STAGE(PG8_SA(0, 1), a2 + hstep, voffA);
            PG8_WAIT_V(8); PG8_WAIT_L(0); PG8_BAR; PG8_MMA(0, 0, At, B0); PG8_MMA(0, 1, At, B1); PG8_BAR; PG8_SCHED;
            PG8_LDA(At, 1, 1); PG8_STAGE(PG8_SB(1, 0), b3, voffB); PG8_STAGE(PG8_SB(1, 1), b3 + hstep, voffB); PG8_STAGE(PG8_SA(1, 0), a3, voffA);
            PG8_WAIT_V(8); PG8_WAIT_L(0); PG8_BAR; PG8_MMA(1, 0, At, B0); PG8_MMA(1, 1, At, B1); PG8_BAR; PG8_SCHED;
        }
        if (wr == 0) PG8_BAR;
        if constexpr (Epi::FP8) { asm volatile("s_nop 15\n\ts_nop 3" ::: "memory"); _Pragma("unroll") for (int i_ = 0; i_ < 32; ++i_) asm volatile("" : "+v"(((f32x4*)acc)[i_])); }
        E(acc, cur, wr, wc, fr, fq);
        if (!has_next) break;
#pragma unroll
        for (int a = 0; a < 2; ++a)
#pragma unroll
            for (int b = 0; b < 2; ++b)
#pragma unroll
                for (int m = 0; m < 4; ++m)
#pragma unroll
                    for (int n = 0; n < 2; ++n) acc[a][b][m][n] = (f32x4){0.f, 0.f, 0.f, 0.f};
        cur = nxt; cA = nA; cB = nB; ++ui;
        if (wr == 1) PG8_BAR;
    }
    PG8_WAIT_V(0);
    PG8_BAR;
    }
    __syncthreads();
#undef PG8_SA
#undef PG8_SB
#undef PG8_STAGE
#undef PG8_LDA
#undef PG8_LDB
#undef PG8_MMA
#undef PG8_WAIT_V
#undef PG8_WAIT_L
#undef PG8_BAR
#undef PG8_SCHED
}
}

#define XB_TMO      128
#define XB_XCNT(j)  (256  + 64 * (j))
#define XB_XSUB(j)  (1280 + 64 * (j))
#define XB_XGEN(j)  (2304 + 64 * (j))
#define XB_TOP      3328
#define XB_TOPGEN   3392
#define XCD_BAR_WORDS 3456
#define XB_SPIN_CAP (1u << 18)
DI unsigned xb_ld(unsigned* p)              { return __hip_atomic_load(p, __ATOMIC_RELAXED, __HIP_MEMORY_SCOPE_AGENT); }
DI unsigned xb_add(unsigned* p, unsigned v) { return __hip_atomic_fetch_add(p, v, __ATOMIC_RELAXED, __HIP_MEMORY_SCOPE_AGENT); }
DI unsigned xb_xcc_id() { return (unsigned)__builtin_amdgcn_s_getreg((3 << 11) | 20) & 0xFu; }
#define XB_SPIN(cond, bar) do { unsigned _sp = 0; while (cond) { __builtin_amdgcn_s_sleep(1); \
    if ((++_sp & 255u) == 0u) { if (xb_ld(&(bar)[XB_TMO])) break; if (_sp > XB_SPIN_CAP) { atomicAdd(&(bar)[XB_TMO], 1u); break; } } } } while (0)
struct XcdBarrier { unsigned* bar; unsigned x; volatile LAS unsigned* st; };
DI XcdBarrier xcd_barrier_post(unsigned* bar, volatile LAS unsigned* st) {
    XcdBarrier b; b.bar = bar; b.x = xb_xcc_id(); b.st = st;
    if (threadIdx.x == 0) (void)xb_add(&bar[XB_XCNT(b.x)], 1u);
    return b;
}
DI void xcd_barrier_complete(unsigned* bar, unsigned x, unsigned& nloc, unsigned& nx) {
    const unsigned G = gridDim.x * gridDim.y * gridDim.z;
    unsigned sum, cnt, mine, sp = 0u;
    for (;;) {
        sum = 0u; cnt = 0u; mine = 0u;
#pragma unroll
        for (unsigned j = 0; j < 16; ++j) { const unsigned c = xb_ld(&bar[XB_XCNT(j)]); sum += c; cnt += (c > 0u) ? 1u : 0u; mine = (j == x) ? c : mine; }
        if (sum == G) break;
        __builtin_amdgcn_s_sleep(1);
        if ((++sp & 255u) == 0u) { if (xb_ld(&bar[XB_TMO])) break; if (sp > XB_SPIN_CAP) { atomicAdd(&bar[XB_TMO], 1u); break; } }
    }
    nloc = mine > 0u ? mine : 1u; nx = cnt > 0u ? cnt : 1u;
}
DI void xcd_barrier(const XcdBarrier& b) {
    asm volatile("s_waitcnt vmcnt(0)" ::: "memory");
    __syncthreads();
    if (threadIdx.x == 0) {
        unsigned* bar = b.bar;
        __builtin_amdgcn_s_waitcnt(0);
        unsigned nloc = b.st[0], nx = b.st[1];
        if (nloc == 0u) { xcd_barrier_complete(bar, b.x, nloc, nx); b.st[0] = nloc; b.st[1] = nx; }
        const unsigned old = xb_add(&bar[XB_XSUB(b.x)], 1u);
        const unsigned gen = old / nloc;
        if (old + 1u == (gen + 1u) * nloc) {
            __builtin_amdgcn_fence(__ATOMIC_RELEASE, "agent");
            asm volatile("s_waitcnt vmcnt(0)" ::: "memory");
            const unsigned og = xb_add(&bar[XB_TOP], 1u);
            const unsigned tg = og / nx;
            if (og + 1u == (tg + 1u) * nx) xb_add(&bar[XB_TOPGEN], 1u);
            else XB_SPIN(xb_ld(&bar[XB_TOPGEN]) == tg, bar);
            __builtin_amdgcn_fence(__ATOMIC_ACQUIRE, "agent");
            xb_add(&bar[XB_XGEN(b.x)], 1u);
            asm volatile("s_waitcnt vmcnt(0)" ::: "memory");
        } else {
            XB_SPIN(xb_ld(&bar[XB_XGEN(b.x)]) == gen, bar);
            __builtin_amdgcn_fence(__ATOMIC_ACQUIRE, "agent");
            asm volatile("s_waitcnt vmcnt(0)" ::: "memory");
        }
    }
    __syncthreads();
}

constexpr size_t MB = 1024 * 1024;
constexpr size_t WS_CTL    = 0;
constexpr size_t CTL_BYTES = 256 * 1024;
constexpr int    CW_BAR = 4096;
constexpr int    CW_CHK = 32768;
constexpr size_t WS_ROPE   = WS_CTL + CTL_BYTES;
constexpr size_t WS_WIN    = WS_ROPE + 512 * 1024;
constexpr size_t WS_WSBO   = WS_WIN + (size_t)NPROJ * DM * 2;
constexpr size_t WS_WRETO  = WS_WSBO + 1 * MB;
constexpr size_t WS_WMIX   = WS_WRETO + 2 * MB;
constexpr size_t WS_WCQ    = WS_WMIX + 2 * MB;
constexpr size_t WS_WCKV   = WS_WCQ + 2 * MB;
constexpr size_t WS_WCO    = WS_WCKV + 4 * MB;
constexpr size_t WS_WE1    = WS_WCO + 2 * MB;
constexpr size_t WS_WE2    = WS_WE1 + 128 * MB;
constexpr size_t WS_SMALL  = WS_WE2 + 64 * MB;
constexpr size_t WS_MEMN   = WS_SMALL + 4 * MB;
constexpr size_t WS_KVMEM  = WS_MEMN + 4 * MB;
constexpr size_t WS_GTOT   = WS_KVMEM + 8 * MB;
constexpr size_t WS_SLOTS  = WS_GTOT + 8 * MB;
constexpr size_t WS_A      = WS_SLOTS + 1 * MB;
constexpr size_t WS_B      = WS_A + 208 * MB;
constexpr size_t WS_C      = WS_B + 32 * MB;
constexpr size_t WS_D      = WS_C + 64 * MB;
constexpr size_t WS_E      = WS_D + 144 * MB;
constexpr size_t WS_END    = WS_E + 144 * MB;
static_assert((size_t)T * NPROJ * 2 <= 208 * MB && (size_t)PROWS * 1024 * 2 <= 144 * MB, "arena sizes");
constexpr size_t WS_PROJ = WS_A, WS_XG = WS_A, WS_XN1 = WS_B, WS_YRET = WS_B, WS_XN3U = WS_B, WS_TMP = WS_C, WS_X2 = WS_C;
constexpr size_t WS_YSB = WS_D, WS_MERGED = WS_D + 16 * MB, WS_XN2U = WS_D + 48 * MB  , WS_QX = WS_D + 80 * MB, WS_OX = WS_D + 112 * MB, WS_ACT = WS_D;
constexpr size_t WS_X1 = WS_E, WS_YROWS = WS_E;
constexpr size_t SM_TOPE = 0;
constexpr size_t SM_GATE = SM_TOPE + T * 16;
constexpr size_t SM_LRANK = SM_GATE + T * 16;
constexpr size_t SM_AROW = SM_LRANK + T * 16;
constexpr size_t SM_RSTD3 = SM_AROW + T * 16;
constexpr size_t SM_CNT = SM_RSTD3 + T * 4;
constexpr size_t SM_RSCALE = SM_CNT + 256 * 32 * 4;
constexpr size_t SM_RGATE = SM_RSCALE + PROWS * 4;
constexpr size_t SM_BLKE = SM_RGATE + PROWS * 4;
constexpr size_t SM_END = SM_BLKE + 4096;
static_assert(SM_END <= 4 * MB, "small tables");

constexpr int RING_OFF = 0, RING_BYTES = 131072;
constexpr int XTRA_OFF = RING_BYTES, XTRA_BYTES = 12288;
constexpr int LDSCTL_OFF = XTRA_OFF + XTRA_BYTES;
constexpr int LDS_BYTES = 147456;
static_assert(LDSCTL_OFF + 256 <= LDS_BYTES, "LDS map");
constexpr int NWAVES = 8;

struct Args { const float* in[20]; float* out; unsigned char* ws; int ph_lo, ph_hi; };

typedef const __attribute__((address_space(4))) unsigned char* kptr_t;
struct Frame {
    LAS unsigned char* lds;
    unsigned char* ws;
    int tid, lane, wave, G, bid;
    kptr_t kp;
    float* out;
};
DI const float* inp(const Frame& F, int i) { return *(const float* const __attribute__((address_space(4)))*)(F.kp + 8 * i); }
enum { I_X = 0, I_MEM, I_GMIX, I_WIN, I_WSBO, I_WRETO, I_WMIX, I_GXATTN, I_GMEM, I_WCQ, I_WCKV, I_WCO, I_GMOE, I_WROUTER, I_BROUTER, I_WE1, I_BE1, I_WE2, I_BE2, I_GFINAL };

DI float wave_sum(float v) {
#pragma unroll
    for (int o = 1; o < 64; o <<= 1) v += __shfl_xor(v, o);
    return v;
}

DI void p0_tr_item(const float* W, int N, int K, bf16* dst, LAS float* scr, int k0, int n0, int lane, const float* rowscale = nullptr) {
#pragma unroll 8
    for (int i = 0; i < 32; ++i) { const int kk = 2 * i + (lane >> 5); scr[kk * 33 + (lane & 31)] = W[(size_t)(k0 + kk) * N + n0 + (lane & 31)] * (rowscale ? rowscale[k0 + kk] : 1.0f); }
    LDS_WAIT(); asm volatile("" ::: "memory");
    const int c = lane & 7;
#pragma unroll
    for (int j = 0; j < 4; ++j) { const int n = (lane >> 3) + 8 * j; const LAS float* s = scr + (8 * c) * 33 + n;
        u32x4 o; o.x = cvtpk(s[0 * 33], s[1 * 33]); o.y = cvtpk(s[2 * 33], s[3 * 33]); o.z = cvtpk(s[4 * 33], s[5 * 33]); o.w = cvtpk(s[6 * 33], s[7 * 33]);
        *(u32x4*)(dst + (size_t)n * K + k0 + 8 * c) = o; }
    LDS_WAIT(); asm volatile("" ::: "memory");
}
DI unsigned cvt4_fp8(float a, float b, float c, float d) { int w = __builtin_amdgcn_cvt_pk_fp8_f32(a, b, 0, false); w = __builtin_amdgcn_cvt_pk_fp8_f32(c, d, w, true); return (unsigned)w; }
DI void p0_tr_item_fp8(const float* W, int N, int K, unsigned char* dst, LAS float* scr, int k0, int n0, int lane) {
#pragma unroll 8
    for (int i = 0; i < 32; ++i) { const int kk = 2 * i + (lane >> 5); scr[kk * 33 + (lane & 31)] = W[(size_t)(k0 + kk) * N + n0 + (lane & 31)] * 64.0f; }
    LDS_WAIT(); asm volatile("" ::: "memory");
    const int c = lane & 7;
#pragma unroll
    for (int j = 0; j < 4; ++j) { const int n = (lane >> 3) + 8 * j; const LAS float* s = scr + (8 * c) * 33 + n;
        u32x2 o; o.x = cvt4_fp8(s[0 * 33], s[1 * 33], s[2 * 33], s[3 * 33]); o.y = cvt4_fp8(s[4 * 33], s[5 * 33], s[6 * 33], s[7 * 33]);
        *(u32x2*)(dst + (size_t)n * K + k0 + 8 * c) = o; }
    LDS_WAIT(); asm volatile("" ::: "memory");
}
DI void rms_row_to_bf16(const float* xrow, const float* g, bf16* orow, int lane) {
    const f32x4* xr = (const f32x4*)xrow + lane; const f32x4* gr = (const f32x4*)g + lane;
    f32x4 v[4]; float s = 0.f;
#pragma unroll
    for (int j = 0; j < 4; ++j) { v[j] = xr[64 * j]; s += (v[j].x * v[j].x + v[j].y * v[j].y) + (v[j].z * v[j].z + v[j].w * v[j].w); }
    const float rstd = 1.0f / sqrtf(wave_sum(s) * (1.f / DM) + NORM_EPS);
    u32x2* o8 = (u32x2*)orow + lane;
#pragma unroll
    for (int j = 0; j < 4; ++j) { const f32x4 gg = gr[64 * j]; u32x2 w; w.x = cvtpk(v[j].x * rstd * gg.x, v[j].y * rstd * gg.y); w.y = cvtpk(v[j].z * rstd * gg.z, v[j].w * rstd * gg.w); o8[64 * j] = w; }
}
constexpr int P0_IE1 = 32 * 16 * 64, P0_IE2 = 32 * 16 * 32;
DI void p0_experts(Frame& F, int vg  , int nvg) {
    LAS float* scr = (LAS float*)(F.lds + RING_OFF + F.wave * 16384);
    constexpr int P0_BASE = 2048 * 22; const bool light = (F.G == 256) && (F.bid >= 192); const int nlv = 64 * NWAVES, lv = (F.bid - 192) * NWAVES + F.wave;
    const int n_mine = (F.G == 256) ? 22 + (light ? 8 : 0) : (P0_IE1 + P0_IE2 + nvg - 1) / nvg;
    for (int j = 0; j < n_mine; ++j) {
        int it; if (F.G != 256) { it = vg + j * nvg; if (it >= P0_IE1 + P0_IE2) break; } else if (j < 22) it = vg + j * nvg; else it = P0_BASE + lv + (j - 22) * nlv;
        int r = it;
        if (r < P0_IE1) { const int e = r / 1024, q = r % 1024, kb = q / 64, nb = q % 64, n0 = 32 * nb;
            const int drow = n0 < 1024 ? 256 * (n0 >> 7) + (n0 & 127) : 256 * ((n0 - 1024) >> 7) + 128 + ((n0 - 1024) & 127);
            p0_tr_item_fp8(inp(F, I_WE1) + (size_t)e * 1024 * 2048, 2048, 1024, F.ws + WS_WE1 + ((size_t)e * 2048 + drow) * 1024, scr, 64 * kb, n0, F.lane); continue; }
        r -= P0_IE1;
        { const int e = r / 512, q = r % 512, kb = q / 32, nb = q % 32;
            p0_tr_item_fp8(inp(F, I_WE2) + (size_t)e * 1024 * 1024, 1024, 1024, F.ws + WS_WE2 + ((size_t)e * 1024 + 32 * nb) * 1024, scr, 64 * kb, 32 * nb, F.lane); }
    }
}


DI void p0_prologue(Frame& F) {
    LAS float* scr = (LAS float*)(F.lds + RING_OFF + F.wave * 16384);
    const int gw = F.bid * NWAVES + F.wave, NGW = F.G * NWAVES;
    constexpr int I0 = 16 * 208, I1 = 8 * 32, I2 = 16 * 32, I5 = 16 * 64;
    constexpr int NITEMS = I0 + I1 + 4 * I2 + I5;
    for (int it = gw; it < NITEMS; it += NGW) {
        int r = it;
        if (r < I0) { const int kb = r / 208, nb = r % 208; p0_tr_item(inp(F, I_WIN), NPROJ, 1024, (bf16*)(F.ws + WS_WIN) + (size_t)(32 * nb) * 1024, scr, 64 * kb, 32 * nb, F.lane); continue; } r -= I0;
        if (r < I1) { const int kb = r / 32, nb = r % 32; p0_tr_item(inp(F, I_WSBO), 1024, 512, (bf16*)(F.ws + WS_WSBO) + (size_t)(32 * nb) * 512, scr, 64 * kb, 32 * nb, F.lane); continue; } r -= I1;
        if (r < I2) { const int kb = r / 32, nb = r % 32; p0_tr_item(inp(F, I_WRETO), 1024, 1024, (bf16*)(F.ws + WS_WRETO) + (size_t)(32 * nb) * 1024, scr, 64 * kb, 32 * nb, F.lane); continue; } r -= I2;
        if (r < I2) { const int kb = r / 32, nb = r % 32; p0_tr_item(inp(F, I_WMIX), 1024, 1024, (bf16*)(F.ws + WS_WMIX) + (size_t)(32 * nb) * 1024, scr, 64 * kb, 32 * nb, F.lane); continue; } r -= I2;
        if (r < I2) { const int kb = r / 32, nb = r % 32; p0_tr_item(inp(F, I_WCQ), 1024, 1024, (bf16*)(F.ws + WS_WCQ) + (size_t)(32 * nb) * 1024, scr, 64 * kb, 32 * nb, F.lane, inp(F, I_GXATTN)); continue; }   r -= I2;
        if (r < I5) { const int kb = r / 64, nb = r % 64; p0_tr_item(inp(F, I_WCKV), 2048, 1024, (bf16*)(F.ws + WS_WCKV) + (size_t)(32 * nb) * 1024, scr, 64 * kb, 32 * nb, F.lane); continue; } r -= I5;
        { const int kb = r / 32, nb = r % 32; p0_tr_item(inp(F, I_WCO), 1024, 1024, (bf16*)(F.ws + WS_WCO) + (size_t)(32 * nb) * 1024, scr, 64 * kb, 32 * nb, F.lane); }
    }
    for (int m = gw; m < T + BATCH * MEML; m += NGW) {
        if (m < T) rms_row_to_bf16(inp(F, I_X) + (size_t)m * DM, inp(F, I_GMIX), (bf16*)(F.ws + WS_XN1) + (size_t)m * DM, F.lane);
        else rms_row_to_bf16(inp(F, I_MEM) + (size_t)(m - T) * DM, inp(F, I_GMEM), (bf16*)(F.ws + WS_MEMN) + (size_t)(m - T) * DM, F.lane);
    }
    { float* ct = (float*)(F.ws + WS_ROPE); float* st = ct + SEQ * 32;
      for (int i = F.bid * 512 + F.tid; i < SEQ * 32; i += F.G * 512) { const int pos = i >> 5, k = i & 31;
          const float inv = fexp2(-(float)k * (13.287712379549449f / 32.0f)); const float ang = (float)pos * inv;
          const float n = rintf(ang * 0.15915494309189535f); float r = fmaf(-n, 6.2831854820251465f, ang); r = fmaf(-n, -1.7484555e-7f, r);
          const float rev = r * 0.15915494309189535f; ct[i] = __builtin_amdgcn_cosf(rev); st[i] = __builtin_amdgcn_sinf(rev); } }
}

typedef f32x4 AccT[2][2][4][2];
#define EPI_ROWS_BEGIN _Pragma("unroll") for (int ai = 0; ai < 2; ++ai) _Pragma("unroll") for (int m = 0; m < 4; ++m) { const int rloc = ai * 128 + wr * 64 + m * 16 + fr; const size_t row = (size_t)u.pm * 256 + rloc; (void)row;
#define EPI_ROWS_END }
DI u32x4 pack8(f32x4 a, f32x4 b) { u32x4 w; w.x = cvtpk(a[0], a[1]); w.y = cvtpk(a[2], a[3]); w.z = cvtpk(b[0], b[1]); w.w = cvtpk(b[2], b[3]); return w; }
DI void unpack8(u32x4 w, f32x4& a, f32x4& b) { a = (f32x4){bflo(w.x), bfhi(w.x), bflo(w.y), bfhi(w.y)}; b = (f32x4){bflo(w.z), bfhi(w.z), bflo(w.w), bfhi(w.w)}; }
DI f32x4 sig4(f32x4 g) { return (f32x4){sigmoidf_(g[0]), sigmoidf_(g[1]), sigmoidf_(g[2]), sigmoidf_(g[3])}; }

struct Epi1 { static constexpr bool PERM = true, FP8 = false; bf16* proj; bf16* kvmem;
    DI void operator()(const AccT& acc, const pg8::Unit& u, int wr, int wc, int fr, int fq) const {
        bf16* base; int ldc; float sc = 1.f;
        if (u.tag == 0) { base = proj; ldc = NPROJ; if (u.pn < 2) sc = SBQ_SCALE; else if (u.pn == 8 || u.pn == 9) sc = 0.125f; } else { base = kvmem; ldc = 2048; }
        const int col0 = u.pn * 256 + wc * 32 + 8 * fq;
        EPI_ROWS_BEGIN
            bf16* rowp = base + row * ldc + col0;
#pragma unroll
            for (int bj = 0; bj < 2; ++bj) *(u32x4*)(rowp + bj * 128) = pack8(acc[ai][bj][m][0] * sc, acc[ai][bj][m][1] * sc);
        EPI_ROWS_END
    }
};
struct Epi5a { static constexpr bool PERM = true, FP8 = false; const bf16* proj; bf16* tmp;
    DI void operator()(const AccT& acc, const pg8::Unit& u, int wr, int wc, int fr, int fq) const {
        const int col0 = u.pn * 256 + wc * 32 + 8 * fq;
        EPI_ROWS_BEGIN
#pragma unroll
            for (int bj = 0; bj < 2; ++bj) { f32x4 g0, g1; unpack8(*(const u32x4*)(proj + row * NPROJ + C_GSB + col0 + bj * 128), g0, g1);
                *(u32x4*)(tmp + row * DM + col0 + bj * 128) = pack8(sig4(g0) * acc[ai][bj][m][0], sig4(g1) * acc[ai][bj][m][1]); }
        EPI_ROWS_END
    }
};
struct Epi5b { static constexpr bool PERM = true, FP8 = false; const bf16* proj; const bf16* tmp; bf16* merged;
    DI void operator()(const AccT& acc, const pg8::Unit& u, int wr, int wc, int fr, int fq) const {
        const int col0 = u.pn * 256 + wc * 32 + 8 * fq;
        EPI_ROWS_BEGIN
#pragma unroll
            for (int bj = 0; bj < 2; ++bj) { f32x4 g0, g1; unpack8(*(const u32x4*)(proj + row * NPROJ + C_GRET + col0 + bj * 128), g0, g1);
                f32x4 t0, t1; unpack8(*(const u32x4*)(tmp + row * DM + col0 + bj * 128), t0, t1);
                *(u32x4*)(merged + row * DM + col0 + bj * 128) = pack8(t0 + sig4(g0) * acc[ai][bj][m][0], t1 + sig4(g1) * acc[ai][bj][m][1]); }
        EPI_ROWS_END
    }
};
template <bool FIRST> struct EpiRes { static constexpr bool PERM = true, FP8 = false; const void* xi; bf16* xo; float* slots;
    DI void operator()(const AccT& acc, const pg8::Unit& u, int wr, int wc, int fr, int fq) const {
        const int col0 = u.pn * 256 + wc * 32 + 8 * fq;
        EPI_ROWS_BEGIN
            float ss = 0.f;
#pragma unroll
            for (int bj = 0; bj < 2; ++bj) { const size_t off = row * DM + col0 + bj * 128; f32x4 a, b;
                if (FIRST) { a = *(const f32x4*)((const float*)xi + off); b = *(const f32x4*)((const float*)xi + off + 4); } else unpack8(*(const u32x4*)((const bf16*)xi + off), a, b);
                a += acc[ai][bj][m][0]; b += acc[ai][bj][m][1];
                *(u32x4*)(xo + off) = pack8(a, b);
                if (FIRST) ss += (a[0] * a[0] + a[1] * a[1]) + (a[2] * a[2] + a[3] * a[3]) + (b[0] * b[0] + b[1] * b[1]) + (b[2] * b[2] + b[3] * b[3]); }
            if (FIRST) { ss += __shfl_xor(ss, 16); ss += __shfl_xor(ss, 32); if (fq == 0) slots[row * 16 + u.pn * 4 + wc] = ss; }
        EPI_ROWS_END
    }
};
struct Epi7 { static constexpr bool PERM = true, FP8 = false; const float* slots; bf16* qx;
    DI void operator()(const AccT& acc, const pg8::Unit& u, int wr, int wc, int fr, int fq) const {
        const int col0 = u.pn * 256 + wc * 32 + 8 * fq;
        EPI_ROWS_BEGIN
            const f32x4 s4 = *(const f32x4*)(slots + row * 16 + 4 * fq); float ss = (s4[0] + s4[1]) + (s4[2] + s4[3]); ss += __shfl_xor(ss, 16); ss += __shfl_xor(ss, 32);
            const float sc = XQ_SCALE / sqrtf(ss * (1.f / DM) + NORM_EPS);
#pragma unroll
            for (int bj = 0; bj < 2; ++bj) *(u32x4*)(qx + row * DM + col0 + bj * 128) = pack8(acc[ai][bj][m][0] * sc, acc[ai][bj][m][1] * sc);
        EPI_ROWS_END
    }
};
struct Epi12 { static constexpr bool PERM = true, FP8 = true; static constexpr int SCALE_W = 0x79797979, SCALE_A = 0x7f7f7f7f;   const float* rscale; const float* b1; unsigned char* act;
    DI void operator()(const AccT& acc, const pg8::Unit& u, int wr, int wc, int fr, int fq) const {
        const int ac0 = u.pn * 128 + wc * 32 + 8 * fq; const float* bb = b1 + (size_t)u.e * 2048;
        const f32x4 bg0 = *(const f32x4*)(bb + ac0), bg1 = *(const f32x4*)(bb + ac0 + 4), bl0 = *(const f32x4*)(bb + 1024 + ac0), bl1 = *(const f32x4*)(bb + 1024 + ac0 + 4);
        EPI_ROWS_BEGIN
            const float rs = rscale[row];
            f32x4 o[2];
#pragma unroll
            for (int n = 0; n < 2; ++n) { const f32x4 gl = acc[ai][0][m][n] * rs + (n ? bg1 : bg0), li = acc[ai][1][m][n] * rs + (n ? bl1 : bl0);
#pragma unroll
                for (int i = 0; i < 4; ++i) { const float gg = fminf(gl[i], 7.0f), ll = fminf(fmaxf(li[i], -7.0f), 7.0f); o[n][i] = gg * frcp(1.0f + fexp2(-1.702f * LOG2E * gg)) * (ll + 1.0f); } }
            { u32x2 w; w.x = cvt4_fp8(o[0][0], o[0][1], o[0][2], o[0][3]); w.y = cvt4_fp8(o[1][0], o[1][1], o[1][2], o[1][3]); *(u32x2*)(act + row * DFF + ac0) = w; }
        EPI_ROWS_END
    }
};
struct Epi13 { static constexpr bool PERM = true, FP8 = true; static constexpr int SCALE_W = 0x79797979, SCALE_A = 0x7f7f7f7f; const float* rgate; const float* b2; bf16* yrows;
    DI void operator()(const AccT& acc, const pg8::Unit& u, int wr, int wc, int fr, int fq) const {
        const int col0 = u.pn * 256 + wc * 32 + 8 * fq; const float* bb = b2 + (size_t)u.e * 1024 + col0;
        f32x4 bv[2][2];
#pragma unroll
        for (int bj = 0; bj < 2; ++bj) { bv[bj][0] = *(const f32x4*)(bb + bj * 128); bv[bj][1] = *(const f32x4*)(bb + bj * 128 + 4); }
        EPI_ROWS_BEGIN
            const float gt = rgate[row];
#pragma unroll
            for (int bj = 0; bj < 2; ++bj) *(u32x4*)(yrows + row * DM + col0 + bj * 128) = pack8((acc[ai][bj][m][0] + bv[bj][0]) * gt, (acc[ai][bj][m][1] + bv[bj][1]) * gt);
        EPI_ROWS_END
    }
};

DI void lds_barrier() { asm volatile("s_waitcnt lgkmcnt(0)" ::: "memory"); __builtin_amdgcn_s_barrier(); asm volatile("" ::: "memory"); }

constexpr int SB_K = 0, SB_V = 8192;
DI void sb_unit(Frame& F, int b, int h, int qb) {
    const int lane = F.lane, r32 = lane & 31, hi = lane >> 5, wid = F.wave;
    LAS char* lds = (LAS char*)F.lds;
    const bf16* Pj = (const bf16*)(F.ws + WS_PROJ) + (size_t)b * SEQ * NPROJ;
    const int qw0 = qb * 256 + wid * 32, q = qw0 + r32;
    bf16x8 qr[4];
#pragma unroll
    for (int d0 = 0; d0 < 4; ++d0) qr[d0] = *(const bf16x8*)(Pj + (size_t)q * NPROJ + C_SBQ + h * 64 + d0 * 16 + hi * 8);
    f32x16 o0, o1;
#pragma unroll
    for (int r = 0; r < 16; ++r) { o0[r] = 0.f; o1[r] = 0.f; }
    float carry = 0.f;
    const bf16* ksrc = Pj + (size_t)lane * NPROJ + C_SBK + h * 64 + wid * 8;
    const bf16* vsrc = Pj + (size_t)(16 * (wid & 3) + (lane >> 2)) * NPROJ + C_SBV + h * 64 + (wid >> 2) * 32 + (lane & 3) * 8;
    LAS char* kdst = lds + SB_K + wid * 1024 + lane * 16; LAS char* vdst = lds + SB_V + wid * 1024 + lane * 16;
    const LAS char* kp0 = lds + SB_K + hi * 1024 + r32 * 16;
    const LAS char* vp0 = lds + SB_V + ((lane >> 4) & 1) * 32 + (lane & 3) * 8 + (4 * hi + ((lane & 15) >> 2)) * 64;
    int kt = 4 * qb + 3, par = 0;
    volatile LAS int* flg = (volatile LAS int*)(lds + XTRA_OFF + 1024);
    u32x4 kreg = *(const u32x4*)(ksrc + (size_t)kt * 64 * NPROJ), vreg = *(const u32x4*)(vsrc + (size_t)kt * 64 * NPROJ);
    for (;;) {
        *(LAS u32x4*)kdst = kreg; *(LAS u32x4*)vdst = vreg;
        __syncthreads();
        if (kt > 0) { kreg = *(const u32x4*)(ksrc + (size_t)(kt - 1) * 64 * NPROJ); vreg = *(const u32x4*)(vsrc + (size_t)(kt - 1) * 64 * NPROJ); }
        const int k0 = kt * 64;
        const bool active = (k0 < qw0 + 31) && !__all(carry >= SB_THR);
        if (active) {
            f32x16 p0, p1;
#pragma unroll
            for (int r = 0; r < 16; ++r) { p0[r] = 0.f; p1[r] = 0.f; }
#pragma unroll
            for (int d0 = 0; d0 < 4; ++d0) { const bf16x8 a0 = *(const LAS bf16x8*)(kp0 + d0 * 2048), a1 = *(const LAS bf16x8*)(kp0 + d0 * 2048 + 512);
                p0 = MFMA32(a0, qr[d0], p0); p1 = MFMA32(a1, qr[d0], p1); }
            const bool mask = (k0 + 63 >= qw0);
            float sp[8][4], Mj[8];
#pragma unroll
            for (int j = 0; j < 8; ++j) { float s = 0.f;
#pragma unroll
                for (int i = 0; i < 4; ++i) { const float zl = (j < 4) ? p0[4 * (j & 3) + i] : p1[4 * (j & 3) + i];
                    float v = fmaxf(zl, 0.f) + flog2(1.0f + fexp2(-fabsf(zl)));
                    if (mask) { const int key = k0 + 32 * (j >> 2) + 8 * (j & 3) + 4 * hi + i; v = (key < q) ? v : 0.f; }
                    sp[j][i] = v; s += v; }
                Mj[j] = s; }
            float ps = 0.f; u32x4 pw[4];
#pragma unroll
            for (int j = 7; j >= 0; --j) {
                const auto rr = __builtin_amdgcn_permlane32_swap(__float_as_uint(Mj[j]), __float_as_uint(Mj[j]), false, false);
                const float Pp = __uint_as_float(hi ? rr[0] : rr[1]);
                float C = carry + ps + (hi ? 0.f : Pp);
                float w[4];
#pragma unroll
                for (int i = 3; i >= 0; --i) { const float zl = (j < 4) ? p0[4 * (j & 3) + i] : p1[4 * (j & 3) + i];
                    C += sp[j][i]; float wv = fexp2(zl - C);
                    if (mask) { const int key = k0 + 32 * (j >> 2) + 8 * (j & 3) + 4 * hi + i; wv = (key < q) ? wv : 0.f; }
                    w[i] = wv; }
                pw[j >> 1][2 * (j & 1)] = cvtpk(w[0], w[1]); pw[j >> 1][2 * (j & 1) + 1] = cvtpk(w[2], w[3]);
                ps += Mj[j] + Pp; }
            carry += ps;
#pragma unroll
            for (int ks = 0; ks < 4; ++ks) {
                const s16x4 l0 = vtr(vp0 + ks * 1024), h0 = vtr(vp0 + ks * 1024 + 512), l1 = vtr(vp0 + 4096 + ks * 1024), h1 = vtr(vp0 + 4096 + ks * 1024 + 512);
                const bf16x8 pa = __builtin_bit_cast(bf16x8, pw[ks]);
                o0 = MFMA32(pa, ((bf16x8){l0[0], l0[1], l0[2], l0[3], h0[0], h0[1], h0[2], h0[3]}), o0);
                o1 = MFMA32(pa, ((bf16x8){l1[0], l1[1], l1[2], l1[3], h1[0], h1[1], h1[2], h1[3]}), o1); }
        }
        const int need = (kt > 0) && !__all(carry >= SB_THR);
        if (lane == 0) flg[par * 8 + wid] = need;
        __syncthreads();
        const int any = (flg[par * 8] | flg[par * 8 + 1]) | (flg[par * 8 + 2] | flg[par * 8 + 3]) | (flg[par * 8 + 4] | flg[par * 8 + 5]) | (flg[par * 8 + 6] | flg[par * 8 + 7]);
        par ^= 1;
        if (!any) break;
        --kt;
    }
    bf16* Y = (bf16*)(F.ws + WS_YSB) + (size_t)(b * SEQ + qw0) * 512 + h * 64 + r32;
#pragma unroll
    for (int r = 0; r < 16; ++r) { const int rw = crow(r, hi); Y[(size_t)rw * 512] = (bf16)(cvtpk(o0[r], 0.f) & 0xffffu); Y[(size_t)rw * 512 + 32] = (bf16)(cvtpk(o1[r], 0.f) & 0xffffu); }
}

DI float ret_log2g(int h) { const float x = fexp2(-(float)(5 + h)); return -LOG2E * (x * (1.0f + x * (0.5f + x * (0.33333334f + x * (0.25f + x * 0.2f))))); }
DI int vlay(int tok, int col) { return (col >> 5) * 4096 + (tok >> 4) * 1024 + (tok & 15) * 64 + (col & 31) * 2; }
struct RotRegs { u32x4 a, b; f32x4 c0, c1, s0, s1; };
DI void rot_load(RotRegs& R, const bf16* row  , const float* rope, int pos, int c) {
    R.a = *(const u32x4*)(row + 8 * c); R.b = *(const u32x4*)(row + 32 + 8 * c);
    const float* ct = rope + pos * 32 + 8 * c; const float* st = ct + SEQ * 32;
    R.c0 = *(const f32x4*)ct; R.c1 = *(const f32x4*)(ct + 4); R.s0 = *(const f32x4*)st; R.s1 = *(const f32x4*)(st + 4);
}
DI void rot_apply(const RotRegs& R, f32x4& y1a, f32x4& y1b, f32x4& y2a, f32x4& y2b) {
    f32x4 x1a, x1b, x2a, x2b; unpack8(R.a, x1a, x1b); unpack8(R.b, x2a, x2b);
    y1a = x1a * R.c0 - x2a * R.s0; y1b = x1b * R.c1 - x2b * R.s1; y2a = x1a * R.s0 + x2a * R.c0; y2b = x1b * R.s1 + x2b * R.c1;
}

constexpr int RT_KD = 16384, RT_V = 24576;
DI void rt_unit(Frame& F, int b, int h, int g) {
    const int lane = F.lane, r32 = lane & 31, hi = lane >> 5, wid = F.wave, tid = F.tid, di = wid >> 2, dj = wid & 3;
    LAS char* lds = (LAS char*)F.lds;
    const bf16* Pj = (const bf16*)(F.ws + WS_PROJ) + (size_t)(b * SEQ + g * 512) * NPROJ;
    const float* rope = (const float*)(F.ws + WS_ROPE);
    const float lg = ret_log2g(h);
    f32x16 acc;
#pragma unroll
    for (int r = 0; r < 16; ++r) acc[r] = 0.f;
    const int ktok = tid >> 2, kc = tid & 3;
    RotRegs R; u32x4 v0, v1;
    const int vt0 = tid >> 4, vc0 = tid & 15, vt1 = (tid + 512) >> 4;
#define RT_LOADS(step_) do { const bf16* base_ = Pj + (size_t)((step_) * 64) * NPROJ; \
        if (tid < 256) rot_load(R, base_ + (size_t)ktok * NPROJ + C_RK + h * 64, rope, g * 512 + (step_) * 64 + ktok, kc); \
        v0 = *(const u32x4*)(base_ + (size_t)vt0 * NPROJ + C_RV + h * 128 + 8 * vc0); v1 = *(const u32x4*)(base_ + (size_t)vt1 * NPROJ + C_RV + h * 128 + 8 * vc0); } while (0)
    RT_LOADS(0);
    const LAS char* trb = lds + ((lane >> 4) & 1) * 32 + (lane & 3) * 8 + (4 * hi + ((lane & 15) >> 2)) * 64;
    for (int step = 0; step < 8; ++step) {
        if (tid < 256) { f32x4 y1a, y1b, y2a, y2b; rot_apply(R, y1a, y1b, y2a, y2b); const float dec = fexp2(lg * (float)(511 - (step * 64 + ktok)));
            *(LAS u32x4*)(lds + RT_KD + vlay(ktok, 8 * kc)) = pack8(y1a * dec, y1b * dec); *(LAS u32x4*)(lds + RT_KD + vlay(ktok, 32 + 8 * kc)) = pack8(y2a * dec, y2b * dec); }
        *(LAS u32x4*)(lds + RT_V + vlay(vt0, 8 * vc0)) = v0; *(LAS u32x4*)(lds + RT_V + vlay(vt1, 8 * vc0)) = v1;
        __syncthreads();
        if (step < 7) RT_LOADS(step + 1);
#pragma unroll
        for (int ks = 0; ks < 4; ++ks) {
            const s16x4 al = vtr(trb + RT_KD + di * 4096 + ks * 1024), ah = vtr(trb + RT_KD + di * 4096 + ks * 1024 + 512);
            const s16x4 bl = vtr(trb + RT_V + dj * 4096 + ks * 1024), bh = vtr(trb + RT_V + dj * 4096 + ks * 1024 + 512);
            acc = MFMA32(((bf16x8){al[0], al[1], al[2], al[3], ah[0], ah[1], ah[2], ah[3]}), ((bf16x8){bl[0], bl[1], bl[2], bl[3], bh[0], bh[1], bh[2], bh[3]}), acc); }
        __syncthreads();
    }
    float* G = (float*)(F.ws + WS_GTOT) + (size_t)((b * 8 + h) * 4 + g) * 8192 + dj * 32 + r32;
#pragma unroll
    for (int r = 0; r < 16; ++r) G[(di * 32 + crow(r, hi)) * 128] = acc[r];
}

constexpr int RO_QD = 0, RO_KI = 8192, RO_KD = 16384, RO_V = 24576, RO_SS = 40960, RO_OST = 57344;
DI void ro_unit(Frame& F, int b, int h, int g) {
    const int lane = F.lane, r32 = lane & 31, hi = lane >> 5, wid = F.wave, tid = F.tid, ci = wid >> 2, dj = wid & 3;
    LAS char* lds = (LAS char*)F.lds;
    const bf16* Pg = (const bf16*)(F.ws + WS_PROJ) + (size_t)(b * SEQ + g * 512) * NPROJ;
    const float* rope = (const float*)(F.ws + WS_ROPE);
    const float lg = ret_log2g(h);
    f32x16 st;
#pragma unroll
    for (int r = 0; r < 16; ++r) st[r] = 0.f;
    for (int gp = 0; gp < g; ++gp) { const float coef = fexp2(lg * (float)(512 * (g - 1 - gp)));
        const float* G = (const float*)(F.ws + WS_GTOT) + (size_t)((b * 8 + h) * 4 + gp) * 8192 + dj * 32 + r32;
#pragma unroll
        for (int r = 0; r < 16; ++r) st[r] += coef * G[(ci * 32 + crow(r, hi)) * 128]; }
    const float dec64 = fexp2(lg * 64.0f);
    const bool isq = tid < 256; const int rtok = (tid & 255) >> 2, rc = tid & 3;
    RotRegs R; u32x4 v0, v1, gn0, gn1, gc0, gc1;
    const int vt0 = tid >> 4, vc0 = tid & 15, vt1 = (tid + 512) >> 4;
    const int grow = tid >> 3, gseg = tid & 7;
#define RO_LOADS(n_) do { const bf16* base_ = Pg + (size_t)((n_) * 64) * NPROJ; \
        rot_load(R, base_ + (size_t)rtok * NPROJ + (isq ? C_RQ : C_RK) + h * 64, rope, g * 512 + (n_) * 64 + rtok, rc); \
        v0 = *(const u32x4*)(base_ + (size_t)vt0 * NPROJ + C_RV + h * 128 + 8 * vc0); v1 = *(const u32x4*)(base_ + (size_t)vt1 * NPROJ + C_RV + h * 128 + 8 * vc0); \
        gn0 = *(const u32x4*)(base_ + (size_t)grow * NPROJ + C_RG + h * 128 + gseg * 16); gn1 = *(const u32x4*)(base_ + (size_t)grow * NPROJ + C_RG + h * 128 + gseg * 16 + 8); } while (0)
    RO_LOADS(0);
    const LAS char* trv = lds + ((lane >> 4) & 1) * 32 + (lane & 3) * 8 + (4 * hi + ((lane & 15) >> 2)) * 64;
    const LAS char* trs = lds + ((lane >> 4) & 1) * 32 + (lane & 3) * 8 + (8 * hi + ((lane & 15) >> 2)) * 64;
    for (int n = 0; n < 8; ++n) {
        lds_barrier();
        gc0 = gn0; gc1 = gn1;
        { f32x4 y1a, y1b, y2a, y2b; rot_apply(R, y1a, y1b, y2a, y2b);
          if (isq) { const float s = fexp2(lg * (float)(rtok + 1));
              *(LAS u32x4*)(lds + RO_QD + rc * 1024 + rtok * 16) = pack8(y1a * s, y1b * s); *(LAS u32x4*)(lds + RO_QD + (rc + 4) * 1024 + rtok * 16) = pack8(y2a * s, y2b * s); }
          else { const float si = fexp2(-lg * (float)(rtok + 1)), sd = fexp2(lg * (float)(63 - rtok));
              *(LAS u32x4*)(lds + RO_KI + rc * 1024 + rtok * 16) = pack8(y1a * si, y1b * si); *(LAS u32x4*)(lds + RO_KI + (rc + 4) * 1024 + rtok * 16) = pack8(y2a * si, y2b * si);
              *(LAS u32x4*)(lds + RO_KD + vlay(rtok, 8 * rc)) = pack8(y1a * sd, y1b * sd); *(LAS u32x4*)(lds + RO_KD + vlay(rtok, 32 + 8 * rc)) = pack8(y2a * sd, y2b * sd); } }
        *(LAS u32x4*)(lds + RO_V + vlay(vt0, 8 * vc0)) = v0; *(LAS u32x4*)(lds + RO_V + vlay(vt1, 8 * vc0)) = v1;
#pragma unroll
        for (int r = 0; r < 16; ++r) *(LAS bf16*)(lds + RO_SS + vlay(ci * 32 + crow(r, hi), dj * 32 + r32)) = (bf16)(cvtpk(st[r], 0.f) & 0xffffu);
        lds_barrier();
        if (n < 7) RO_LOADS(n + 1);
        bf16x8 qf[4];
#pragma unroll
        for (int d0 = 0; d0 < 4; ++d0) qf[d0] = *(const LAS bf16x8*)(lds + RO_QD + (2 * d0 + hi) * 1024 + (ci * 32 + r32) * 16);
        f32x16 p0, p1, o;
#pragma unroll
        for (int r = 0; r < 16; ++r) { p0[r] = 0.f; p1[r] = 0.f; o[r] = 0.f; }
#pragma unroll
        for (int d0 = 0; d0 < 4; ++d0) { p0 = MFMA32(*(const LAS bf16x8*)(lds + RO_KI + (2 * d0 + hi) * 1024 + r32 * 16), qf[d0], p0);
            if (ci) p1 = MFMA32(*(const LAS bf16x8*)(lds + RO_KI + (2 * d0 + hi) * 1024 + 512 + r32 * 16), qf[d0], p1); }
        const int ql = ci * 32 + r32;
        u32x4 pw[4];
#pragma unroll
        for (int j = 0; j < 8; ++j) { float w[4];
#pragma unroll
            for (int i = 0; i < 4; ++i) { const float z = (j < 4) ? p0[4 * (j & 3) + i] : p1[4 * (j & 3) + i]; const int key = 32 * (j >> 2) + 8 * (j & 3) + 4 * hi + i; w[i] = (key <= ql) ? z : 0.f; }
            pw[j >> 1][2 * (j & 1)] = cvtpk(w[0], w[1]); pw[j >> 1][2 * (j & 1) + 1] = cvtpk(w[2], w[3]); }
#pragma unroll
        for (int r = 0; r < 16; ++r) st[r] *= dec64;
#pragma unroll
        for (int ks = 0; ks < 4; ++ks) {
            const s16x4 bl = vtr(trv + RO_V + dj * 4096 + ks * 1024), bh = vtr(trv + RO_V + dj * 4096 + ks * 1024 + 512);
            const bf16x8 vf = (bf16x8){bl[0], bl[1], bl[2], bl[3], bh[0], bh[1], bh[2], bh[3]};
            if (ks < 2 || ci) o = MFMA32(__builtin_bit_cast(bf16x8, pw[ks]), vf, o);
            const s16x4 al = vtr(trv + RO_KD + ci * 4096 + ks * 1024), ah = vtr(trv + RO_KD + ci * 4096 + ks * 1024 + 512);
            st = MFMA32(((bf16x8){al[0], al[1], al[2], al[3], ah[0], ah[1], ah[2], ah[3]}), vf, st); }
#pragma unroll
        for (int d0 = 0; d0 < 4; ++d0) { const s16x4 sl = vtr(trs + RO_SS + dj * 4096 + d0 * 1024), sh = vtr(trs + RO_SS + dj * 4096 + d0 * 1024 + 256);
            o = MFMA32(qf[d0], ((bf16x8){sl[0], sl[1], sl[2], sl[3], sh[0], sh[1], sh[2], sh[3]}), o); }
#pragma unroll
        for (int r = 0; r < 16; ++r) *(LAS float*)(lds + RO_OST + ((ci * 32 + crow(r, hi)) * 132 + dj * 32 + r32) * 4) = o[r];
        lds_barrier();
        { const LAS float* orow = (const LAS float*)(lds + RO_OST) + grow * 132 + gseg * 16; f32x4 x[4]; float s = 0.f;
#pragma unroll
          for (int k = 0; k < 4; ++k) { x[k] = *(const LAS f32x4*)(orow + 4 * k); s += (x[k][0] + x[k][1]) + (x[k][2] + x[k][3]); }
          s += __shfl_xor(s, 1); s += __shfl_xor(s, 2); s += __shfl_xor(s, 4);
          const float mu = s * (1.f / 128.f); float qv = 0.f;
#pragma unroll
          for (int k = 0; k < 4; ++k) { x[k] = x[k] - mu; qv += (x[k][0] * x[k][0] + x[k][1] * x[k][1]) + (x[k][2] * x[k][2] + x[k][3] * x[k][3]); }
          qv += __shfl_xor(qv, 1); qv += __shfl_xor(qv, 2); qv += __shfl_xor(qv, 4);
          const float rstd = 1.0f / sqrtf(qv * (1.f / 128.f) + NORM_EPS);
          const size_t trow = (size_t)(b * SEQ + g * 512 + n * 64 + grow);
          f32x4 g0, g1, g2, g3; unpack8(gc0, g0, g1); unpack8(gc1, g2, g3);
          bf16* yo = (bf16*)(F.ws + WS_YRET) + trow * DM + h * 128 + gseg * 16;
          *(u32x4*)yo = pack8(g0 * sig4(g0) * x[0] * rstd, g1 * sig4(g1) * x[1] * rstd); *(u32x4*)(yo + 8) = pack8(g2 * sig4(g2) * x[2] * rstd, g3 * sig4(g3) * x[3] * rstd); }
    }
}

DI void xa_unit(Frame& F, int b, int hx, int qb) {
    const int lane = F.lane, r32 = lane & 31, hi = lane >> 5, wid = F.wave, tid = F.tid;
    LAS char* lds = (LAS char*)F.lds;
    const int qw0 = qb * 256 + wid * 32;
    const bf16* Q = (const bf16*)(F.ws + WS_QX) + (size_t)(b * SEQ + qw0 + r32) * DM + hx * 256 + hi * 8;
    const bf16* KV = (const bf16*)(F.ws + WS_KVMEM) + (size_t)(b * MEML) * 2048 + hx * 256;
    bf16x8 qr[16];
#pragma unroll
    for (int d0 = 0; d0 < 16; ++d0) qr[d0] = *(const bf16x8*)(Q + d0 * 16);
    __syncthreads();
#pragma unroll 4
    for (int j = 0; j < 16; ++j) { const int i = tid + 512 * j, c = i & 31, key = i >> 5;
        *(LAS u32x4*)(lds + (key >> 6) * 32768 + c * 1024 + (key & 63) * 16) = *(const u32x4*)(KV + (size_t)key * 2048 + 8 * c); }
    __syncthreads();
    f32x16 sc[8];
#pragma unroll
    for (int t = 0; t < 8; ++t)
#pragma unroll
        for (int r = 0; r < 16; ++r) sc[t][r] = 0.f;
#pragma unroll
    for (int kt = 0; kt < 4; ++kt)
#pragma unroll
        for (int d0 = 0; d0 < 16; ++d0) { const LAS char* kp = lds + kt * 32768 + (2 * d0 + hi) * 1024 + r32 * 16;
            sc[2 * kt] = MFMA32(*(const LAS bf16x8*)kp, qr[d0], sc[2 * kt]); sc[2 * kt + 1] = MFMA32(*(const LAS bf16x8*)(kp + 512), qr[d0], sc[2 * kt + 1]); }
    float mx = -3.0e38f;
#pragma unroll
    for (int t = 0; t < 8; ++t)
#pragma unroll
        for (int r = 0; r < 16; ++r) mx = fmaxf(mx, sc[t][r]);
    { const auto rr = __builtin_amdgcn_permlane32_swap(__float_as_uint(mx), __float_as_uint(mx), false, false); mx = fmaxf(__uint_as_float(rr[0]), __uint_as_float(rr[1])); }
    float l = 0.f; u32x4 pa[16];
#pragma unroll
    for (int t = 0; t < 8; ++t)
#pragma unroll
        for (int r2 = 0; r2 < 8; ++r2) { const float e0 = fexp2(sc[t][2 * r2] - mx), e1 = fexp2(sc[t][2 * r2 + 1] - mx); l += e0 + e1; pa[2 * t + (r2 >> 2)][r2 & 3] = cvtpk(e0, e1); }
    { const auto rr = __builtin_amdgcn_permlane32_swap(__float_as_uint(l), __float_as_uint(l), false, false); l = __uint_as_float(rr[0]) + __uint_as_float(rr[1]); }
    LAS float* wsf = (LAS float*)(lds + XTRA_OFF) + wid * 32;
    if (hi == 0) wsf[r32] = 1.0f / l;
    __syncthreads();
#pragma unroll 4
    for (int j = 0; j < 16; ++j) { const int i = tid + 512 * j, c = i & 31, key = i >> 5;
        *(LAS u32x4*)(lds + (key >> 6) * 32768 + (c >> 2) * 4096 + ((key & 63) >> 4) * 1024 + (key & 15) * 64 + (c & 3) * 16) = *(const u32x4*)(KV + (size_t)key * 2048 + 1024 + 8 * c); }
    __syncthreads();
    f32x16 o[8];
#pragma unroll
    for (int t = 0; t < 8; ++t)
#pragma unroll
        for (int r = 0; r < 16; ++r) o[t][r] = 0.f;
    const LAS char* vp0 = lds + ((lane >> 4) & 1) * 32 + (lane & 3) * 8 + (4 * hi + ((lane & 15) >> 2)) * 64;
#pragma unroll
    for (int vt = 0; vt < 4; ++vt)
#pragma unroll
        for (int ks = 0; ks < 4; ++ks) { const bf16x8 pf = __builtin_bit_cast(bf16x8, pa[4 * vt + ks]);
#pragma unroll
            for (int d0 = 0; d0 < 8; ++d0) { const s16x4 lo = vtr(vp0 + vt * 32768 + d0 * 4096 + ks * 1024), hh = vtr(vp0 + vt * 32768 + d0 * 4096 + ks * 1024 + 512);
                o[d0] = MFMA32(pf, ((bf16x8){lo[0], lo[1], lo[2], lo[3], hh[0], hh[1], hh[2], hh[3]}), o[d0]); } }
    bf16* O = (bf16*)(F.ws + WS_OX) + (size_t)(b * SEQ + qw0) * DM + hx * 256 + r32;
#pragma unroll
    for (int r = 0; r < 16; ++r) { const int rw = crow(r, hi); const float il = wsf[rw];
#pragma unroll
        for (int d0 = 0; d0 < 8; ++d0) O[(size_t)rw * DM + d0 * 32] = (bf16)(cvtpk(o[d0][r] * il, 0.f) & 0xffffu); }
}

DI void route_a(Frame& F, int tb) {
    const int lane = F.lane, wid = F.wave, tid = F.tid, tg = wid >> 2, kq = wid & 3, hi = lane >> 5, e31 = lane & 31;
    LAS char* lds = (LAS char*)F.lds;
    const float* wr = inp(F, I_WROUTER); const float* gm = inp(F, I_GMOE); const bf16* x2 = (const bf16*)(F.ws + WS_XN3U);
    unsigned char* sm = F.ws + WS_SMALL;
    __syncthreads();
#pragma unroll 4
    for (int j = 0; j < 16; ++j) { const int i = tid + 512 * j, k = i >> 3, e4 = (i & 7) * 4; *(LAS f32x4*)(lds + (k * 32 + e4) * 4) = *(const f32x4*)(wr + k * 32 + e4) * gm[k]; }
    __syncthreads();
    const int tok = tb * 64 + tg * 32 + e31;
    const bf16* xr = x2 + (size_t)tok * DM + kq * 256 + 4 * hi;
    f32x16 acc;
#pragma unroll
    for (int r = 0; r < 16; ++r) acc[r] = 0.f;
    float ss = 0.f;
    const LAS float* WR = (const LAS float*)lds + (kq * 256 + 4 * hi) * 32 + e31;
    u32x2 xv[32];
#pragma unroll
    for (int m = 0; m < 32; ++m) xv[m] = *(const u32x2*)(xr + 8 * m);
#pragma unroll
    for (int m = 0; m < 32; ++m) { const f32x4 x4 = (f32x4){bflo(xv[m].x), bfhi(xv[m].x), bflo(xv[m].y), bfhi(xv[m].y)}; ss += (x4[0] * x4[0] + x4[1] * x4[1]) + (x4[2] * x4[2] + x4[3] * x4[3]);
#pragma unroll
        for (int t = 0; t < 4; ++t) acc = __builtin_amdgcn_mfma_f32_32x32x2f32(x4[t], WR[(8 * m + t) * 32], acc, 0, 0, 0); }
    ss += __shfl_xor(ss, 32);
    __syncthreads();
    LAS float* PL = (LAS float*)lds;
    LAS float* SSP = (LAS float*)(lds + 32768);
    LAS float* LG = (LAS float*)(lds + 36864);
    LAS int* SEL = (LAS int*)(lds + 49152);
#pragma unroll
    for (int r = 0; r < 16; ++r) PL[(kq * 64 + tg * 32 + crow(r, hi)) * 32 + e31] = acc[r];
    if (hi == 0) SSP[kq * 64 + tg * 32 + e31] = ss;
    __syncthreads();
#pragma unroll
    for (int j = 0; j < 4; ++j) { const int idx = tid + 512 * j, tl = idx >> 5, e = idx & 31;
        const float rstd = 1.0f / sqrtf(((SSP[tl] + SSP[64 + tl]) + (SSP[128 + tl] + SSP[192 + tl])) * (1.f / DM) + NORM_EPS);
        LG[tl * 33 + e] = rstd * ((PL[tl * 32 + e] + PL[(64 + tl) * 32 + e]) + (PL[(128 + tl) * 32 + e] + PL[(192 + tl) * 32 + e])) + inp(F, I_BROUTER)[e];
        if (e == 0) ((float*)(sm + SM_RSTD3))[tb * 64 + tl] = rstd; }
    __syncthreads();
    if (tid < 64) {
        int sel[4]; float val[4];
#pragma unroll
        for (int k = 0; k < 4; ++k) { float best = -3.0e38f; int bi = 0;
            for (int e = 0; e < 32; ++e) { const float v = LG[tid * 33 + e]; bool taken = false;
#pragma unroll
                for (int k2 = 0; k2 < 4; ++k2) if (k2 < k) taken = taken || (sel[k2] == e);
                if (!taken && v > best) { best = v; bi = e; } }
            sel[k] = bi; val[k] = best; }
        float ex[4], sum = 0.f;
#pragma unroll
        for (int k = 0; k < 4; ++k) { ex[k] = fexp2((val[k] - val[0]) * LOG2E); sum += ex[k]; }
        const float inv = 1.0f / sum; const int tk = tb * 64 + tid;
#pragma unroll
        for (int k = 0; k < 4; ++k) { ((int*)(sm + SM_TOPE))[tk * 4 + k] = sel[k]; ((float*)(sm + SM_GATE))[tk * 4 + k] = ex[k] * inv; SEL[tid * 4 + k] = sel[k]; }
    }
    __syncthreads();
    LAS int* WC = (LAS int*)(lds + 51200);
    int e_my = 0, rank_w = 0;
    if (tid < 256) { e_my = SEL[tid]; const unsigned long long lt = (1ull << lane) - 1ull;
        for (int ex = 0; ex < 32; ++ex) { const unsigned long long m = __ballot(e_my == ex); if (e_my == ex) rank_w = __popcll(m & lt); if (lane == ex) WC[wid * 32 + ex] = __popcll(m); } }
    __syncthreads();
    if (tid < 256) { int rank = rank_w; for (int w = 0; w < wid; ++w) rank += WC[w * 32 + e_my]; ((int*)(sm + SM_LRANK))[(tb * 64 + (tid >> 2)) * 4 + (tid & 3)] = rank; }
    else if (tid < 288) { const int e = tid - 256; ((int*)(sm + SM_CNT))[tb * 32 + e] = (WC[e] + WC[32 + e]) + (WC[64 + e] + WC[96 + e]); }
}

DI void route_b(Frame& F, int tb) {
    const int lane = F.lane, wid = F.wave, tid = F.tid;
    LAS int* L = (LAS int*)F.lds;
    unsigned char* sm = F.ws + WS_SMALL;
    const int* CNT = (const int*)(sm + SM_CNT);
    u32x4 xv[8][2];
#pragma unroll
    for (int j = 0; j < 8; ++j) { const u32x4* sp = (const u32x4*)((const bf16*)(F.ws + WS_XN3U) + (size_t)(tb * 64 + wid * 8 + j) * DM) + 2 * lane; xv[j][0] = sp[0]; xv[j][1] = sp[1]; }
    __syncthreads();
    { const int e = tid & 31, seg = tid >> 5; int t = 0, p = 0;
      for (int w = seg * 16; w < seg * 16 + 16; ++w) { const int c = CNT[w * 32 + e]; t += c; p += (w < tb) ? c : 0; }
      L[seg * 32 + e] = t; L[512 + seg * 32 + e] = p; }
    __syncthreads();
    if (tid < 32) { int t = 0, p = 0; for (int s = 0; s < 16; ++s) { t += L[s * 32 + tid]; p += L[512 + s * 32 + tid]; } L[1024 + tid] = t; L[1056 + tid] = p; }
    __syncthreads();
    if (tid == 0) { int run = 0; for (int e = 0; e < 32; ++e) { L[1088 + e] = run; run += ((L[1024 + e] + 255) >> 8) << 8; } L[1120] = run >> 8; }
    __syncthreads();
    if (tid < 256) { const int tok = tb * 64 + (tid >> 2), a = tok * 4 + (tid & 3); const int e = ((const int*)(sm + SM_TOPE))[a];
        const int row = L[1088 + e] + L[1056 + e] + ((const int*)(sm + SM_LRANK))[a];
        ((int*)(sm + SM_AROW))[a] = row; ((float*)(sm + SM_RSCALE))[row] = ((const float*)(sm + SM_RSTD3))[tok]; ((float*)(sm + SM_RGATE))[row] = ((const float*)(sm + SM_GATE))[a]; L[1152 + tid] = row; }
    if (tb == 0 && tid >= 256 && tid < 288) { const int e = tid - 256, nb = (L[1024 + e] + 255) >> 8, b0 = L[1088 + e] >> 8; int* BLKE = (int*)(sm + SM_BLKE);
        for (int i = 0; i < nb; ++i) BLKE[b0 + i] = e; if (e == 0) BLKE[MAXBLK] = L[1120]; }
    __syncthreads();
    unsigned char* XG = F.ws + WS_XG;
    f32x4 gm[4];
#pragma unroll
    for (int k = 0; k < 4; ++k) gm[k] = *((const f32x4*)inp(F, I_GMOE) + 4 * lane + k);
#pragma unroll
    for (int j = 0; j < 8; ++j) { const u32x4 v0 = xv[j][0], v1 = xv[j][1]; u32x4 o;
        o.x = cvt4_fp8(bflo(v0.x) * gm[0][0], bfhi(v0.x) * gm[0][1], bflo(v0.y) * gm[0][2], bfhi(v0.y) * gm[0][3]); o.y = cvt4_fp8(bflo(v0.z) * gm[1][0], bfhi(v0.z) * gm[1][1], bflo(v0.w) * gm[1][2], bfhi(v0.w) * gm[1][3]);
        o.z = cvt4_fp8(bflo(v1.x) * gm[2][0], bfhi(v1.x) * gm[2][1], bflo(v1.y) * gm[2][2], bfhi(v1.y) * gm[2][3]); o.w = cvt4_fp8(bflo(v1.z) * gm[3][0], bfhi(v1.z) * gm[3][1], bflo(v1.w) * gm[3][2], bfhi(v1.w) * gm[3][3]);
#pragma unroll
        for (int k = 0; k < 4; ++k) *((u32x4*)(XG + (size_t)L[1152 + (wid * 8 + j) * 4 + k] * DM) + lane) = o; }
}

DI void combine_final(Frame& F) {
    const int gw = F.bid * NWAVES + F.wave, NGW = F.G * NWAVES, lane = F.lane;
    const bf16* x2 = (const bf16*)(F.ws + WS_XN3U); const bf16* Y = (const bf16*)(F.ws + WS_YROWS); const int* AROW = (const int*)(F.ws + WS_SMALL + SM_AROW);
    const f32x4* gf = (const f32x4*)inp(F, I_GFINAL) + lane;
    for (int tok = gw; tok < T; tok += NGW) {
        const u32x2* xr = (const u32x2*)(x2 + (size_t)tok * DM) + lane; f32x4 v[4];
#pragma unroll
        for (int j = 0; j < 4; ++j) { const u32x2 w = xr[64 * j]; v[j] = (f32x4){bflo(w.x), bfhi(w.x), bflo(w.y), bfhi(w.y)}; }
#pragma unroll
        for (int k = 0; k < 4; ++k) { const int row = AROW[tok * 4 + k]; const u32x2* yr = (const u32x2*)(Y + (size_t)row * DM) + lane;
#pragma unroll
            for (int j = 0; j < 4; ++j) { const u32x2 w = yr[64 * j]; v[j] += (f32x4){bflo(w.x), bfhi(w.x), bflo(w.y), bfhi(w.y)}; } }
        float s = 0.f;
#pragma unroll
        for (int j = 0; j < 4; ++j) s += (v[j][0] * v[j][0] + v[j][1] * v[j][1]) + (v[j][2] * v[j][2] + v[j][3] * v[j][3]);
        const float rstd = 1.0f / sqrtf(wave_sum(s) * (1.f / DM) + NORM_EPS);
        f32x4* o = (f32x4*)(F.out + (size_t)tok * DM) + lane;
#pragma unroll
        for (int j = 0; j < 4; ++j) o[64 * j] = v[j] * rstd * gf[64 * j];
    }
}

constexpr int NPHASE = 14;
#ifndef WGM_P1
#define WGM_P1 2
#endif
#ifndef WGM_MOE
#define WGM_MOE 4
#endif
__global__ void __launch_bounds__(NWAVES * 64, 2) mega_fwd(Args args) {
    extern __shared__ __attribute__((aligned(16))) unsigned char lds_raw[];
    Frame F;
    F.lds = (LAS unsigned char*)lds_raw; F.ws = args.ws; F.out = args.out;
    F.tid = threadIdx.x; F.lane = F.tid & 63; F.wave = __builtin_amdgcn_readfirstlane(F.tid >> 6); F.G = gridDim.x; F.bid = blockIdx.x;
    F.kp = (kptr_t)__builtin_amdgcn_kernarg_segment_ptr();
    if (F.tid < 64) ((LAS unsigned*)(F.lds + LDSCTL_OFF))[F.tid] = 0u;
    __syncthreads();
    const int lo = args.ph_lo, hi = args.ph_hi;
    XcdBarrier bar; bar.bar = (unsigned*)(F.ws + WS_CTL) + CW_BAR; bar.x = 0; bar.st = nullptr;
    if (hi - lo > 1) bar = xcd_barrier_post((unsigned*)(F.ws + WS_CTL) + CW_BAR, (volatile LAS unsigned*)(F.lds + LDSCTL_OFF) + 8);
#ifndef PHASE_MASK
#define PHASE_MASK 0xFFFF
#endif
#define IN(k) (((PHASE_MASK >> (k)) & 1) && lo <= (k) && (k) < hi)
#ifndef PROBE_MASK
#define PROBE_MASK 0
#endif
#define REP(k) (((PROBE_MASK >> (k)) & 1) ? 2 : 1)
#define LAUNDER() do { asm volatile("" : "+s"(F.kp), "+s"(F.ws), "+s"(F.out), "+v"(F.tid), "+s"(F.bid), "+s"(F.G)); F.lane = F.tid & 63; F.wave = __builtin_amdgcn_readfirstlane(F.tid >> 6); ws = F.ws; } while (0)
#define PHASE(k, ...) do { if (IN(k)) { __VA_ARGS__ if (REP(k) == 2) { xcd_barrier(bar); LAUNDER(); __VA_ARGS__ } } } while (0)
#ifdef DOUBLE_BAR
#define SEAM(k) do { if (IN(k) && IN((k) + 1)) { xcd_barrier(bar); xcd_barrier(bar); } LAUNDER(); } while (0)
#else
#define SEAM(k) do { if (IN(k) && IN((k) + 1)) xcd_barrier(bar); LAUNDER(); } while (0)
#endif
    unsigned char* ws = F.ws;
    LAS unsigned char* ring = F.lds + RING_OFF;

    PHASE(0, { p0_prologue(F); }); SEAM(0);

    PHASE(1, {
        const bool conv_first = (F.bid & 1) != 0;
        if (conv_first) { p0_experts(F, F.bid * NWAVES + F.wave, F.G * NWAVES); __syncthreads(); }
        pg8::Sched2 S{(const bf16*)(ws + WS_XN1), (const bf16*)(ws + WS_WIN), T / 256, NPROJ / 256, (const bf16*)(ws + WS_MEMN), (const bf16*)(ws + WS_WCKV), (BATCH * MEML) / 256, 2048 / 256, F.G, F.bid, 1024, WGM_P1};
        Epi1 E{(bf16*)(ws + WS_PROJ), (bf16*)(ws + WS_KVMEM)};
        pg8::gemm_phase(ring, 1024, S, E);
        if (!conv_first) { p0_experts(F, F.bid * NWAVES + F.wave, F.G * NWAVES); }
    }); SEAM(1);

    PHASE(2, {
        for (int L = F.bid; L < 512 + 192; L += F.G) {
            if (L < 512) sb_unit(F, L >> 6, L & 7, (L >> 3) & 7);
            else { const int q = L - 512; rt_unit(F, (q / 3) >> 3, (q / 3) & 7, q % 3); }
        }
    }); SEAM(2);

    PHASE(3, { for (int L = F.bid; L < 256; L += F.G) ro_unit(F, L >> 5, (L >> 2) & 7, L & 3); }); SEAM(3);

    PHASE(4, {
        { pg8::Sched2 S{(const bf16*)(ws + WS_YSB), (const bf16*)(ws + WS_WSBO), T / 256, 4, nullptr, nullptr, 0, 1, F.G, F.bid, 512};
          Epi5a E{(const bf16*)(ws + WS_PROJ), (bf16*)(ws + WS_TMP)}; pg8::gemm_phase(ring, 512, S, E); }
        { pg8::Sched2 S{(const bf16*)(ws + WS_YRET), (const bf16*)(ws + WS_WRETO), T / 256, 4, nullptr, nullptr, 0, 1, F.G, F.bid, 1024};
          Epi5b E{(const bf16*)(ws + WS_PROJ), (const bf16*)(ws + WS_TMP), (bf16*)(ws + WS_MERGED)}; pg8::gemm_phase(ring, 1024, S, E); }
    }); SEAM(4);

    PHASE(5, {
        pg8::Sched2 S{(const bf16*)(ws + WS_MERGED), (const bf16*)(ws + WS_WMIX), T / 256, 4, nullptr, nullptr, 0, 1, F.G, F.bid, 1024};
        EpiRes<true> E{inp(F, I_X), (bf16*)(ws + WS_XN2U), (float*)(ws + WS_SLOTS)}; pg8::gemm_phase(ring, 1024, S, E);
    }); SEAM(5);

    PHASE(6, {
        pg8::Sched2 S{(const bf16*)(ws + WS_XN2U), (const bf16*)(ws + WS_WCQ), T / 256, 4, nullptr, nullptr, 0, 1, F.G, F.bid, 1024};
        Epi7 E{(const float*)(ws + WS_SLOTS), (bf16*)(ws + WS_QX)}; pg8::gemm_phase(ring, 1024, S, E);
    }); LAUNDER();

    PHASE(7, { for (int L = F.bid; L < 256; L += F.G) { int pm_, pn_; pg8::map_unit(L, 256, 64, 4, pm_, pn_); xa_unit(F, pm_ >> 3, pn_, pm_ & 7); } }); SEAM(7);

    PHASE(8, {
        pg8::Sched2 S{(const bf16*)(ws + WS_OX), (const bf16*)(ws + WS_WCO), T / 256, 4, nullptr, nullptr, 0, 1, F.G, F.bid, 1024};
        EpiRes<false> E{(const void*)(ws + WS_XN2U), (bf16*)(ws + WS_XN3U), nullptr}; pg8::gemm_phase(ring, 1024, S, E);
    }); SEAM(8);

    PHASE(9, { for (int tb = F.bid; tb < T / 64; tb += F.G) route_a(F, tb); }); SEAM(9);
    PHASE(10, { for (int tb = F.bid; tb < T / 64; tb += F.G) route_b(F, tb); }); SEAM(10);

    PHASE(11, {
        const int* BLKE = (const int*)(ws + WS_SMALL + SM_BLKE); const int nblk = __builtin_amdgcn_readfirstlane(__hip_atomic_load(BLKE + MAXBLK, RLX_AGENT));
        pg8::SchedMoE S{ws + WS_XG, ws + WS_WE1, BLKE, nblk, 8, F.G, F.bid, 1024, (size_t)2048 * 1024, WGM_MOE};
        Epi12 E{(const float*)(ws + WS_SMALL + SM_RSCALE), inp(F, I_BE1), ws + WS_ACT}; pg8::gemm_phase(ring, 1024, S, E);
    }); SEAM(11);

    PHASE(12, {
        const int* BLKE = (const int*)(ws + WS_SMALL + SM_BLKE); const int nblk = __builtin_amdgcn_readfirstlane(__hip_atomic_load(BLKE + MAXBLK, RLX_AGENT));
        pg8::SchedMoE S{ws + WS_ACT, ws + WS_WE2, BLKE, nblk, 4, F.G, F.bid, 1024, (size_t)1024 * 1024, WGM_MOE};
        Epi13 E{(const float*)(ws + WS_SMALL + SM_RGATE), inp(F, I_BE2), (bf16*)(ws + WS_YROWS)}; pg8::gemm_phase(ring, 1024, S, E);
    }); SEAM(12);

    PHASE(13, { combine_final(F); });
#undef IN
#undef SEAM
}

#if MK_DEBUG
DI unsigned hsh(unsigned x) { x ^= x >> 16; x *= 0x7feb352du; x ^= x >> 15; x *= 0x846ca68bu; x ^= x >> 16; return x; }
DI void chk_report(unsigned char* ws, int phase, float got, float ref, float atol) {
    float e = fabsf(got - ref) / (fabsf(ref) + atol); if (!(e == e)) e = 1.0e9f; if (e > 1.0e9f) e = 1.0e9f;
    atomicMax((unsigned*)(ws + WS_CTL) + CW_CHK + phase, __float_as_uint(e));
}
DI float dbg_bf(const bf16* p, size_t i) { return bf2f(p[i]); }
DI float dbg_f8(const unsigned char* p, size_t i) { const unsigned b = p[i]; const int e = (b >> 3) & 15, m = b & 7; const float v = e ? (1.0f + m * 0.125f) * exp2f((float)(e - 7)) : m * 0.125f * 0.015625f; return (b & 128) ? -v : v; }
DI float dbg_sigm(float x) { return 1.0f / (1.0f + expf(-x)); }
DI float dbg_rope(const float* rope, int pos, int i, bool sn) { return rope[(sn ? SEQ * 32 : 0) + pos * 32 + i]; }
DI float dbg_rot(const bf16* row, const float* rope, int pos, int d) {
    const int i = d & 31; const float x1 = bf2f(row[i]), x2 = bf2f(row[32 + i]); const float c = dbg_rope(rope, pos, i, false), s = dbg_rope(rope, pos, i, true);
    return d < 32 ? x1 * c - x2 * s : x1 * s + x2 * c;
}
__global__ void __launch_bounds__(64) dbg_kernel(Args a, int phase) {
    const unsigned sid = blockIdx.x * 64 + threadIdx.x; unsigned char* ws = a.ws;
    const unsigned r0 = hsh(sid * 4 + 1 + phase * 7919), r1 = hsh(sid * 4 + 2 + phase * 104729), r2 = hsh(sid * 4 + 3 + phase * 31), r3 = hsh(sid * 4 + 4 + phase * 17);
    const float* rope = (const float*)(ws + WS_ROPE);
    const bf16* PROJ = (const bf16*)(ws + WS_PROJ);
    if (phase == 0) {
        const int which = sid % 12;
        if (which == 7 || which == 8) {   } else if (which < 9) {
            const float* W; const bf16* WT; int K, N; int e = 0;
            switch (which) { case 0: W = a.in[I_WIN]; WT = (const bf16*)(ws + WS_WIN); K = 1024; N = NPROJ; break; case 1: W = a.in[I_WSBO]; WT = (const bf16*)(ws + WS_WSBO); K = 512; N = 1024; break;
                case 2: W = a.in[I_WRETO]; WT = (const bf16*)(ws + WS_WRETO); K = 1024; N = 1024; break; case 3: W = a.in[I_WMIX]; WT = (const bf16*)(ws + WS_WMIX); K = 1024; N = 1024; break;
                case 4: W = a.in[I_WCQ]; WT = (const bf16*)(ws + WS_WCQ); K = 1024; N = 1024; break; case 5: W = a.in[I_WCKV]; WT = (const bf16*)(ws + WS_WCKV); K = 1024; N = 2048; break;
                case 6: W = a.in[I_WCO]; WT = (const bf16*)(ws + WS_WCO); K = 1024; N = 1024; break;
                case 7: e = r2 % 32; W = a.in[I_WE1] + (size_t)e * 1024 * 2048; WT = (const bf16*)(ws + WS_WE1 + (size_t)e * 2048 * 1024); K = 1024; N = 2048; break;
                default: e = r2 % 32; W = a.in[I_WE2] + (size_t)e * 1024 * 1024; WT = (const bf16*)(ws + WS_WE2 + (size_t)e * 1024 * 1024); K = 1024; N = 1024; break; }
            const int k = r0 % K, n = r1 % N; int nr = n; if (which == 7) nr = n < 1024 ? 256 * (n >> 7) + (n & 127) : 256 * ((n - 1024) >> 7) + 128 + ((n - 1024) & 127);
            if (which >= 7) chk_report(ws, 0, dbg_f8((const unsigned char*)WT, (size_t)nr * K + k), W[(size_t)k * N + n] * 64.0f, 0.5f);
            else { const float ref = bf2f((bf16)(cvtpk(W[(size_t)k * N + n], 0.f) & 0xffffu)); chk_report(ws, 0, dbg_bf(WT, (size_t)nr * K + k), ref, 1e-6f); }
        } else if (which < 11) {
            const bool isx = which == 9; const int row = isx ? r0 % T : r0 % (BATCH * MEML), col = r1 % DM;
            const float* xr = (isx ? a.in[I_X] : a.in[I_MEM]) + (size_t)row * DM; double ss = 0; for (int k = 0; k < DM; ++k) ss += (double)xr[k] * xr[k];
            const float ref = xr[col] * (float)(1.0 / sqrt(ss / DM + 1e-5)) * (isx ? a.in[I_GMIX] : a.in[I_GMEM])[col];
            chk_report(ws, 0, dbg_bf((const bf16*)(ws + (isx ? WS_XN1 : WS_MEMN)), (size_t)row * DM + col), ref, 0.5f);
        } else { const int pos = r0 % SEQ, i = r1 % 32; const double inv = exp2(-(double)i * 13.287712379549449 / 32.0); const float angf = (float)pos * (float)inv; double an = (double)angf; an -= 6.283185307179586 * rint(an / 6.283185307179586);
            const float rev = (float)(an / 6.283185307179586); chk_report(ws, 0, dbg_rope(rope, pos, i, false), __builtin_amdgcn_cosf(rev), 0.5f); chk_report(ws, 0, dbg_rope(rope, pos, i, true), __builtin_amdgcn_sinf(rev), 0.5f); }
    } else if (phase == 1) {
        if (sid % 3 == 2) {
            const int e = r2 % 32; const bool w1 = (sid & 4) != 0; const int K = 1024, N = w1 ? 2048 : 1024; const float* W = (w1 ? a.in[I_WE1] : a.in[I_WE2]) + (size_t)e * K * N; const unsigned char* WT = ws + (w1 ? WS_WE1 : WS_WE2) + (size_t)e * N * K;
            const int k = r0 % K, n = r1 % N; int nr = n; if (w1) nr = n < 1024 ? 256 * (n >> 7) + (n & 127) : 256 * ((n - 1024) >> 7) + 128 + ((n - 1024) & 127);
            chk_report(ws, 1, dbg_f8(WT, (size_t)nr * K + k), W[(size_t)k * N + n] * 64.0f, 0.5f);
        } else if (sid & 1) { const int row = r0 % T, col = r1 % NPROJ; const bf16* xr = (const bf16*)(ws + WS_XN1) + (size_t)row * DM; const float* W = a.in[I_WIN]; double s = 0; for (int k = 0; k < DM; ++k) s += (double)bf2f(xr[k]) * W[(size_t)k * NPROJ + col];
            const float sc = col < 512 ? SBQ_SCALE : ((col >= C_RK && col < C_RV) ? 0.125f : 1.0f); chk_report(ws, 1, dbg_bf(PROJ, (size_t)row * NPROJ + col), (float)s * sc, sc); }
        else { const int row = r0 % (BATCH * MEML), col = r1 % 2048; const bf16* xr = (const bf16*)(ws + WS_MEMN) + (size_t)row * DM; const float* W = a.in[I_WCKV]; double s = 0; for (int k = 0; k < DM; ++k) s += (double)bf2f(xr[k]) * W[(size_t)k * 2048 + col];
            chk_report(ws, 1, dbg_bf((const bf16*)(ws + WS_KVMEM), (size_t)row * 2048 + col), (float)s, 1.0f); }
    } else if (phase == 2) {
        if (sid & 1) {
            const int b = r0 % BATCH, h = r1 % 8, t = (sid & 2) ? r2 % SEQ : r2 % 300, d = r3 % 64; const bf16* Pb = PROJ + (size_t)b * SEQ * NPROJ; const bf16* qrow = Pb + (size_t)t * NPROJ + C_SBQ + h * 64;
            double o = 0, between = 0;
            for (int s = t - 1; s >= 0; --s) { const bf16* krow = Pb + (size_t)s * NPROJ + C_SBK + h * 64; double zl = 0; for (int k = 0; k < 64; ++k) zl += (double)bf2f(qrow[k]) * bf2f(krow[k]);
                const double z = zl / 1.4426950408889634; const double lsp = z > 0 ? z + log1p(exp(-z)) : log1p(exp(z));
                const double w = exp(z - lsp + between); between -= lsp; o += w * bf2f(Pb[(size_t)s * NPROJ + C_SBV + h * 64 + d]); if (between < -200.0) break; }
            chk_report(ws, 2, dbg_bf((const bf16*)(ws + WS_YSB), (size_t)(b * SEQ + t) * 512 + h * 64 + d), (float)o, 0.5f);
        } else {
            const int b = r0 % BATCH, h = r1 % 8, g = r2 % 3, dk = r3 % 64, dv = (r3 >> 8) % 128; const double gam = 1.0 - exp2(-5.0 - h); double s = 0;
            for (int p = 0; p < 512; ++p) { const int pos = g * 512 + p; const bf16* row = PROJ + (size_t)(b * SEQ + pos) * NPROJ; s += pow(gam, 511 - p) * dbg_rot(row + C_RK + h * 64, rope, pos, dk) * bf2f(row[C_RV + h * 128 + dv]); }
            chk_report(ws, 2, ((const float*)(ws + WS_GTOT))[(size_t)((b * 8 + h) * 4 + g) * 8192 + dk * 128 + dv], (float)s, 0.5f);
        }
    } else if (phase == 3) {
        const int b = r0 % BATCH, h = r1 % 8, t = (sid & 1) ? r2 % SEQ : r2 % 200; const double gam = 1.0 - exp2(-5.0 - h); const bf16* Pb = PROJ + (size_t)b * SEQ * NPROJ;
        float q[64];
#pragma unroll
        for (int d = 0; d < 64; ++d) q[d] = dbg_rot(Pb + (size_t)t * NPROJ + C_RQ + h * 64, rope, t, d);
        float o[128];
#pragma unroll
        for (int e = 0; e < 128; ++e) o[e] = 0.f;
        for (int s = 0; s <= t; ++s) { const bf16* row = Pb + (size_t)s * NPROJ; float dot = 0.f;
#pragma unroll
            for (int d = 0; d < 64; ++d) dot += q[d] * dbg_rot(row + C_RK + h * 64, rope, s, d);
            const float w = dot * (float)pow(gam, t - s);
#pragma unroll
            for (int e = 0; e < 128; ++e) o[e] += w * bf2f(row[C_RV + h * 128 + e]); }
        float mu = 0.f;
#pragma unroll
        for (int e = 0; e < 128; ++e) mu += o[e];
        mu *= (1.f / 128.f); float var = 0.f;
#pragma unroll
        for (int e = 0; e < 128; ++e) var += (o[e] - mu) * (o[e] - mu);
        const float rstd = 1.0f / sqrtf(var * (1.f / 128.f) + 1e-5f);
#pragma unroll
        for (int e = 0; e < 128; ++e) { const float gv = bf2f(Pb[(size_t)t * NPROJ + C_RG + h * 128 + e]); chk_report(ws, 3, dbg_bf((const bf16*)(ws + WS_YRET), (size_t)(b * SEQ + t) * DM + h * 128 + e), gv * dbg_sigm(gv) * (o[e] - mu) * rstd, 1.0f); }
    } else if (phase == 4) {
        const int row = r0 % T, col = r1 % DM; const bf16* ys = (const bf16*)(ws + WS_YSB) + (size_t)row * 512; const bf16* yr = (const bf16*)(ws + WS_YRET) + (size_t)row * DM; double s1 = 0, s2 = 0;
        for (int k = 0; k < 512; ++k) s1 += (double)bf2f(ys[k]) * a.in[I_WSBO][(size_t)k * DM + col]; for (int k = 0; k < DM; ++k) s2 += (double)bf2f(yr[k]) * a.in[I_WRETO][(size_t)k * DM + col];
        const float ref = dbg_sigm(bf2f(PROJ[(size_t)row * NPROJ + C_GSB + col])) * (float)s1 + dbg_sigm(bf2f(PROJ[(size_t)row * NPROJ + C_GRET + col])) * (float)s2;
        chk_report(ws, 4, dbg_bf((const bf16*)(ws + WS_MERGED), (size_t)row * DM + col), ref, 0.5f);
    } else if (phase == 5 || phase == 8) {
        const bool p5 = phase == 5; const int row = r0 % T, col = r1 % DM; const bf16* ar = (const bf16*)(ws + (p5 ? WS_MERGED : WS_OX)) + (size_t)row * DM; const float* W = p5 ? a.in[I_WMIX] : a.in[I_WCO];
        double s = 0; for (int k = 0; k < DM; ++k) s += (double)bf2f(ar[k]) * W[(size_t)k * DM + col];
        const float xi = p5 ? a.in[I_X][(size_t)row * DM + col] : dbg_bf((const bf16*)(ws + WS_XN2U), (size_t)row * DM + col); const float ref = xi + (float)s; const float got = dbg_bf((const bf16*)(ws + (p5 ? WS_XN2U : WS_XN3U)), (size_t)row * DM + col);
        chk_report(ws, phase, got, ref, 1.0f);
        if (p5) { const bf16* xr = (const bf16*)(ws + WS_XN2U) + (size_t)row * DM; double ss = 0; for (int k = 0; k < DM; ++k) ss += (double)bf2f(xr[k]) * bf2f(xr[k]); float sl = 0; for (int k = 0; k < 16; ++k) sl += ((const float*)(ws + WS_SLOTS))[(size_t)row * 16 + k]; chk_report(ws, 5, sl, (float)ss, 100.0f); }
    } else if (phase == 6) {
        const int row = r0 % T, col = r1 % DM; const bf16* ar = (const bf16*)(ws + WS_XN2U) + (size_t)row * DM; double s = 0, ss = 0; for (int k = 0; k < DM; ++k) { const double x = bf2f(ar[k]); s += x * a.in[I_GXATTN][k] * a.in[I_WCQ][(size_t)k * DM + col]; ss += x * x; }
        chk_report(ws, 6, dbg_bf((const bf16*)(ws + WS_QX), (size_t)row * DM + col), (float)(s / sqrt(ss / DM + 1e-5)) * XQ_SCALE, XQ_SCALE);
    } else if (phase == 7) {
        const int b = r0 % BATCH, t = r1 % SEQ, hx = r2 % 4, d = r3 % 256; const bf16* qrow = (const bf16*)(ws + WS_QX) + (size_t)(b * SEQ + t) * DM + hx * 256; const bf16* KV = (const bf16*)(ws + WS_KVMEM) + (size_t)(b * MEML) * 2048;
        double mx = -1e30; for (int m = 0; m < MEML; ++m) { double z = 0; for (int k = 0; k < 256; ++k) z += (double)bf2f(qrow[k]) * bf2f(KV[(size_t)m * 2048 + hx * 256 + k]); if (z > mx) mx = z; }
        double l = 0, o = 0; for (int m = 0; m < MEML; ++m) { double z = 0; for (int k = 0; k < 256; ++k) z += (double)bf2f(qrow[k]) * bf2f(KV[(size_t)m * 2048 + hx * 256 + k]); const double p = exp2(z - mx); l += p; o += p * bf2f(KV[(size_t)m * 2048 + 1024 + hx * 256 + d]); }
        chk_report(ws, 7, dbg_bf((const bf16*)(ws + WS_OX), (size_t)(b * SEQ + t) * DM + hx * 256 + d), (float)(o / l), 0.1f);
    } else if (phase == 9) {
        const int tok = r0 % T; const bf16* xr = (const bf16*)(ws + WS_XN3U) + (size_t)tok * DM; double ss = 0; for (int k = 0; k < DM; ++k) ss += (double)bf2f(xr[k]) * bf2f(xr[k]); const double rstd = 1.0 / sqrt(ss / DM + 1e-5);
        chk_report(ws, 9, ((const float*)(ws + WS_SMALL + SM_RSTD3))[tok], (float)rstd, 1e-3f);
        double v0 = -1e30, v1 = -1e30, v2 = -1e30, v3 = -1e30, v4 = -1e30; int i0 = -1, i1 = -1, i2 = -1, i3 = -1;
        for (int e = 0; e < 32; ++e) { double s = 0; for (int k = 0; k < DM; ++k) s += (double)bf2f(xr[k]) * a.in[I_GMOE][k] * a.in[I_WROUTER][k * 32 + e]; s = s * rstd + a.in[I_BROUTER][e];
            if (s > v0) { v4 = v3; v3 = v2; i3 = i2; v2 = v1; i2 = i1; v1 = v0; i1 = i0; v0 = s; i0 = e; } else if (s > v1) { v4 = v3; v3 = v2; i3 = i2; v2 = v1; i2 = i1; v1 = s; i1 = e; }
            else if (s > v2) { v4 = v3; v3 = v2; i3 = i2; v2 = s; i2 = e; } else if (s > v3) { v4 = v3; v3 = s; i3 = e; } else if (s > v4) v4 = s; }
        const int* te = (const int*)(ws + WS_SMALL + SM_TOPE) + tok * 4; const float* tg = (const float*)(ws + WS_SMALL + SM_GATE) + tok * 4;
        const bool close = (v0 - v1 < 1e-4) || (v1 - v2 < 1e-4) || (v2 - v3 < 1e-4) || (v3 - v4 < 1e-4);
        if (!close) { chk_report(ws, 9, (te[0] == i0 && te[1] == i1 && te[2] == i2 && te[3] == i3) ? 0.f : 1.f, 0.f, 1.0f);
            const double e1 = exp(v1 - v0), e2 = exp(v2 - v0), e3 = exp(v3 - v0), sm = 1.0 + e1 + e2 + e3; chk_report(ws, 9, tg[0], (float)(1.0 / sm), 0.01f); chk_report(ws, 9, tg[3], (float)(e3 / sm), 0.01f); }
    } else if (phase == 10) {
        const int tok = r0 % T, k = r1 % 4, col = r2 % DM; const int row = ((const int*)(ws + WS_SMALL + SM_AROW))[tok * 4 + k], e = ((const int*)(ws + WS_SMALL + SM_TOPE))[tok * 4 + k]; const int* BLKE = (const int*)(ws + WS_SMALL + SM_BLKE);
        const bool okr = row >= 0 && row < BLKE[MAXBLK] * 256; chk_report(ws, 10, okr ? 0.f : 1.f, 0.f, 1.0f);
        if (okr) { chk_report(ws, 10, BLKE[row >> 8] == e ? 0.f : 1.f, 0.f, 1.0f); chk_report(ws, 10, dbg_f8(ws + WS_XG, (size_t)row * DM + col), dbg_bf((const bf16*)(ws + WS_XN3U), (size_t)tok * DM + col) * a.in[I_GMOE][col], 0.5f);
            chk_report(ws, 10, ((const float*)(ws + WS_SMALL + SM_RSCALE))[row], ((const float*)(ws + WS_SMALL + SM_RSTD3))[tok], 1e-6f); chk_report(ws, 10, ((const float*)(ws + WS_SMALL + SM_RGATE))[row], ((const float*)(ws + WS_SMALL + SM_GATE))[tok * 4 + k], 1e-6f);
 }
    } else if (phase == 11) {
        const int tok = r0 % T, k = r1 % 4, col = r2 % DFF; const int row = ((const int*)(ws + WS_SMALL + SM_AROW))[tok * 4 + k], e = ((const int*)(ws + WS_SMALL + SM_TOPE))[tok * 4 + k];
        const unsigned char* xr = ws + WS_XG + (size_t)row * DM; const unsigned char* W = ws + WS_WE1 + (size_t)e * 2048 * 1024; const int rg = 256 * (col >> 7) + (col & 127), rl = rg + 128; double sg = 0, sl = 0;
        for (int kk = 0; kk < DM; ++kk) { const double x = dbg_f8(xr, kk); sg += x * dbg_f8(W, (size_t)rg * 1024 + kk); sl += x * dbg_f8(W, (size_t)rl * 1024 + kk); }
        sg *= (1.0 / 64.0); sl *= (1.0 / 64.0);
        const float rs = ((const float*)(ws + WS_SMALL + SM_RSTD3))[tok]; float gl = (float)sg * rs + a.in[I_BE1][e * 2048 + col], li = (float)sl * rs + a.in[I_BE1][e * 2048 + 1024 + col]; gl = fminf(gl, 7.f); li = fminf(fmaxf(li, -7.f), 7.f);
        chk_report(ws, 11, dbg_f8(ws + WS_ACT, (size_t)row * DFF + col), gl * dbg_sigm(1.702f * gl) * (li + 1.0f), 0.5f);
    } else if (phase == 12) {
        const int tok = r0 % T, k = r1 % 4, col = r2 % DM; const int row = ((const int*)(ws + WS_SMALL + SM_AROW))[tok * 4 + k], e = ((const int*)(ws + WS_SMALL + SM_TOPE))[tok * 4 + k];
        const unsigned char* ar = ws + WS_ACT + (size_t)row * DFF; const unsigned char* W = ws + WS_WE2 + (size_t)e * 1024 * 1024; double s = 0; for (int kk = 0; kk < DFF; ++kk) s += (double)dbg_f8(ar, kk) * dbg_f8(W, (size_t)col * 1024 + kk);
        s *= (1.0 / 64.0);
        chk_report(ws, 12, dbg_bf((const bf16*)(ws + WS_YROWS), (size_t)row * DM + col), ((float)s + a.in[I_BE2][e * 1024 + col]) * ((const float*)(ws + WS_SMALL + SM_GATE))[tok * 4 + k], 0.1f);
    }
}
__global__ void dbg_rows_a(Args a) { const int i = blockIdx.x * 256 + threadIdx.x; if (i < T * 4) atomicAdd((int*)(a.ws + WS_E + 64 * MB) + ((const int*)(a.ws + WS_SMALL + SM_AROW))[i], 1); }
__global__ void dbg_rows_b(Args a) { const int i = blockIdx.x * 256 + threadIdx.x; if (i < PROWS) { const int c = ((const int*)(a.ws + WS_E + 64 * MB))[i]; if (c > 1) atomicMax((unsigned*)(a.ws + WS_CTL) + CW_CHK + 10, __float_as_uint(100.0f + c)); } }
__global__ void dbg_verdict(Args a) {
    const unsigned* chk = (const unsigned*)(a.ws + WS_CTL) + CW_CHK; int code = 0;
    for (int p = 0; p < NPHASE; ++p) if (code == 0 && __uint_as_float(chk[p]) > 0.08f) code = p + 1;
    if (code) { const float sc = 1.0f + (float)code; for (size_t i = (size_t)blockIdx.x * 256 + threadIdx.x; i < (size_t)T * DM; i += (size_t)gridDim.x * 256) a.out[i] *= sc; }
}
static void dbg_check(int p, const Args& a, hipStream_t stream) {
    if (p == 13) { hipLaunchKernelGGL(dbg_verdict, dim3(1024), dim3(256), 0, stream, a); return; }
    if (p == 10) { (void)hipMemsetAsync(a.ws + WS_E + 64 * MB, 0, (size_t)PROWS * 4, stream); hipLaunchKernelGGL(dbg_rows_a, dim3(T * 4 / 256), dim3(256), 0, stream, a); hipLaunchKernelGGL(dbg_rows_b, dim3(PROWS / 256), dim3(256), 0, stream, a); }
    hipLaunchKernelGGL(dbg_kernel, dim3(p == 3 ? 2 : 16), dim3(64), 0, stream, a, p);
}
#endif

extern "C" void kernel_launch(void* const* d_in, const int* in_sizes, int n_in, void* d_out, int out_size, void* d_ws, size_t ws_size, hipStream_t stream) {
    static int grid = 0;
    if (grid == 0) {
        if (n_in != 20 || in_sizes[0] != T * DM || out_size != T * DM || ws_size < WS_END) { fprintf(stderr, "kernel_launch: unexpected problem shape (n_in %d, in0 %d, out %d, ws %zu < %zu)\n", n_in, n_in > 0 ? in_sizes[0] : -1, out_size, ws_size, (size_t)WS_END); grid = -1; return; }
        int dev = 0, cus = 0;
        if (hipGetDevice(&dev) != hipSuccess || hipDeviceGetAttribute(&cus, hipDeviceAttributeMultiprocessorCount, dev) != hipSuccess) { grid = -1; return; }
        if (hipFuncSetAttribute((const void*)mega_fwd, hipFuncAttributeMaxDynamicSharedMemorySize, LDS_BYTES) != hipSuccess) { fprintf(stderr, "kernel_launch: hipFuncSetAttribute failed\n"); grid = -1; return; }
        grid = cus;
    }
    if (grid < 0) return;
    (void)hipMemsetAsync((char*)d_ws + WS_CTL, 0, CTL_BYTES, stream);
    Args a{};
    for (int i = 0; i < 20; ++i) a.in[i] = (const float*)d_in[i];
    a.out = (float*)d_out; a.ws = (unsigned char*)d_ws;
#if MK_DEBUG
    for (int p = 0; p < NPHASE; ++p) { a.ph_lo = p; a.ph_hi = p + 1; hipLaunchKernelGGL(mega_fwd, dim3(grid), dim3(NWAVES * 64), LDS_BYTES, stream, a); dbg_check(p, a, stream); }
#else
    a.ph_lo = 0; a.ph_hi = NPHASE;
    hipLaunchKernelGGL(mega_fwd, dim3(grid), dim3(NWAVES * 64), LDS_BYTES, stream, a);
#endif
}
```

```cpp
#include <hip/hip_runtime.h>
#include <cstdio>
#include <cstdint>

#ifndef MK_DEBUG
#define MK_DEBUG 0
#endif

#define LAS __attribute__((address_space(3)))
#define GAS __attribute__((address_space(1)))
typedef unsigned short bf16;
typedef short bf16x8 __attribute__((ext_vector_type(8)));
typedef short s16x4 __attribute__((ext_vector_type(4)));
typedef short v4i16_t __attribute__((ext_vector_type(4)));
typedef float f32x2 __attribute__((ext_vector_type(2)));
typedef float f32x4 __attribute__((ext_vector_type(4)));
typedef float f32x16 __attribute__((ext_vector_type(16)));
typedef unsigned u32x2 __attribute__((ext_vector_type(2)));
typedef unsigned u32x4 __attribute__((ext_vector_type(4)));
typedef __bf16 bf16x2_t __attribute__((ext_vector_type(2)));
typedef GAS unsigned gu32;
#define RLX_AGENT __ATOMIC_RELAXED, __HIP_MEMORY_SCOPE_AGENT
#define LDS_WAIT() asm volatile("s_waitcnt lgkmcnt(0)" ::: "memory")
#define VM_WAIT() asm volatile("s_waitcnt vmcnt(0)" ::: "memory")
#define DI __device__ __forceinline__

DI unsigned cvtpk(float lo, float hi) { f32x2 v = {lo, hi}; bf16x2_t b = __builtin_convertvector(v, bf16x2_t); return __builtin_bit_cast(unsigned, b); }
DI float bflo(unsigned w) { return __uint_as_float(w << 16); }
DI float bfhi(unsigned w) { return __uint_as_float(w & 0xffff0000u); }
DI float bf2f(bf16 u) { return __uint_as_float((unsigned)u << 16); }
DI float fexp2(float x) { return __builtin_amdgcn_exp2f(x); }
DI float flog2(float x) { return __builtin_amdgcn_logf(x); }
DI float frcp(float x) { return __builtin_amdgcn_rcpf(x); }
DI float sigmoidf_(float x) { return frcp(1.0f + fexp2(-1.4426950408889634f * x)); }
DI int crow(int r, int hi) { return (r & 3) + 8 * (r >> 2) + 4 * hi; }
DI s16x4 vtr(const LAS char* p) { return __builtin_bit_cast(s16x4, __builtin_amdgcn_ds_read_tr16_b64_v4i16((LAS v4i16_t*)p)); }
#define MFMA32(a, b, c) __builtin_amdgcn_mfma_f32_32x32x16_bf16((a), (b), (c), 0, 0, 0)

constexpr int BATCH = 8, SEQ = 2048, DM = 1024, T = BATCH * SEQ, NPROJ = 6656, MEML = 256;
constexpr int C_SBQ = 0, C_SBK = 512, C_SBV = 1024, C_RQ = 1536, C_RK = 2048, C_RV = 2560, C_RG = 3584, C_GSB = 4608, C_GRET = 5632;
__host__ __device__ __forceinline__ size_t proj_off(size_t row, int col) {
    if (col < C_RV) return ((size_t)(col >> 6) * T + row) * 64 + (col & 63);
    if (col < C_RG) { const int c = col - C_RV; return (size_t)C_RV * T + ((size_t)(c >> 7) * T + row) * 128 + (c & 127); }
    return (size_t)C_RG * T + row * 3072 + (col - C_RG);
}
constexpr int NEXP = 32, TOPK = 4, DFF = 1024;
constexpr int MAXBLK = 288, PROWS = MAXBLK * 256;
constexpr float NORM_EPS = 1e-5f;
constexpr float LOG2E = 1.4426950408889634f;
constexpr float SBQ_SCALE = 0.125f * LOG2E;
constexpr float XQ_SCALE = 0.0625f * LOG2E;
constexpr float SB_THR = 150.0f;

namespace pg8 {
constexpr int BM = 256, BK = 64, HALF = 128, HTB = HALF * BK * 2, STAGE_BYTES = 8 * HTB, NXCD = 8;
__host__ __device__ __forceinline__ int lds_byte(int r, int c) { const int st = (r >> 4) * 2 + (c >> 5), rr = r & 15, cc = c & 31, ob = rr * 64 + cc * 2; return st * 1024 + (ob ^ (((ob >> 9) & 1) << 5)); }
__host__ __device__ __forceinline__ void stage_rc(int b, int& R, int& C) { const int st = b / 1024, sb = b % 1024, swz = sb ^ (((sb >> 9) & 1) << 5); R = (st >> 1) * 16 + swz / 64; C = (st & 1) * 32 + (swz % 64) / 2; }
__host__ __device__ __forceinline__ int perm32(int rho) { const int n = rho >> 4, i = rho & 15; return 8 * (i >> 2) + 4 * n + (i & 3); }

typedef int v8i_t __attribute__((ext_vector_type(8)));
typedef int v4i_t __attribute__((ext_vector_type(4)));
DI v8i_t cat8(bf16x8 a, bf16x8 b) { const v4i_t x = __builtin_bit_cast(v4i_t, a), y = __builtin_bit_cast(v4i_t, b); return __builtin_shufflevector(x, y, 0, 1, 2, 3, 4, 5, 6, 7); }
DI bf16x8 lo8(v8i_t v) { return __builtin_bit_cast(bf16x8, (v4i_t)__builtin_shufflevector(v, v, 0, 1, 2, 3)); }
DI bf16x8 hi8(v8i_t v) { return __builtin_bit_cast(bf16x8, (v4i_t)__builtin_shufflevector(v, v, 4, 5, 6, 7)); }
constexpr int PG8_XTRA = 131072;
struct Unit { int pm, pn; const char* A; const char* B; int tag, e; };

DI void map_unit(int L, int nwg, int nM, int nN, int& pm, int& pn, const int WGM = 4) {
    int wgid = L; { const int q = nwg / NXCD, r = nwg % NXCD, xcd = wgid % NXCD, off = wgid / NXCD; wgid = (xcd < r ? xcd * (q + 1) : r * (q + 1) + (xcd - r) * q) + off; }
    const int nig = WGM * nN, gid = wgid / nig, fm = gid * WGM, gsz = (nM - fm) < WGM ? (nM - fm) : WGM;
    pm = fm + ((wgid % nig) % gsz); pn = (wgid % nig) / gsz;
}
struct Sched2 {
    DI void prep(LAS unsigned char*, int) const {}
    DI void poll(int, LAS unsigned char*, int) const {}
    DI void acquire(const Unit&, const LAS unsigned char*) const {}
    DI void signal(int, int, int, int) const {}
    DI void first(const Unit&) const {}
    const bf16* A0; const bf16* B0; int nM0, nN0; const bf16* A1; const bf16* B1; int nM1, nN1; int G, c, K; int wgm = 4;
    DI bool next(int i, Unit& u) const {
        const int n0 = nM0 * nN0, n1 = nM1 * nN1; const long L = (long)i * G + c; if (L >= n0 + n1) return false;
        const bool first = L < n0; int pm, pn; map_unit(first ? (int)L : (int)L - n0, first ? n0 : n1, first ? nM0 : nM1, first ? nN0 : nN1, pm, pn, wgm);
        u.pm = pm; u.pn = pn; u.tag = first ? 0 : 1; u.e = 0;
        u.A = (const char*)(first ? A0 : A1) + (size_t)pm * BM * K * 2; u.B = (const char*)(first ? B0 : B1) + (size_t)pn * BM * K * 2; return true;
    }
};
DI void bmap(int L, int nN, int wgm, int& pml, int& pn) { const int nig = wgm * nN, g = L / nig, l = L % nig; pml = g * wgm + l % wgm; pn = l / wgm; }
struct SchedB {
    DI void prep(LAS unsigned char*, int) const {}
    DI void poll(int, LAS unsigned char*, int) const {}
    DI void acquire(const Unit&, const LAS unsigned char*) const {}
    DI void signal(int, int, int, int) const {}
    DI void first(const Unit&) const {}
    const bf16* A0; const bf16* B0; int nN0; const bf16* A1; const bf16* B1; int nN1; int b, r, nr, K; int wgm;
    DI bool next(int i, Unit& u) const {
        const int n0 = 8 * nN0; const int L = i * nr + r; if (L >= n0 + nN1) return false;
        const bool first = L < n0; int pml, pn; bmap(first ? L : 0, nN0, wgm, pml, pn);
        const int pm = first ? 8 * b + pml : b; pn = first ? pn : L - n0;
        u.pm = pm; u.pn = pn; u.tag = first ? 0 : 1; u.e = 0;
        u.A = (const char*)(first ? A0 : A1) + (size_t)pm * BM * K * 2; u.B = (const char*)(first ? B0 : B1) + (size_t)pn * BM * K * 2; return true;
    }
};
struct SchedMoEx {
    const unsigned char* A; const unsigned char* W; size_t es; const int* blk_e; unsigned* done; int lo, nbx, r, nr, K, nN, wg, tag;
    mutable const LAS int* etab = nullptr;
    DI void unit_of(int L, int& pm, int& pn) const {
        const int fm = (L >> 5) * wg, gsz = (nbx - fm) < wg ? (nbx - fm) : wg, q = L & 31;
        const int mg = gsz == 1 ? 256 : gsz == 2 ? 128 : gsz == 3 ? 86 : gsz == 4 ? 64 : gsz == 5 ? 52 : gsz == 6 ? 43 : gsz == 7 ? 37 : 32;
        pn = (q * mg) >> 8; pm = fm + q - pn * gsz;
    }
    DI void prep(LAS unsigned char* xt, int tid) const {
        LAS int* tab = (LAS int*)xt;
        if (tid < 32) { const int L = tid * nr + r; int pm = 0, pn = 0, e = 0; const int ok = L < nbx * nN;
            if (ok) { unit_of(L, pm, pn); e = __hip_atomic_load(blk_e + lo + pm, RLX_AGENT); }
            const unsigned long long pa = (unsigned long long)((const char*)A + (size_t)(lo + pm) * BM * K), pb = (unsigned long long)((const char*)W + ((size_t)e * es + (size_t)pn * BM * K));
            *(LAS u32x4*)(tab + 8 * tid) = (u32x4){(unsigned)(lo + pm), (unsigned)pn, (unsigned)e, (unsigned)ok};
            *(LAS u32x4*)(tab + 8 * tid + 4) = (u32x4){(unsigned)pa, (unsigned)(pa >> 32), (unsigned)pb, (unsigned)(pb >> 32)}; }
        __syncthreads();
        etab = tab;
    }
    DI bool next(int i, Unit& u) const {
        if (i >= 32) return false;
        const u32x4 h = *(const LAS u32x4*)(etab + 8 * i), q = *(const LAS u32x4*)(etab + 8 * i + 4);
        if (__builtin_amdgcn_readfirstlane((int)h[3]) == 0) return false;
        u.pm = __builtin_amdgcn_readfirstlane((int)h[0]); u.pn = __builtin_amdgcn_readfirstlane((int)h[1]); u.e = __builtin_amdgcn_readfirstlane((int)h[2]); u.tag = tag;
        const unsigned a0 = (unsigned)__builtin_amdgcn_readfirstlane((int)q[0]), a1 = (unsigned)__builtin_amdgcn_readfirstlane((int)q[1]), b0 = (unsigned)__builtin_amdgcn_readfirstlane((int)q[2]), b1 = (unsigned)__builtin_amdgcn_readfirstlane((int)q[3]);
        u.A = (const char*)(((unsigned long long)a1 << 32) | a0); u.B = (const char*)(((unsigned long long)b1 << 32) | b0); return true;
    }
    DI void poll(int i, LAS unsigned char* mb, int wid) const {
        if (done != nullptr && tag == 1 && wid == 0 && i < 32) { const u32x4 h = *(const LAS u32x4*)(etab + 8 * i);
            if (__builtin_amdgcn_readfirstlane((int)h[3]) != 0) __builtin_amdgcn_global_load_lds((const unsigned*)(done + __builtin_amdgcn_readfirstlane((int)h[0])), (LAS unsigned*)mb, 4, 0, 17  ); }
    }
    DI void spin(int pm) const { unsigned sp = 0, v; do { __builtin_amdgcn_s_sleep(2); v = __builtin_amdgcn_readfirstlane(__hip_atomic_load(done + pm, RLX_AGENT)); } while (v < 8u && ++sp < (1u << 22)); __builtin_amdgcn_fence(__ATOMIC_ACQUIRE, "agent"); }
    DI void acquire(const Unit& n, const LAS unsigned char* mb) const {
        if (done != nullptr && tag == 1) { const unsigned v = __builtin_amdgcn_readfirstlane(*(const LAS unsigned*)mb); if (v < 8u) spin(n.pm); }
    }
    DI void first(const Unit& u) const { if (done != nullptr && tag == 1) { const unsigned v = __builtin_amdgcn_readfirstlane(__hip_atomic_load(done + u.pm, RLX_AGENT)); if (v < 8u) spin(u.pm); } }
    DI void signal(int pm, int tg, int wid, int lane) const { if (done != nullptr && tag == 0 && wid == 0 && lane == 0) (void)__hip_atomic_fetch_add(done + pm, 1u, RLX_AGENT); }
};

template <class Epi, class Sched>
DI void gemm_phase(LAS unsigned char* lds, const int K, const Sched& S, const Epi& E) {
    const int tid = threadIdx.x, wid = __builtin_amdgcn_readfirstlane(tid >> 6), lane = tid & 63, wr = wid >> 2, wc = wid & 3, fr = lane & 15, fq = lane >> 4;
    constexpr int ESZ = Epi::FP8 ? 1 : 2;
    int nt = K * ESZ / 128; asm volatile("" : "+s"(nt));
    unsigned voffA[2], voffB[2];
#pragma unroll
    for (int i = 0; i < 2; ++i) { int R, C; stage_rc(tid * 16 + i * 8192, R, C); const int Rb = Epi::CM2 ? (64 * (R >> 5) + perm32(R & 31)) : (Epi::PERM ? ((R & ~31) + perm32(R & 31)) : R);
        voffA[i] = (unsigned)(R * K * ESZ + 2 * C); voffB[i] = (unsigned)(Rb * K * ESZ + 2 * C); }
    const size_t kstep = (size_t)(BK * 2);
    const size_t hstep = (size_t)HALF * K * ESZ;
    const size_t hstepB = (size_t)(Epi::CM2 ? 32 : HALF) * K * ESZ;
    const unsigned ldsw = (unsigned)wid * 1024u;
    const int aoff = lds_byte(wr * 64 + fr, fq * 8), boff = lds_byte(wc * 32 + fr, fq * 8);
#define PG8_SA(b, h) (((b) * 2 + (h)) * HTB)
#define PG8_SB(b, h) ((4 + (b) * 2 + (h)) * HTB)
#define PG8_STAGE(bufoff, gbase, voff) do { _Pragma("unroll") for (int _i = 0; _i < 2; ++_i) \
        __builtin_amdgcn_global_load_lds((const unsigned*)((const char*)(gbase) + (voff)[_i]), (LAS unsigned*)(lds + (bufoff) + ldsw + _i * 8192), 16, 0, 0); } while (0)
#define PG8_LDA(dst, b, h) do { _Pragma("unroll") for (int m = 0; m < 4; ++m) dst[m] = cat8(*(const LAS bf16x8*)(lds + PG8_SA(b, h) + aoff + m * 2048), *(const LAS bf16x8*)(lds + PG8_SA(b, h) + aoff + m * 2048 + 1024)); } while (0)
#define PG8_LDB(dst, b, h) do { _Pragma("unroll") for (int n = 0; n < 2; ++n) dst[n] = cat8(*(const LAS bf16x8*)(lds + PG8_SB(b, h) + boff + n * 2048), *(const LAS bf16x8*)(lds + PG8_SB(b, h) + boff + n * 2048 + 1024)); } while (0)
#define PG8_MMA(ai, bj, At, Bt) do { __builtin_amdgcn_s_setprio(1); _Pragma("unroll") for (int m = 0; m < 4; ++m) _Pragma("unroll") for (int n = 0; n < 2; ++n) { \
        if constexpr (Epi::FP8) { asm volatile("v_mfma_scale_f32_16x16x128_f8f6f4 %0, %1, %2, %0, %3, %4 op_sel_hi:[0,0,0]" : "+v"(acc[ai][bj][m][n]) : "v"(Bt[n]), "v"(At[m]), "v"(sc_w), "v"(sc_a)); } \
        else { acc[ai][bj][m][n] = __builtin_amdgcn_mfma_f32_16x16x32_bf16(lo8(Bt[n]), lo8(At[m]), acc[ai][bj][m][n], 0, 0, 0); acc[ai][bj][m][n] = __builtin_amdgcn_mfma_f32_16x16x32_bf16(hi8(Bt[n]), hi8(At[m]), acc[ai][bj][m][n], 0, 0, 0); } } \
        __builtin_amdgcn_s_setprio(0); } while (0)
#define PG8_WAIT_V(n) asm volatile("s_waitcnt vmcnt(" #n ")" ::: "memory")
#define PG8_WAIT_L(n) asm volatile("s_waitcnt lgkmcnt(" #n ")" ::: "memory")
#define PG8_BAR __builtin_amdgcn_s_barrier()
#define PG8_SCHED __builtin_amdgcn_sched_barrier(0)
    S.prep(lds + PG8_XTRA + 4096, tid);
    Unit cur, nxt; int ui = 0, prv_pm = 0, prv_tag = 1;
    if (S.next(0, cur)) {
    f32x4 acc[2][2][4][2];
#pragma unroll
    for (int a = 0; a < 2; ++a)
#pragma unroll
        for (int b = 0; b < 2; ++b)
#pragma unroll
            for (int m = 0; m < 4; ++m)
#pragma unroll
                for (int n = 0; n < 2; ++n) acc[a][b][m][n] = (f32x4){0.f, 0.f, 0.f, 0.f};
    v8i_t At[4], B0[2], B1[2];
    int sc_w = 0, sc_a = 0; if constexpr (Epi::FP8) { sc_w = Epi::SCALE_W; sc_a = Epi::SCALE_A; asm volatile("" : "+v"(sc_w), "+v"(sc_a)); }
    (void)sc_w; (void)sc_a;
    S.first(cur);
    S.poll(1, lds + PG8_XTRA + 5120 + 256, wid);
    const char* cA = cur.A; const char* cB = cur.B;
    PG8_STAGE(PG8_SB(0, 0), cB, voffB); PG8_STAGE(PG8_SB(0, 1), cB + hstepB, voffB); PG8_STAGE(PG8_SA(0, 0), cA, voffA); PG8_STAGE(PG8_SA(0, 1), cA + hstep, voffA);
    if (wr == 1) PG8_BAR;
    PG8_WAIT_V(2); PG8_BAR;
    PG8_STAGE(PG8_SB(1, 0), cB + kstep, voffB); PG8_STAGE(PG8_SA(1, 0), cA + kstep, voffA); PG8_STAGE(PG8_SB(1, 1), cB + hstepB + kstep, voffB);
    PG8_WAIT_V(6); PG8_BAR;
    for (;;) {
        const bool has_next = S.next(ui + 1, nxt);
        E.pre(cur, lds + PG8_XTRA + (ui & 1) * 2048, wid, lane);
        const char* nA = has_next ? nxt.A : cA; const char* nB = has_next ? nxt.B : cB;
#pragma nounroll
        for (int t = 0; t < nt; t += 2) {
            const bool last = (t == nt - 2);
            if (last && has_next) S.acquire(nxt, lds + PG8_XTRA + 5120 + ((ui + 1) & 1) * 256);
            const char* a1 = cA + (size_t)(t + 1) * kstep;
            const char* a2 = last ? nA : cA + (size_t)(t + 2) * kstep; const char* b2 = last ? nB : cB + (size_t)(t + 2) * kstep;
            const char* a3 = a2 + kstep; const char* b3 = b2 + kstep;
            PG8_LDB(B0, 0, 0); PG8_LDB(B1, 0, 1); PG8_SCHED; PG8_LDA(At, 0, 0); PG8_STAGE(PG8_SA(1, 1), a1 + hstep, voffA);
            PG8_WAIT_V(8); PG8_WAIT_L(0); PG8_BAR; PG8_MMA(0, 0, At, B0); PG8_MMA(0, 1, At, B1); PG8_BAR; PG8_SCHED;
            PG8_LDA(At, 0, 1); PG8_STAGE(PG8_SB(0, 0), b2, voffB); PG8_STAGE(PG8_SB(0, 1), b2 + hstepB, voffB); PG8_STAGE(PG8_SA(0, 0), a2, voffA);
            PG8_WAIT_V(8); PG8_WAIT_L(0); PG8_BAR; PG8_MMA(1, 0, At, B0); PG8_MMA(1, 1, At, B1); PG8_BAR; PG8_SCHED;
            PG8_LDB(B0, 1, 0); PG8_LDB(B1, 1, 1); PG8_SCHED; PG8_LDA(At, 1, 0); PG8_STAGE(PG8_SA(0, 1), a2 + hstep, voffA);
            PG8_WAIT_V(8); PG8_WAIT_L(0); PG8_BAR; PG8_MMA(0, 0, At, B0); PG8_MMA(0, 1, At, B1); PG8_BAR; PG8_SCHED;
            PG8_LDA(At, 1, 1); PG8_STAGE(PG8_SB(1, 0), b3, voffB); PG8_STAGE(PG8_SB(1, 1), b3 + hstepB, voffB); PG8_STAGE(PG8_SA(1, 0), a3, voffA);
            PG8_WAIT_V(8); PG8_WAIT_L(0); PG8_BAR; PG8_MMA(1, 0, At, B0); PG8_MMA(1, 1, At, B1); PG8_BAR; PG8_SCHED;
        }
        if (wr == 0) PG8_BAR;
        S.poll(ui + 2, lds + PG8_XTRA + 5120 + (ui & 1) * 256, wid);
        if (ui > 0) S.signal(prv_pm, prv_tag, wid, lane);
        if constexpr (Epi::FP8) { asm volatile("s_nop 15\n\ts_nop 3" ::: "memory"); _Pragma("unroll") for (int i_ = 0; i_ < 32; ++i_) asm volatile("" : "+v"(((f32x4*)acc)[i_])); }
        E(acc, cur, wr, wc, fr, fq, lds + PG8_XTRA + (ui & 1) * 2048);
        if (!has_next) break;
#pragma unroll
        for (int a = 0; a < 2; ++a)
#pragma unroll
            for (int b = 0; b < 2; ++b)
#pragma unroll
                for (int m = 0; m < 4; ++m)
#pragma unroll
                    for (int n = 0; n < 2; ++n) acc[a][b][m][n] = (f32x4){0.f, 0.f, 0.f, 0.f};
        prv_pm = cur.pm; prv_tag = cur.tag; cur = nxt; cA = nA; cB = nB; ++ui;
        if (wr == 1) PG8_BAR;
    }
    PG8_WAIT_V(0);
    PG8_BAR;
    S.signal(cur.pm, cur.tag, wid, lane);
    }
    __syncthreads();
#undef PG8_SA
#undef PG8_SB
#undef PG8_STAGE
#undef PG8_LDA
#undef PG8_LDB
#undef PG8_MMA
#undef PG8_WAIT_V
#undef PG8_WAIT_L
#undef PG8_BAR
#undef PG8_SCHED
}
}

#define XB_TMO      128
#define XB_XCNT(j)  (256  + 64 * (j))
#define XB_XSUB(j)  (1280 + 64 * (j))
#define XB_XGEN(j)  (2304 + 64 * (j))
#define XB_TOP      3328
#define XB_TOPGEN   3392
#define XB_LSUB(j)  (3456 + 64 * (j))
#define XB_LGEN(j)  (4480 + 64 * (j))
#define XB_GRP(j, g) (5504 + 64 * ((j) * 8 + (g)))
#define XCD_BAR_WORDS 13696
#define XB_SPIN_CAP (1u << 18)
DI unsigned xb_ld(unsigned* p)              { return __hip_atomic_load(p, __ATOMIC_RELAXED, __HIP_MEMORY_SCOPE_AGENT); }
DI unsigned xb_add(unsigned* p, unsigned v) { return __hip_atomic_fetch_add(p, v, __ATOMIC_RELAXED, __HIP_MEMORY_SCOPE_AGENT); }
DI unsigned xb_xcc_id() { return (unsigned)__builtin_amdgcn_s_getreg((3 << 11) | 20) & 0xFu; }
#define XB_SPIN(cond, bar) do { unsigned _sp = 0; while (cond) { __builtin_amdgcn_s_sleep(1); \
    if ((++_sp & 255u) == 0u) { if (xb_ld(&(bar)[XB_TMO])) break; if (_sp > XB_SPIN_CAP) { atomicAdd(&(bar)[XB_TMO], 1u); break; } } } } while (0)
#ifndef XB_NO_EARLY_INV
#define XB_INV_EARLY() asm volatile("buffer_inv sc1" ::: "memory")
#define XB_INV_LATE()  __atomic_signal_fence(__ATOMIC_SEQ_CST)
#else
#define XB_INV_EARLY() do {} while (0)
#define XB_INV_LATE()  __builtin_amdgcn_fence(__ATOMIC_ACQUIRE, "agent")
#endif
struct XcdBarrier { unsigned* bar; unsigned x; volatile LAS unsigned* st; };
DI XcdBarrier xcd_barrier_post(unsigned* bar, volatile LAS unsigned* st) {
    XcdBarrier b; b.bar = bar; b.x = xb_xcc_id(); b.st = st;
    if (threadIdx.x == 0) st[3] = xb_add(&bar[XB_XCNT(b.x)], 1u);
    return b;
}
DI void xcd_barrier_complete(unsigned* bar, unsigned x, unsigned& nloc, unsigned& nx, unsigned& eight) {
    const unsigned G = gridDim.x * gridDim.y * gridDim.z;
    unsigned sum, cnt, mine, low, sp = 0u;
    for (;;) {
        sum = 0u; cnt = 0u; mine = 0u; low = 0u;
#pragma unroll
        for (unsigned j = 0; j < 16; ++j) { const unsigned c = xb_ld(&bar[XB_XCNT(j)]); sum += c; cnt += (c > 0u) ? 1u : 0u; low += (c > 0u && j < 8u) ? 1u : 0u; mine = (j == x) ? c : mine; }
        if (sum == G) break;
        __builtin_amdgcn_s_sleep(1);
        if ((++sp & 255u) == 0u) { if (xb_ld(&bar[XB_TMO])) break; if (sp > XB_SPIN_CAP) { atomicAdd(&bar[XB_TMO], 1u); break; } }
    }
    nloc = mine > 0u ? mine : 1u; nx = cnt > 0u ? cnt : 1u; eight = (sum == G && cnt == 8u && low == 8u && mine * 8u == G) ? 1u : 0u;
}
DI void xcd_barrier(const XcdBarrier& b) {
    asm volatile("s_waitcnt vmcnt(0)" ::: "memory");
    __syncthreads();
    if (threadIdx.x == 0) {
        unsigned* bar = b.bar;
        __builtin_amdgcn_s_waitcnt(0);
        unsigned nloc = b.st[0], nx = b.st[1];
        if (nloc == 0u) { unsigned eight; xcd_barrier_complete(bar, b.x, nloc, nx, eight); b.st[0] = nloc; b.st[1] = nx; b.st[2] = eight; }
        const unsigned old = xb_add(&bar[XB_XSUB(b.x)], 1u);
        const unsigned gen = old / nloc;
        if (old + 1u == (gen + 1u) * nloc) {
            __builtin_amdgcn_fence(__ATOMIC_RELEASE, "agent");
            asm volatile("s_waitcnt vmcnt(0)" ::: "memory");
            const unsigned og = xb_add(&bar[XB_TOP], 1u);
            const unsigned tg = og / nx;
            XB_INV_EARLY();
            if (og + 1u == (tg + 1u) * nx) xb_add(&bar[XB_TOPGEN], 1u);
            else XB_SPIN(xb_ld(&bar[XB_TOPGEN]) == tg, bar);
            XB_INV_LATE();
            xb_add(&bar[XB_XGEN(b.x)], 1u);
            asm volatile("s_waitcnt vmcnt(0)" ::: "memory");
        } else {
            XB_INV_EARLY();
            XB_SPIN(xb_ld(&bar[XB_XGEN(b.x)]) == gen, bar);
            XB_INV_LATE();
            asm volatile("s_waitcnt vmcnt(0)" ::: "memory");
        }
    }
    __syncthreads();
}

DI void xcd_local_barrier(const XcdBarrier& b) {
    asm volatile("s_waitcnt vmcnt(0)" ::: "memory");
    __syncthreads();
    if (threadIdx.x == 0) {
        unsigned* bar = b.bar;
        __builtin_amdgcn_s_waitcnt(0);
        const unsigned nloc = b.st[0];
        const unsigned old = xb_add(&bar[XB_LSUB(b.x)], 1u);
        const unsigned gen = old / nloc;
        XB_INV_EARLY();
        if (old + 1u == (gen + 1u) * nloc) xb_add(&bar[XB_LGEN(b.x)], 1u);
        else XB_SPIN(xb_ld(&bar[XB_LGEN(b.x)]) == gen, bar);
        XB_INV_LATE();
        asm volatile("s_waitcnt vmcnt(0)" ::: "memory");
    }
    __syncthreads();
}

DI void xcd_group_barrier(const XcdBarrier& b, int grp, unsigned ng) {
    asm volatile("s_waitcnt vmcnt(0)" ::: "memory");
    __syncthreads();
    if (threadIdx.x == 0) {
        unsigned* cnt = &b.bar[XB_GRP(b.x, grp)];
        __builtin_amdgcn_s_waitcnt(0);
        const unsigned old = xb_add(cnt, 1u);
        const unsigned target = (old / ng + 1u) * ng;
        XB_INV_EARLY();
        XB_SPIN(xb_ld(cnt) < target, b.bar);
        XB_INV_LATE();
        asm volatile("s_waitcnt vmcnt(0)" ::: "memory");
    }
    __syncthreads();
}

constexpr size_t MB = 1024 * 1024;
constexpr size_t WS_CTL    = 0;
constexpr size_t CTL_BYTES = 256 * 1024;
constexpr int    CW_BAR = 4096;
constexpr int    CW_DONE = 24576;
constexpr int    CW_CHK = 32768;
constexpr size_t WS_ROPE   = WS_CTL + CTL_BYTES;
constexpr size_t WS_WIN    = WS_ROPE + 512 * 1024;
constexpr size_t WS_WSBO   = WS_WIN + (size_t)NPROJ * DM * 2;
constexpr size_t WS_WRETO  = WS_WSBO + 1 * MB;
constexpr size_t WS_WMIX   = WS_WRETO + 2 * MB;
constexpr size_t WS_WCQ    = WS_WMIX + 2 * MB;
constexpr size_t WS_WCKV   = WS_WCQ + 2 * MB;
constexpr size_t WS_WCO    = WS_WCKV + 4 * MB;
constexpr size_t WS_WE1    = WS_WCO + 2 * MB;
constexpr size_t WS_WE2    = WS_WE1 + 128 * MB;
constexpr size_t WS_SMALL  = WS_WE2 + 64 * MB;
constexpr size_t WS_MEMN   = WS_SMALL + 4 * MB;
constexpr size_t WS_KVMEM  = WS_MEMN + 4 * MB;
constexpr size_t WS_GTOT   = WS_KVMEM + 8 * MB;
constexpr size_t WS_SLOTS  = WS_GTOT + 8 * MB;
constexpr size_t WS_A      = WS_SLOTS + 1 * MB;
constexpr size_t WS_B      = WS_A + 208 * MB;
constexpr size_t WS_C      = WS_B + 32 * MB;
constexpr size_t WS_D      = WS_C + 64 * MB;
constexpr size_t WS_E      = WS_D + 144 * MB;
constexpr size_t WS_END    = WS_E + 144 * MB;
static_assert((size_t)T * NPROJ * 2 <= 208 * MB && (size_t)PROWS * 1024 * 2 <= 144 * MB, "arena sizes");
constexpr size_t WS_PROJ = WS_A, WS_XG = WS_A, WS_XN1 = WS_B, WS_YRET = WS_B, WS_XN3U = WS_B, WS_TMP = WS_C, WS_X2 = WS_C;
constexpr size_t WS_YSB = WS_D, WS_MERGED = WS_D + 16 * MB, WS_XN2U = WS_D + 48 * MB  , WS_QX = WS_D + 80 * MB, WS_OX = WS_D + 112 * MB, WS_ACT = WS_D;
constexpr size_t WS_X1 = WS_E, WS_YROWS = WS_E;
constexpr size_t SM_TOPE = 0;
constexpr size_t SM_GATE = SM_TOPE + T * 16;
constexpr size_t SM_LRANK = SM_GATE + T * 16;
constexpr size_t SM_AROW = SM_LRANK + T * 16;
constexpr size_t SM_RSTD3 = SM_AROW + T * 16;
constexpr size_t SM_CNT = SM_RSTD3 + T * 4;
constexpr size_t SM_RSCALE = SM_CNT + 256 * 32 * 4;
constexpr size_t SM_RGATE = SM_RSCALE + PROWS * 4;
constexpr size_t SM_BLKE = SM_RGATE + PROWS * 4;
constexpr size_t SM_END = SM_BLKE + 4096;
static_assert(SM_END <= 4 * MB, "small tables");

constexpr int RING_OFF = 0, RING_BYTES = 131072;
constexpr int XTRA_OFF = RING_BYTES, XTRA_BYTES = 12288;
static_assert(pg8::PG8_XTRA == XTRA_OFF - RING_OFF, "pg8 scratch offset");
constexpr int LDSCTL_OFF = XTRA_OFF + XTRA_BYTES;
constexpr int LDS_BYTES = 147456;
static_assert(LDSCTL_OFF + 256 <= LDS_BYTES, "LDS map");
constexpr int NWAVES = 8;

struct Args { const float* in[20]; float* out; unsigned char* ws; int ph_lo, ph_hi; };

typedef const __attribute__((address_space(4))) unsigned char* kptr_t;
struct Frame {
    LAS unsigned char* lds;
    unsigned char* ws;
    int tid, lane, wave, G, bid;
    kptr_t kp;
    float* out;
};
DI const float* inp(const Frame& F, int i) { return (const float*)(GAS const float*)*(const float* const __attribute__((address_space(4)))*)(F.kp + 8 * i); }
enum { I_X = 0, I_MEM, I_GMIX, I_WIN, I_WSBO, I_WRETO, I_WMIX, I_GXATTN, I_GMEM, I_WCQ, I_WCKV, I_WCO, I_GMOE, I_WROUTER, I_BROUTER, I_WE1, I_BE1, I_WE2, I_BE2, I_GFINAL };

DI float wave_sum(float v) {
#pragma unroll
    for (int o = 1; o < 64; o <<= 1) v += __shfl_xor(v, o);
    return v;
}

#ifndef P0_NO_NT
#define P0_LD(p) __builtin_nontemporal_load(p)
#else
#define P0_LD(p) (*(p))
#endif
DI void p0_tr_item(const float* W, int N, int K, bf16* dst, LAS float* scr, int k0, int n0, int lane, const float* rowscale = nullptr) {
    float wv[32], rv[32];
#pragma unroll
    for (int i = 0; i < 32; ++i) { const int kk = 2 * i + (lane >> 5); wv[i] = P0_LD(W + (size_t)(k0 + kk) * N + n0 + (lane & 31)); rv[i] = rowscale ? rowscale[k0 + kk] : 1.0f; }
#pragma unroll
    for (int i = 0; i < 32; ++i) { const int kk = 2 * i + (lane >> 5); scr[kk * 33 + (lane & 31)] = wv[i] * rv[i]; }
    LDS_WAIT(); asm volatile("" ::: "memory");
    const int c = lane & 7;
#pragma unroll
    for (int j = 0; j < 4; ++j) { const int n = (lane >> 3) + 8 * j; const LAS float* s = scr + (8 * c) * 33 + n;
        u32x4 o; o.x = cvtpk(s[0 * 33], s[1 * 33]); o.y = cvtpk(s[2 * 33], s[3 * 33]); o.z = cvtpk(s[4 * 33], s[5 * 33]); o.w = cvtpk(s[6 * 33], s[7 * 33]);
        *(u32x4*)(dst + (size_t)n * K + k0 + 8 * c) = o; }
    LDS_WAIT(); asm volatile("" ::: "memory");
}
DI unsigned cvt4_fp8(float a, float b, float c, float d) { int w = __builtin_amdgcn_cvt_pk_fp8_f32(a, b, 0, false); w = __builtin_amdgcn_cvt_pk_fp8_f32(c, d, w, true); return (unsigned)w; }
DI void p0_tr_item_fp8(const float* W, int N, int K, unsigned char* dst, LAS float* scr, int k0, int n0, int lane) {
#pragma unroll 8
    for (int i = 0; i < 32; ++i) { const int kk = 2 * i + (lane >> 5); scr[kk * 33 + (lane & 31)] = W[(size_t)(k0 + kk) * N + n0 + (lane & 31)] * 64.0f; }
    LDS_WAIT(); asm volatile("" ::: "memory");
    const int c = lane & 7;
#pragma unroll
    for (int j = 0; j < 4; ++j) { const int n = (lane >> 3) + 8 * j; const LAS float* s = scr + (8 * c) * 33 + n;
        u32x2 o; o.x = cvt4_fp8(s[0 * 33], s[1 * 33], s[2 * 33], s[3 * 33]); o.y = cvt4_fp8(s[4 * 33], s[5 * 33], s[6 * 33], s[7 * 33]);
        *(u32x2*)(dst + (size_t)n * K + k0 + 8 * c) = o; }
    LDS_WAIT(); asm volatile("" ::: "memory");
}
DI void rms_row_to_bf16(const float* xrow, const float* g, bf16* orow, int lane) {
    const f32x4* xr = (const f32x4*)xrow + lane; const f32x4* gr = (const f32x4*)g + lane;
    f32x4 v[4]; float s = 0.f;
#pragma unroll
    for (int j = 0; j < 4; ++j) { v[j] = P0_LD(xr + 64 * j); s += (v[j].x * v[j].x + v[j].y * v[j].y) + (v[j].z * v[j].z + v[j].w * v[j].w); }
    const float rstd = 1.0f / sqrtf(wave_sum(s) * (1.f / DM) + NORM_EPS);
    u32x2* o8 = (u32x2*)orow + lane;
#pragma unroll
    for (int j = 0; j < 4; ++j) { const f32x4 gg = gr[64 * j]; u32x2 w; w.x = cvtpk(v[j].x * rstd * gg.x, v[j].y * rstd * gg.y); w.y = cvtpk(v[j].z * rstd * gg.z, v[j].w * rstd * gg.w); o8[64 * j] = w; }
}
DI void rms_regs_to_bf16(const f32x4 (&v)[4], const float* g, bf16* orow, int lane) {
    const f32x4* gr = (const f32x4*)g + lane; float s = 0.f;
#pragma unroll
    for (int j = 0; j < 4; ++j) s += (v[j].x * v[j].x + v[j].y * v[j].y) + (v[j].z * v[j].z + v[j].w * v[j].w);
    const float rstd = 1.0f / sqrtf(wave_sum(s) * (1.f / DM) + NORM_EPS);
    u32x2* o8 = (u32x2*)orow + lane;
#pragma unroll
    for (int j = 0; j < 4; ++j) { const f32x4 gg = gr[64 * j]; u32x2 w; w.x = cvtpk(v[j].x * rstd * gg.x, v[j].y * rstd * gg.y); w.y = cvtpk(v[j].z * rstd * gg.z, v[j].w * rstd * gg.w); o8[64 * j] = w; }
}
#ifndef CONV_NO_NT
#define CONV_LD(p) __builtin_nontemporal_load(p)
#define CONV_ST(p, v) __builtin_nontemporal_store((v), (p))
#else
#define CONV_LD(p) (*(p))
#define CONV_ST(p, v) (*(p) = (v))
#endif
#ifndef CONV_DEPTH
#define CONV_DEPTH 2
#endif
constexpr int P0_IE1 = 32 * 8 * 64, P0_IE2 = 32 * 8 * 32;
DI void p0_experts(Frame& F, int vg  , int nvg, int lightidx  , int jlo = 0, int jhi = 1 << 20  ) {
    LAS float* scr = (LAS float*)(F.lds + RING_OFF + F.wave * 16896);
    constexpr int P0_BASE = 2048 * 11; const bool light = (F.G == 256) && (lightidx >= 0); const int nlv = 64 * NWAVES, lv = lightidx * NWAVES + F.wave;
    const int n_mine = (F.G == 256) ? 11 + (light ? 4 : 0) : (P0_IE1 + P0_IE2 + nvg - 1) / nvg;
    const int jend = n_mine < jhi ? n_mine : jhi;
    struct Item { const float* W; unsigned char* dst; int N, k0, n0; };
    auto decode = [&](int j, Item& t) -> bool {
        if (j >= jend) return false;
        int it; if (F.G != 256) { it = vg + j * nvg; if (it >= P0_IE1 + P0_IE2) return false; } else if (j < 11) it = vg + j * nvg; else it = P0_BASE + lv + (j - 11) * nlv;
        int r = it;
        if (r < P0_IE1) { const int e = r / 512, q = r % 512, kb = q / 64, nb = q % 64, n0 = 32 * nb;
            const int drow = n0 < 1024 ? 256 * (n0 >> 7) + (n0 & 127) : 256 * ((n0 - 1024) >> 7) + 128 + ((n0 - 1024) & 127);
            t.W = inp(F, I_WE1) + (size_t)e * 1024 * 2048; t.N = 2048; t.dst = F.ws + WS_WE1 + ((size_t)e * 2048 + drow) * 1024; t.k0 = 128 * kb; t.n0 = n0; return true; }
        r -= P0_IE1;
        { const int e = r / 256, q = r % 256, kb = q / 32, nb = q % 32;
            t.W = inp(F, I_WE2) + (size_t)e * 1024 * 1024; t.N = 1024; t.dst = F.ws + WS_WE2 + ((size_t)e * 1024 + 32 * nb) * 1024; t.k0 = 128 * kb; t.n0 = 32 * nb; return true; }
    };
    const int lane = F.lane;
#define TR_LOAD(v, t) do { const float* wp_ = (t).W + (size_t)((t).k0 + (lane >> 3)) * (t).N + (t).n0 + 4 * (lane & 7); _Pragma("unroll") for (int i = 0; i < 16; ++i) v[i] = CONV_LD((const f32x4*)(wp_ + (size_t)(8 * i) * (t).N)); } while (0)
#define TR_STORE(v, t) do { _Pragma("unroll") for (int i = 0; i < 16; ++i) { LAS float* sp_ = scr + (8 * i + (lane >> 3)) * 33 + 4 * (lane & 7); sp_[0] = v[i][0] * 64.0f; sp_[1] = v[i][1] * 64.0f; sp_[2] = v[i][2] * 64.0f; sp_[3] = v[i][3] * 64.0f; } \
        LDS_WAIT(); asm volatile("" ::: "memory"); \
        { const int c = lane >> 2; _Pragma("unroll") for (int jj = 0; jj < 8; ++jj) { const int n = (lane & 3) + 4 * jj; const LAS float* s = scr + (8 * c) * 33 + n; \
            u32x2 o; o.x = cvt4_fp8(s[0 * 33], s[1 * 33], s[2 * 33], s[3 * 33]); o.y = cvt4_fp8(s[4 * 33], s[5 * 33], s[6 * 33], s[7 * 33]); \
            CONV_ST((u32x2*)((t).dst + (size_t)n * 1024 + (t).k0 + 8 * c), o); } }     \
        LDS_WAIT(); asm volatile("" ::: "memory"); } while (0)
    f32x4 v[CONV_DEPTH][16]; Item t[CONV_DEPTH]; bool h[CONV_DEPTH];
    int j0 = jlo;
#pragma unroll
    for (int q = 0; q < CONV_DEPTH; ++q) { h[q] = decode(j0 + q, t[q]); if (h[q]) TR_LOAD(v[q], t[q]); }
    while (h[0]) {
#pragma unroll
        for (int q = 0; q < CONV_DEPTH; ++q) if (h[q]) { TR_STORE(v[q], t[q]); h[q] = decode(j0 + CONV_DEPTH + q, t[q]); if (h[q]) TR_LOAD(v[q], t[q]); }
        j0 += CONV_DEPTH;
    }
#undef TR_LOAD
#undef TR_STORE
}


DI void p0_prologue(Frame& F) {
    LAS float* scr = (LAS float*)(F.lds + RING_OFF + F.wave * 16384);
    const int gw = F.bid * NWAVES + F.wave, NGW = F.G * NWAVES;
    constexpr int I0 = 16 * 208, I1 = 8 * 32, I2 = 16 * 32, I5 = 16 * 64;
    constexpr int NITEMS = I0 + I1 + 4 * I2 + I5;
    for (int it = gw; it < NITEMS; it += NGW) {
        int r = it;
        if (r < I0) { const int kb = r / 208, nb = r % 208; p0_tr_item(inp(F, I_WIN), NPROJ, 1024, (bf16*)(F.ws + WS_WIN) + (size_t)(32 * nb) * 1024, scr, 64 * kb, 32 * nb, F.lane); continue; } r -= I0;
        if (r < I1) { const int kb = r / 32, nb = r % 32; p0_tr_item(inp(F, I_WSBO), 1024, 512, (bf16*)(F.ws + WS_WSBO) + (size_t)(32 * nb) * 512, scr, 64 * kb, 32 * nb, F.lane); continue; } r -= I1;
        if (r < I2) { const int kb = r / 32, nb = r % 32; p0_tr_item(inp(F, I_WRETO), 1024, 1024, (bf16*)(F.ws + WS_WRETO) + (size_t)(32 * nb) * 1024, scr, 64 * kb, 32 * nb, F.lane); continue; } r -= I2;
        if (r < I2) { const int kb = r / 32, nb = r % 32; p0_tr_item(inp(F, I_WMIX), 1024, 1024, (bf16*)(F.ws + WS_WMIX) + (size_t)(32 * nb) * 1024, scr, 64 * kb, 32 * nb, F.lane); continue; } r -= I2;
        if (r < I2) { const int kb = r / 32, nb = r % 32; p0_tr_item(inp(F, I_WCQ), 1024, 1024, (bf16*)(F.ws + WS_WCQ) + (size_t)(32 * nb) * 1024, scr, 64 * kb, 32 * nb, F.lane, inp(F, I_GXATTN)); continue; }   r -= I2;
        if (r < I5) { const int kb = r / 64, nb = r % 64; p0_tr_item(inp(F, I_WCKV), 2048, 1024, (bf16*)(F.ws + WS_WCKV) + (size_t)(32 * nb) * 1024, scr, 64 * kb, 32 * nb, F.lane); continue; } r -= I5;
        { const int kb = r / 32, nb = r % 32; p0_tr_item(inp(F, I_WCO), 1024, 1024, (bf16*)(F.ws + WS_WCO) + (size_t)(32 * nb) * 1024, scr, 64 * kb, 32 * nb, F.lane); }
    }
    {
        const int MT = T + BATCH * MEML; const int lane = F.lane;
#define P0_ROWSRC(m_) ((const f32x4*)((m_) < T ? inp(F, I_X) + (size_t)(m_) * DM : inp(F, I_MEM) + (size_t)((m_) - T) * DM) + lane)
#define P0_ROWLD(v_, m_) do { const f32x4* p_ = P0_ROWSRC(m_); v_##0 = P0_LD(p_); v_##1 = P0_LD(p_ + 64); v_##2 = P0_LD(p_ + 128); v_##3 = P0_LD(p_ + 192); } while (0)
#define P0_ROWFIN(v_, m_) do { const f32x4* gr_ = (const f32x4*)((m_) < T ? inp(F, I_GMIX) : inp(F, I_GMEM)) + lane; \
        float s_ = ((v_##0).x * (v_##0).x + (v_##0).y * (v_##0).y) + ((v_##0).z * (v_##0).z + (v_##0).w * (v_##0).w); s_ += ((v_##1).x * (v_##1).x + (v_##1).y * (v_##1).y) + ((v_##1).z * (v_##1).z + (v_##1).w * (v_##1).w); \
        s_ += ((v_##2).x * (v_##2).x + (v_##2).y * (v_##2).y) + ((v_##2).z * (v_##2).z + (v_##2).w * (v_##2).w); s_ += ((v_##3).x * (v_##3).x + (v_##3).y * (v_##3).y) + ((v_##3).z * (v_##3).z + (v_##3).w * (v_##3).w); \
        const float rstd_ = 1.0f / sqrtf(wave_sum(s_) * (1.f / DM) + NORM_EPS); \
        u32x2* o8_ = (u32x2*)((m_) < T ? (bf16*)(F.ws + WS_XN1) + (size_t)(m_) * DM : (bf16*)(F.ws + WS_MEMN) + (size_t)((m_) - T) * DM) + lane; \
        { const f32x4 g_ = gr_[0];   u32x2 w_; w_.x = cvtpk((v_##0).x * rstd_ * g_.x, (v_##0).y * rstd_ * g_.y); w_.y = cvtpk((v_##0).z * rstd_ * g_.z, (v_##0).w * rstd_ * g_.w); o8_[0] = w_; } \
        { const f32x4 g_ = gr_[64];  u32x2 w_; w_.x = cvtpk((v_##1).x * rstd_ * g_.x, (v_##1).y * rstd_ * g_.y); w_.y = cvtpk((v_##1).z * rstd_ * g_.z, (v_##1).w * rstd_ * g_.w); o8_[64] = w_; } \
        { const f32x4 g_ = gr_[128]; u32x2 w_; w_.x = cvtpk((v_##2).x * rstd_ * g_.x, (v_##2).y * rstd_ * g_.y); w_.y = cvtpk((v_##2).z * rstd_ * g_.z, (v_##2).w * rstd_ * g_.w); o8_[128] = w_; } \
        { const f32x4 g_ = gr_[192]; u32x2 w_; w_.x = cvtpk((v_##3).x * rstd_ * g_.x, (v_##3).y * rstd_ * g_.y); w_.y = cvtpk((v_##3).z * rstd_ * g_.z, (v_##3).w * rstd_ * g_.w); o8_[192] = w_; } } while (0)
        f32x4 ra0, ra1, ra2, ra3, rb0, rb1, rb2, rb3; int m = gw;
        if (m < MT) { P0_ROWLD(ra, m);
            for (;;) {
                const int mn = m + NGW; const bool hn = mn < MT;
                if (hn) P0_ROWLD(rb, mn);
                P0_ROWFIN(ra, m);
                if (!hn) break;
                const int mn2 = mn + NGW; const bool hn2 = mn2 < MT;
                if (hn2) P0_ROWLD(ra, mn2);
                P0_ROWFIN(rb, mn);
                if (!hn2) break;
                m = mn2;
            } }
#undef P0_ROWSRC
#undef P0_ROWLD
#undef P0_ROWFIN
    }
    { float* ct = (float*)(F.ws + WS_ROPE); float* st = ct + SEQ * 32;
      for (int i = F.bid * 512 + F.tid; i < SEQ * 32; i += F.G * 512) { const int pos = i >> 5, k = i & 31;
          const float inv = fexp2(-(float)k * (13.287712379549449f / 32.0f)); const float ang = (float)pos * inv;
          const float n = rintf(ang * 0.15915494309189535f); float r = fmaf(-n, 6.2831854820251465f, ang); r = fmaf(-n, -1.7484555e-7f, r);
          const float rev = r * 0.15915494309189535f; ct[i] = __builtin_amdgcn_cosf(rev); st[i] = __builtin_amdgcn_sinf(rev); } }
}

typedef f32x4 AccT[2][2][4][2];
#define EPI_ROWS_BEGIN _Pragma("unroll") for (int ai = 0; ai < 2; ++ai) _Pragma("unroll") for (int m = 0; m < 4; ++m) { const int rloc = ai * 128 + wr * 64 + m * 16 + fr; const size_t row = (size_t)u.pm * 256 + rloc; (void)row;
#define EPI_ROWS_END }
DI void xchg8(const u32x4 p0, const u32x4 p1, u32x4& a, u32x4& b) {
#pragma unroll
    for (int c = 0; c < 4; ++c) { a[c] = (unsigned)__builtin_amdgcn_update_dpp((int)p0[c], (int)p1[c], 0x128, 0xF, 0xC, false);
                                  b[c] = (unsigned)__builtin_amdgcn_update_dpp((int)p1[c], (int)p0[c], 0x128, 0xF, 0x3, false); }
}
#define EPI_ST2(ADDR, P0, P1) do { u32x4 a_, b_; xchg8((P0), (P1), a_, b_); const size_t ra_ = row & ~(size_t)8; const int ca_ = colw + ((fr >> 3) << 5) + 8 * fq; \
    *(u32x4*)(ADDR(ra_, ca_)) = a_; *(u32x4*)(ADDR(ra_ + 8, ca_)) = b_; } while (0)
#ifdef EPL_NT
#define EPL_LD(p) __builtin_nontemporal_load(p)
#else
#define EPL_LD(p) (*(p))
#endif
DI u32x4 pack8(f32x4 a, f32x4 b) { u32x4 w; w.x = cvtpk(a[0], a[1]); w.y = cvtpk(a[2], a[3]); w.z = cvtpk(b[0], b[1]); w.w = cvtpk(b[2], b[3]); return w; }
DI void unpack8(u32x4 w, f32x4& a, f32x4& b) { a = (f32x4){bflo(w.x), bfhi(w.x), bflo(w.y), bfhi(w.y)}; b = (f32x4){bflo(w.z), bfhi(w.z), bflo(w.w), bfhi(w.w)}; }
DI f32x4 sig4(f32x4 g) { return (f32x4){sigmoidf_(g[0]), sigmoidf_(g[1]), sigmoidf_(g[2]), sigmoidf_(g[3])}; }

struct Epi1 { DI void pre(const pg8::Unit&, LAS unsigned char*, int, int) const {} static constexpr bool PERM = true, FP8 = false, CM2 = true; bf16* proj; bf16* kvmem;
    DI void operator()(const AccT& acc, const pg8::Unit& u, int wr, int wc, int fr, int fq, const LAS unsigned char* xl) const {
        const int colw = u.pn * 256 + wc * 64;
        if (u.tag == 0) {
            const float sc = (u.pn < 2) ? SBQ_SCALE : ((u.pn == 8 || u.pn == 9) ? 0.125f : 1.f);
#define A_PROJ(r_, c_) (proj + proj_off((r_), (c_)))
            EPI_ROWS_BEGIN
                EPI_ST2(A_PROJ, pack8(acc[ai][0][m][0] * sc, acc[ai][0][m][1] * sc), pack8(acc[ai][1][m][0] * sc, acc[ai][1][m][1] * sc));
            EPI_ROWS_END
#undef A_PROJ
        } else {
#define A_KV(r_, c_) (kvmem + (r_) * 2048 + (c_))
            EPI_ROWS_BEGIN
                EPI_ST2(A_KV, pack8(acc[ai][0][m][0], acc[ai][0][m][1]), pack8(acc[ai][1][m][0], acc[ai][1][m][1]));
            EPI_ROWS_END
#undef A_KV
        }
    }
};
struct Epi5a { DI void pre(const pg8::Unit&, LAS unsigned char*, int, int) const {} static constexpr bool PERM = true, FP8 = false, CM2 = false; const bf16* proj; bf16* tmp;
    DI void operator()(const AccT& acc, const pg8::Unit& u, int wr, int wc, int fr, int fq, const LAS unsigned char* xl) const {
        const int col0 = u.pn * 256 + wc * 32 + 8 * fq;
        u32x4 gq[2][4][2];
#pragma unroll
        for (int ai = 0; ai < 2; ++ai)
#pragma unroll
            for (int m = 0; m < 4; ++m) { const size_t row = (size_t)u.pm * 256 + ai * 128 + wr * 64 + m * 16 + fr;
#pragma unroll
                for (int bj = 0; bj < 2; ++bj) gq[ai][m][bj] = EPL_LD((const u32x4*)(proj + proj_off(row, C_GSB + col0 + bj * 128))); }
#pragma unroll
        for (int ai = 0; ai < 2; ++ai)
#pragma unroll
            for (int m = 0; m < 4; ++m) { const size_t row = (size_t)u.pm * 256 + ai * 128 + wr * 64 + m * 16 + fr;
#pragma unroll
                for (int bj = 0; bj < 2; ++bj) { f32x4 g0, g1; unpack8(gq[ai][m][bj], g0, g1);
                    *(u32x4*)(tmp + row * DM + col0 + bj * 128) = pack8(sig4(g0) * acc[ai][bj][m][0], sig4(g1) * acc[ai][bj][m][1]); } }
    }
};
struct Epi5b { DI void pre(const pg8::Unit&, LAS unsigned char*, int, int) const {} static constexpr bool PERM = true, FP8 = false, CM2 = false; const bf16* proj; const bf16* tmp; bf16* merged;
    DI void operator()(const AccT& acc, const pg8::Unit& u, int wr, int wc, int fr, int fq, const LAS unsigned char* xl) const {
        const int col0 = u.pn * 256 + wc * 32 + 8 * fq;
#pragma unroll
        for (int ai = 0; ai < 2; ++ai) { u32x4 gq[4][2], tq[4][2];
#pragma unroll
            for (int m = 0; m < 4; ++m) { const size_t row = (size_t)u.pm * 256 + ai * 128 + wr * 64 + m * 16 + fr;
#pragma unroll
                for (int bj = 0; bj < 2; ++bj) { gq[m][bj] = EPL_LD((const u32x4*)(proj + proj_off(row, C_GRET + col0 + bj * 128))); tq[m][bj] = *(const u32x4*)(tmp + row * DM + col0 + bj * 128); } }
#pragma unroll
            for (int m = 0; m < 4; ++m) { const size_t row = (size_t)u.pm * 256 + ai * 128 + wr * 64 + m * 16 + fr;
#pragma unroll
                for (int bj = 0; bj < 2; ++bj) { f32x4 g0, g1, t0, t1; unpack8(gq[m][bj], g0, g1); unpack8(tq[m][bj], t0, t1);
                    *(u32x4*)(merged + row * DM + col0 + bj * 128) = pack8(t0 + sig4(g0) * acc[ai][bj][m][0], t1 + sig4(g1) * acc[ai][bj][m][1]); } } }
    }
};
template <bool FIRST> struct EpiRes { DI void pre(const pg8::Unit&, LAS unsigned char*, int, int) const {} static constexpr bool PERM = true, FP8 = false, CM2 = false; const void* xi; bf16* xo; float* slots;
    DI void operator()(const AccT& acc, const pg8::Unit& u, int wr, int wc, int fr, int fq, const LAS unsigned char* xl) const {
        const int col0 = u.pn * 256 + wc * 32 + 8 * fq;
        u32x4 xq[2][4][2];
        if (!FIRST) {
#pragma unroll
            for (int ai = 0; ai < 2; ++ai)
#pragma unroll
                for (int m = 0; m < 4; ++m) { const size_t row = (size_t)u.pm * 256 + ai * 128 + wr * 64 + m * 16 + fr;
#pragma unroll
                    for (int bj = 0; bj < 2; ++bj) xq[ai][m][bj] = *(const u32x4*)((const bf16*)xi + row * DM + col0 + bj * 128); } }
#pragma unroll
        for (int ai = 0; ai < 2; ++ai) { f32x4 xa[4][2], xb[4][2];
            if (FIRST) {
#pragma unroll
                for (int m = 0; m < 4; ++m) { const size_t row = (size_t)u.pm * 256 + ai * 128 + wr * 64 + m * 16 + fr;
#pragma unroll
                    for (int bj = 0; bj < 2; ++bj) { const size_t off = row * DM + col0 + bj * 128; xa[m][bj] = EPL_LD((const f32x4*)((const float*)xi + off)); xb[m][bj] = EPL_LD((const f32x4*)((const float*)xi + off + 4)); } } }
#pragma unroll
            for (int m = 0; m < 4; ++m) { const size_t row = (size_t)u.pm * 256 + ai * 128 + wr * 64 + m * 16 + fr; float ss = 0.f;
#pragma unroll
                for (int bj = 0; bj < 2; ++bj) { const size_t off = row * DM + col0 + bj * 128; f32x4 a, b;
                    if (FIRST) { a = xa[m][bj]; b = xb[m][bj]; } else unpack8(xq[ai][m][bj], a, b);
                    a += acc[ai][bj][m][0]; b += acc[ai][bj][m][1];
                    *(u32x4*)(xo + off) = pack8(a, b);
                    if (FIRST) ss += (a[0] * a[0] + a[1] * a[1]) + (a[2] * a[2] + a[3] * a[3]) + (b[0] * b[0] + b[1] * b[1]) + (b[2] * b[2] + b[3] * b[3]); }
                if (FIRST) { ss += __shfl_xor(ss, 16); ss += __shfl_xor(ss, 32); if (fq == 0) slots[row * 16 + u.pn * 4 + wc] = ss; } } }
    }
};
struct Epi7 { DI void pre(const pg8::Unit&, LAS unsigned char*, int, int) const {} static constexpr bool PERM = true, FP8 = false, CM2 = false; const float* slots; bf16* qx;
    DI void operator()(const AccT& acc, const pg8::Unit& u, int wr, int wc, int fr, int fq, const LAS unsigned char* xl) const {
        const int col0 = u.pn * 256 + wc * 32 + 8 * fq;
        f32x4 s4[2][4];
#pragma unroll
        for (int ai = 0; ai < 2; ++ai)
#pragma unroll
            for (int m = 0; m < 4; ++m) { const size_t row = (size_t)u.pm * 256 + ai * 128 + wr * 64 + m * 16 + fr; s4[ai][m] = *(const f32x4*)(slots + row * 16 + 4 * fq); }
#pragma unroll
        for (int ai = 0; ai < 2; ++ai)
#pragma unroll
            for (int m = 0; m < 4; ++m) { const size_t row = (size_t)u.pm * 256 + ai * 128 + wr * 64 + m * 16 + fr;
                float ss = (s4[ai][m][0] + s4[ai][m][1]) + (s4[ai][m][2] + s4[ai][m][3]); ss += __shfl_xor(ss, 16); ss += __shfl_xor(ss, 32);
                const float sc = XQ_SCALE / sqrtf(ss * (1.f / DM) + NORM_EPS);
#pragma unroll
                for (int bj = 0; bj < 2; ++bj) *(u32x4*)(qx + row * DM + col0 + bj * 128) = pack8(acc[ai][bj][m][0] * sc, acc[ai][bj][m][1] * sc); }
    }
};
struct Epi12 { static constexpr bool PERM = true, FP8 = true, CM2 = false; static constexpr int SCALE_W = 0x79797979, SCALE_A = 0x7f7f7f7f;   const float* rscale; const float* b1; unsigned char* act;
    DI void pre(const pg8::Unit& u, LAS unsigned char* xl, int wid, int lane) const {
        if (wid == 0) __builtin_amdgcn_global_load_lds((const unsigned*)(rscale + (size_t)u.pm * 256 + lane * 4), (LAS unsigned*)xl, 16, 0, 0);
        else if (wid == 1) __builtin_amdgcn_global_load_lds((const unsigned*)(b1 + (size_t)u.e * 2048 + (lane >> 5) * 1024 + u.pn * 128 + (lane & 31) * 4), (LAS unsigned*)(xl + 1024), 16, 0, 0);
    }
    DI void operator()(const AccT& acc, const pg8::Unit& u, int wr, int wc, int fr, int fq, const LAS unsigned char* xl) const {
        const int ac0 = u.pn * 128 + wc * 32 + 8 * fq; const LAS float* bb = (const LAS float*)(xl + 1024) + wc * 32 + 8 * fq;
        const f32x4 bg0 = *(const LAS f32x4*)(bb), bg1 = *(const LAS f32x4*)(bb + 4), bl0 = *(const LAS f32x4*)(bb + 128), bl1 = *(const LAS f32x4*)(bb + 128 + 4);
        EPI_ROWS_BEGIN
            const float rs = ((const LAS float*)xl)[rloc];
            f32x4 o[2];
#pragma unroll
            for (int n = 0; n < 2; ++n) { const f32x4 gl = acc[ai][0][m][n] * rs + (n ? bg1 : bg0), li = acc[ai][1][m][n] * rs + (n ? bl1 : bl0);
#pragma unroll
                for (int i = 0; i < 4; i += 2) {
                    const f32x2 gg = (f32x2){fminf(gl[i], 7.0f), fminf(gl[i + 1], 7.0f)}, ll = (f32x2){fminf(fmaxf(li[i], -7.0f), 7.0f), fminf(fmaxf(li[i + 1], -7.0f), 7.0f)};
                    const f32x2 t = gg * (f32x2){-1.702f * LOG2E, -1.702f * LOG2E};
                    const f32x2 d = (f32x2){fexp2(t[0]), fexp2(t[1])} + (f32x2){1.0f, 1.0f};
                    const f32x2 r = (gg * (f32x2){frcp(d[0]), frcp(d[1])}) * (ll + (f32x2){1.0f, 1.0f});
                    o[n][i] = r[0]; o[n][i + 1] = r[1]; } }
            { u32x2 w; w.x = cvt4_fp8(o[0][0], o[0][1], o[0][2], o[0][3]); w.y = cvt4_fp8(o[1][0], o[1][1], o[1][2], o[1][3]); *(u32x2*)(act + row * DFF + ac0) = w; }
        EPI_ROWS_END
    }
};
struct Epi13 { static constexpr bool PERM = true, FP8 = true, CM2 = false; static constexpr int SCALE_W = 0x79797979, SCALE_A = 0x7f7f7f7f; const float* rgate; const float* b2; bf16* yrows;
    DI void pre(const pg8::Unit& u, LAS unsigned char* xl, int wid, int lane) const {
        if (wid == 0) __builtin_amdgcn_global_load_lds((const unsigned*)(rgate + (size_t)u.pm * 256 + lane * 4), (LAS unsigned*)xl, 16, 0, 0);
        else if (wid == 1) __builtin_amdgcn_global_load_lds((const unsigned*)(b2 + (size_t)u.e * 1024 + u.pn * 256 + lane * 4), (LAS unsigned*)(xl + 1024), 16, 0, 0);
    }
    DI void operator()(const AccT& acc, const pg8::Unit& u, int wr, int wc, int fr, int fq, const LAS unsigned char* xl) const {
        const int col0 = u.pn * 256 + wc * 32 + 8 * fq; const LAS float* bb = (const LAS float*)(xl + 1024) + wc * 32 + 8 * fq;
        f32x4 bv[2][2];
#pragma unroll
        for (int bj = 0; bj < 2; ++bj) { bv[bj][0] = *(const LAS f32x4*)(bb + bj * 128); bv[bj][1] = *(const LAS f32x4*)(bb + bj * 128 + 4); }
        EPI_ROWS_BEGIN
            const float gt = ((const LAS float*)xl)[rloc];
#pragma unroll
            for (int bj = 0; bj < 2; ++bj) *(u32x4*)(yrows + row * DM + col0 + bj * 128) = pack8((acc[ai][bj][m][0] + bv[bj][0]) * gt, (acc[ai][bj][m][1] + bv[bj][1]) * gt);
        EPI_ROWS_END
    }
};

DI void lds_barrier() { asm volatile("s_waitcnt lgkmcnt(0)" ::: "memory"); __builtin_amdgcn_s_barrier(); asm volatile("" ::: "memory"); }

constexpr int SB_K = 0, SB_V = 8192;
DI void sb_unit(Frame& F, int b, int h, int qb) {
    const int lane = F.lane, r32 = lane & 31, hi = lane >> 5, wid = F.wave;
    LAS char* lds = (LAS char*)F.lds;
    const bf16* Pj = (const bf16*)(F.ws + WS_PROJ); const size_t brow = (size_t)b * SEQ;
    const int qw0 = qb * 256 + wid * 32, q = qw0 + r32;
    bf16x8 qr[4];
#pragma unroll
    for (int d0 = 0; d0 < 4; ++d0) qr[d0] = *(const bf16x8*)(Pj + proj_off(brow + q, C_SBQ + h * 64) + d0 * 16 + hi * 8);
    f32x16 o0, o1;
#pragma unroll
    for (int r = 0; r < 16; ++r) { o0[r] = 0.f; o1[r] = 0.f; }
    float carry = 0.f;
    const bf16* ksrc = Pj + proj_off(brow + lane, C_SBK + h * 64) + wid * 8;
    const bf16* vsrc = Pj + proj_off(brow + 16 * (wid & 3) + (lane >> 2), C_SBV + h * 64) + (wid >> 2) * 32 + (lane & 3) * 8;
    LAS char* kdst = lds + SB_K + wid * 1024 + lane * 16; LAS char* vdst = lds + SB_V + wid * 1024 + lane * 16;
    const LAS char* kp0 = lds + SB_K + hi * 1024 + r32 * 16;
    const LAS char* vp0 = lds + SB_V + ((lane >> 4) & 1) * 32 + (lane & 3) * 8 + (4 * hi + ((lane & 15) >> 2)) * 64;
    int kt = 4 * qb + 3, par = 0;
    volatile LAS int* flg = (volatile LAS int*)(lds + XTRA_OFF + 1024);
    u32x4 kreg = *(const u32x4*)(ksrc + (size_t)kt * 4096), vreg = *(const u32x4*)(vsrc + (size_t)kt * 4096);
    for (;;) {
        *(LAS u32x4*)kdst = kreg; *(LAS u32x4*)vdst = vreg;
        __syncthreads();
        if (kt > 0) { kreg = *(const u32x4*)(ksrc + (size_t)(kt - 1) * 4096); vreg = *(const u32x4*)(vsrc + (size_t)(kt - 1) * 4096); }
        const int k0 = kt * 64;
        const bool active = (k0 < qw0 + 31) && !__all(carry >= SB_THR);
        if (active) {
            f32x16 p0, p1;
#pragma unroll
            for (int r = 0; r < 16; ++r) { p0[r] = 0.f; p1[r] = 0.f; }
#pragma unroll
            for (int d0 = 0; d0 < 4; ++d0) { const bf16x8 a0 = *(const LAS bf16x8*)(kp0 + d0 * 2048), a1 = *(const LAS bf16x8*)(kp0 + d0 * 2048 + 512);
                p0 = MFMA32(a0, qr[d0], p0); p1 = MFMA32(a1, qr[d0], p1); }
            const bool mask = (k0 + 63 >= qw0);
            const int tq = q - k0 - 4 * hi;
            float sp[8][4], Mj[8]; float ps = 0.f; u32x4 pw[4];
#define SB_ELEMWISE(MASKED) do { \
            _Pragma("unroll") for (int j = 0; j < 8; ++j) { float s_ = 0.f; \
                _Pragma("unroll") for (int i = 0; i < 4; ++i) { float zl = (j < 4) ? p0[4 * (j & 3) + i] : p1[4 * (j & 3) + i]; \
                    if (MASKED) { zl = (32 * (j >> 2) + 8 * (j & 3) + i < tq) ? zl : -1.0e4f; if (j < 4) p0[4 * (j & 3) + i] = zl; else p1[4 * (j & 3) + i] = zl; } \
                    const float v_ = flog2(1.0f + fexp2(zl)); sp[j][i] = v_; s_ += v_; } \
                Mj[j] = s_; } \
            _Pragma("unroll") for (int j = 7; j >= 0; --j) { \
                const auto rr = __builtin_amdgcn_permlane32_swap(__float_as_uint(Mj[j]), __float_as_uint(Mj[j]), false, false); \
                const float Pp = __uint_as_float(hi ? rr[0] : rr[1]);             \
                float C = carry + ps + (hi ? 0.f : Pp);                           \
                float w[4]; \
                _Pragma("unroll") for (int i = 3; i >= 0; --i) { const float zl = (j < 4) ? p0[4 * (j & 3) + i] : p1[4 * (j & 3) + i]; C += sp[j][i]; w[i] = fexp2(zl - C); } \
                pw[j >> 1][2 * (j & 1)] = cvtpk(w[0], w[1]); pw[j >> 1][2 * (j & 1) + 1] = cvtpk(w[2], w[3]); \
                ps += Mj[j] + Pp; } } while (0)
            if (mask) SB_ELEMWISE(true); else SB_ELEMWISE(false);
#undef SB_ELEMWISE
            carry += ps;
#pragma unroll
            for (int ks = 0; ks < 4; ++ks) {
                const s16x4 l0 = vtr(vp0 + ks * 1024), h0 = vtr(vp0 + ks * 1024 + 512), l1 = vtr(vp0 + 4096 + ks * 1024), h1 = vtr(vp0 + 4096 + ks * 1024 + 512);
                const bf16x8 pa = __builtin_bit_cast(bf16x8, pw[ks]);
                o0 = MFMA32(pa, ((bf16x8){l0[0], l0[1], l0[2], l0[3], h0[0], h0[1], h0[2], h0[3]}), o0);
                o1 = MFMA32(pa, ((bf16x8){l1[0], l1[1], l1[2], l1[3], h1[0], h1[1], h1[2], h1[3]}), o1); }
        }
        const int need = (kt > 0) && !__all(carry >= SB_THR);
        if (lane == 0) flg[par * 8 + wid] = need;
        __syncthreads();
        const int any = (flg[par * 8] | flg[par * 8 + 1]) | (flg[par * 8 + 2] | flg[par * 8 + 3]) | (flg[par * 8 + 4] | flg[par * 8 + 5]) | (flg[par * 8 + 6] | flg[par * 8 + 7]);
        par ^= 1;
        if (!any) break;
        --kt;
    }
    bf16* Y = (bf16*)(F.ws + WS_YSB) + (size_t)(b * SEQ + qw0) * 512 + h * 64 + r32;
#pragma unroll
    for (int r = 0; r < 16; ++r) { const int rw = crow(r, hi); Y[(size_t)rw * 512] = (bf16)(cvtpk(o0[r], 0.f) & 0xffffu); Y[(size_t)rw * 512 + 32] = (bf16)(cvtpk(o1[r], 0.f) & 0xffffu); }
}

DI float ret_log2g(int h) { const float x = fexp2(-(float)(5 + h)); return -LOG2E * (x * (1.0f + x * (0.5f + x * (0.33333334f + x * (0.25f + x * 0.2f))))); }
DI int vlay(int tok, int col) { return (col >> 5) * 4096 + (tok >> 4) * 1024 + (tok & 15) * 64 + (col & 31) * 2; }
struct RotRegs { u32x4 a, b; f32x4 c0, c1, s0, s1; };
DI void rot_load(RotRegs& R, const bf16* row  , const float* rope, int pos, int c) {
    R.a = *(const u32x4*)(row + 8 * c); R.b = *(const u32x4*)(row + 32 + 8 * c);
    const float* ct = rope + pos * 32 + 8 * c; const float* st = ct + SEQ * 32;
    R.c0 = *(const f32x4*)ct; R.c1 = *(const f32x4*)(ct + 4); R.s0 = *(const f32x4*)st; R.s1 = *(const f32x4*)(st + 4);
}
DI void rot_apply(const RotRegs& R, f32x4& y1a, f32x4& y1b, f32x4& y2a, f32x4& y2b) {
    f32x4 x1a, x1b, x2a, x2b; unpack8(R.a, x1a, x1b); unpack8(R.b, x2a, x2b);
    y1a = x1a * R.c0 - x2a * R.s0; y1b = x1b * R.c1 - x2b * R.s1; y2a = x1a * R.s0 + x2a * R.c0; y2b = x1b * R.s1 + x2b * R.c1;
}

constexpr int RT_KD = 16384, RT_V = 24576;
DI void rt_unit(Frame& F, int b, int h, int g) {
    const int lane = F.lane, r32 = lane & 31, hi = lane >> 5, wid = F.wave, tid = F.tid, di = wid >> 2, dj = wid & 3;
    LAS char* lds = (LAS char*)F.lds;
    const bf16* Pj = (const bf16*)(F.ws + WS_PROJ); const size_t grow0 = (size_t)(b * SEQ + g * 512);
    const float* rope = (const float*)(F.ws + WS_ROPE);
    const float lg = ret_log2g(h);
    f32x16 acc;
#pragma unroll
    for (int r = 0; r < 16; ++r) acc[r] = 0.f;
    const int ktok = tid >> 2, kc = tid & 3;
    RotRegs R[4]; u32x4 v0[4], v1[4];
    const int vt0 = tid >> 4, vc0 = tid & 15, vt1 = (tid + 512) >> 4;
#define RT_LOADS(step_, sl_) do { const size_t r0_ = grow0 + (size_t)(step_) * 64; \
        if (tid < 256) rot_load(R[sl_], Pj + proj_off(r0_ + ktok, C_RK + h * 64), rope, g * 512 + (step_) * 64 + ktok, kc); \
        v0[sl_] = *(const u32x4*)(Pj + proj_off(r0_ + vt0, C_RV + h * 128) + 8 * vc0); v1[sl_] = *(const u32x4*)(Pj + proj_off(r0_ + vt1, C_RV + h * 128) + 8 * vc0); } while (0)
    RT_LOADS(0, 0); RT_LOADS(1, 1); RT_LOADS(2, 2); RT_LOADS(3, 3);
    const LAS char* trb = lds + ((lane >> 4) & 1) * 32 + (lane & 3) * 8 + (4 * hi + ((lane & 15) >> 2)) * 64;
#pragma unroll
    for (int step = 0; step < 8; ++step) {
        const int sl = step & 3;
        if (tid < 256) { f32x4 y1a, y1b, y2a, y2b; rot_apply(R[sl], y1a, y1b, y2a, y2b); const float dec = fexp2(lg * (float)(511 - (step * 64 + ktok)));
            *(LAS u32x4*)(lds + RT_KD + vlay(ktok, 8 * kc)) = pack8(y1a * dec, y1b * dec); *(LAS u32x4*)(lds + RT_KD + vlay(ktok, 32 + 8 * kc)) = pack8(y2a * dec, y2b * dec); }
        *(LAS u32x4*)(lds + RT_V + vlay(vt0, 8 * vc0)) = v0[sl]; *(LAS u32x4*)(lds + RT_V + vlay(vt1, 8 * vc0)) = v1[sl];
        __syncthreads();
        if (step + 4 < 8) RT_LOADS(step + 4, sl);
#pragma unroll
        for (int ks = 0; ks < 4; ++ks) {
            const s16x4 al = vtr(trb + RT_KD + di * 4096 + ks * 1024), ah = vtr(trb + RT_KD + di * 4096 + ks * 1024 + 512);
            const s16x4 bl = vtr(trb + RT_V + dj * 4096 + ks * 1024), bh = vtr(trb + RT_V + dj * 4096 + ks * 1024 + 512);
            acc = MFMA32(((bf16x8){al[0], al[1], al[2], al[3], ah[0], ah[1], ah[2], ah[3]}), ((bf16x8){bl[0], bl[1], bl[2], bl[3], bh[0], bh[1], bh[2], bh[3]}), acc); }
        __syncthreads();
    }
#undef RT_LOADS
    float* G = (float*)(F.ws + WS_GTOT) + (size_t)((b * 8 + h) * 4 + g) * 8192 + dj * 32 + r32;
#pragma unroll
    for (int r = 0; r < 16; ++r) G[(di * 32 + crow(r, hi)) * 128] = acc[r];
}

constexpr int RO_QD = 0, RO_KI = 8192, RO_KD = 16384, RO_V = 24576, RO_SS = 40960, RO_OST = 57344;
DI void ro_unit(Frame& F, int b, int h, int g) {
    const int lane = F.lane, r32 = lane & 31, hi = lane >> 5, wid = F.wave, tid = F.tid, ci = wid >> 2, dj = wid & 3;
    LAS char* lds = (LAS char*)F.lds;
    const bf16* Pg = (const bf16*)(F.ws + WS_PROJ); const size_t grow0 = (size_t)(b * SEQ + g * 512);
    const float* rope = (const float*)(F.ws + WS_ROPE);
    const float lg = ret_log2g(h);
    f32x16 st;
#pragma unroll
    for (int r = 0; r < 16; ++r) st[r] = 0.f;
#pragma unroll
    for (int gp = 0; gp < 3; ++gp) if (gp < g) { const float coef = fexp2(lg * (float)(512 * (g - 1 - gp)));
        const float* G = (const float*)(F.ws + WS_GTOT) + (size_t)((b * 8 + h) * 4 + gp) * 8192 + dj * 32 + r32;
#pragma unroll
        for (int r = 0; r < 16; ++r) st[r] += coef * G[(ci * 32 + crow(r, hi)) * 128]; }
    const float dec64 = fexp2(lg * 64.0f);
    const bool isq = tid < 256; const int rtok = (tid & 255) >> 2, rc = tid & 3;
    RotRegs R; u32x4 v0, v1, gn0, gn1, gc0, gc1;
    const int vt0 = tid >> 4, vc0 = tid & 15, vt1 = (tid + 512) >> 4;
    const int grow = tid >> 3, gseg = tid & 7;
#ifdef RO_NT
#define RO_LD(p) __builtin_nontemporal_load(p)
#else
#define RO_LD(p) (*(p))
#endif
#define RO_LOADS(n_) do { const size_t r0_ = grow0 + (size_t)(n_) * 64; \
        rot_load(R, Pg + proj_off(r0_ + rtok, (isq ? C_RQ : C_RK) + h * 64), rope, g * 512 + (n_) * 64 + rtok, rc); \
        v0 = RO_LD((const u32x4*)(Pg + proj_off(r0_ + vt0, C_RV + h * 128) + 8 * vc0)); v1 = RO_LD((const u32x4*)(Pg + proj_off(r0_ + vt1, C_RV + h * 128) + 8 * vc0)); \
        gn0 = RO_LD((const u32x4*)(Pg + proj_off(r0_ + grow, C_RG + h * 128 + gseg * 16))); gn1 = RO_LD((const u32x4*)(Pg + proj_off(r0_ + grow, C_RG + h * 128 + gseg * 16 + 8))); } while (0)
    RO_LOADS(0);
    const LAS char* trv = lds + ((lane >> 4) & 1) * 32 + (lane & 3) * 8 + (4 * hi + ((lane & 15) >> 2)) * 64;
    const LAS char* trs = lds + ((lane >> 4) & 1) * 32 + (lane & 3) * 8 + (8 * hi + ((lane & 15) >> 2)) * 64;
    for (int n = 0; n < 8; ++n) {
        gc0 = gn0; gc1 = gn1;
        { f32x4 y1a, y1b, y2a, y2b; rot_apply(R, y1a, y1b, y2a, y2b);
          if (isq) { const float s = fexp2(lg * (float)(rtok + 1));
              *(LAS u32x4*)(lds + RO_QD + rc * 1024 + rtok * 16) = pack8(y1a * s, y1b * s); *(LAS u32x4*)(lds + RO_QD + (rc + 4) * 1024 + rtok * 16) = pack8(y2a * s, y2b * s); }
          else { const float si = fexp2(-lg * (float)(rtok + 1)), sd = fexp2(lg * (float)(63 - rtok));
              *(LAS u32x4*)(lds + RO_KI + rc * 1024 + rtok * 16) = pack8(y1a * si, y1b * si); *(LAS u32x4*)(lds + RO_KI + (rc + 4) * 1024 + rtok * 16) = pack8(y2a * si, y2b * si);
              *(LAS u32x4*)(lds + RO_KD + vlay(rtok, 8 * rc)) = pack8(y1a * sd, y1b * sd); *(LAS u32x4*)(lds + RO_KD + vlay(rtok, 32 + 8 * rc)) = pack8(y2a * sd, y2b * sd); } }
        *(LAS u32x4*)(lds + RO_V + vlay(vt0, 8 * vc0)) = v0; *(LAS u32x4*)(lds + RO_V + vlay(vt1, 8 * vc0)) = v1;
#pragma unroll
        for (int r = 0; r < 16; ++r) *(LAS bf16*)(lds + RO_SS + vlay(ci * 32 + crow(r, hi), dj * 32 + r32)) = (bf16)(cvtpk(st[r], 0.f) & 0xffffu);
        lds_barrier();
        if (n < 7) RO_LOADS(n + 1);
        bf16x8 qf[4];
#pragma unroll
        for (int d0 = 0; d0 < 4; ++d0) qf[d0] = *(const LAS bf16x8*)(lds + RO_QD + (2 * d0 + hi) * 1024 + (ci * 32 + r32) * 16);
        f32x16 p0, p1, o;
#pragma unroll
        for (int r = 0; r < 16; ++r) { p0[r] = 0.f; p1[r] = 0.f; o[r] = 0.f; }
#pragma unroll
        for (int d0 = 0; d0 < 4; ++d0) { p0 = MFMA32(*(const LAS bf16x8*)(lds + RO_KI + (2 * d0 + hi) * 1024 + r32 * 16), qf[d0], p0);
            if (ci) p1 = MFMA32(*(const LAS bf16x8*)(lds + RO_KI + (2 * d0 + hi) * 1024 + 512 + r32 * 16), qf[d0], p1); }
        const int ql = ci * 32 + r32;
        u32x4 pw[4];
#pragma unroll
        for (int j = 0; j < 8; ++j) { float w[4];
#pragma unroll
            for (int i = 0; i < 4; ++i) { const float z = (j < 4) ? p0[4 * (j & 3) + i] : p1[4 * (j & 3) + i]; const int key = 32 * (j >> 2) + 8 * (j & 3) + 4 * hi + i; w[i] = (key <= ql) ? z : 0.f; }
            pw[j >> 1][2 * (j & 1)] = cvtpk(w[0], w[1]); pw[j >> 1][2 * (j & 1) + 1] = cvtpk(w[2], w[3]); }
#pragma unroll
        for (int r = 0; r < 16; ++r) st[r] *= dec64;
#pragma unroll
        for (int ks = 0; ks < 4; ++ks) {
            const s16x4 bl = vtr(trv + RO_V + dj * 4096 + ks * 1024), bh = vtr(trv + RO_V + dj * 4096 + ks * 1024 + 512);
            const bf16x8 vf = (bf16x8){bl[0], bl[1], bl[2], bl[3], bh[0], bh[1], bh[2], bh[3]};
            if (ks < 2 || ci) o = MFMA32(__builtin_bit_cast(bf16x8, pw[ks]), vf, o);
            const s16x4 al = vtr(trv + RO_KD + ci * 4096 + ks * 1024), ah = vtr(trv + RO_KD + ci * 4096 + ks * 1024 + 512);
            st = MFMA32(((bf16x8){al[0], al[1], al[2], al[3], ah[0], ah[1], ah[2], ah[3]}), vf, st); }
#pragma unroll
        for (int d0 = 0; d0 < 4; ++d0) { const s16x4 sl = vtr(trs + RO_SS + dj * 4096 + d0 * 1024), sh = vtr(trs + RO_SS + dj * 4096 + d0 * 1024 + 256);
            o = MFMA32(qf[d0], ((bf16x8){sl[0], sl[1], sl[2], sl[3], sh[0], sh[1], sh[2], sh[3]}), o); }
#pragma unroll
        for (int r = 0; r < 16; ++r) *(LAS float*)(lds + RO_OST + ((ci * 32 + crow(r, hi)) * 132 + dj * 32 + r32) * 4) = o[r];
        lds_barrier();
        { const LAS float* orow = (const LAS float*)(lds + RO_OST) + grow * 132 + gseg * 16; f32x4 x[4]; float s = 0.f;
#pragma unroll
          for (int k = 0; k < 4; ++k) { x[k] = *(const LAS f32x4*)(orow + 4 * k); s += (x[k][0] + x[k][1]) + (x[k][2] + x[k][3]); }
          s += __shfl_xor(s, 1); s += __shfl_xor(s, 2); s += __shfl_xor(s, 4);
          const float mu = s * (1.f / 128.f); float qv = 0.f;
#pragma unroll
          for (int k = 0; k < 4; ++k) { x[k] = x[k] - mu; qv += (x[k][0] * x[k][0] + x[k][1] * x[k][1]) + (x[k][2] * x[k][2] + x[k][3] * x[k][3]); }
          qv += __shfl_xor(qv, 1); qv += __shfl_xor(qv, 2); qv += __shfl_xor(qv, 4);
          const float rstd = 1.0f / sqrtf(qv * (1.f / 128.f) + NORM_EPS);
          const size_t trow = (size_t)(b * SEQ + g * 512 + n * 64 + grow);
          f32x4 g0, g1, g2, g3; unpack8(gc0, g0, g1); unpack8(gc1, g2, g3);
          bf16* yo = (bf16*)(F.ws + WS_YRET) + trow * DM + h * 128 + gseg * 16;
          *(u32x4*)yo = pack8(g0 * sig4(g0) * x[0] * rstd, g1 * sig4(g1) * x[1] * rstd); *(u32x4*)(yo + 8) = pack8(g2 * sig4(g2) * x[2] * rstd, g3 * sig4(g3) * x[3] * rstd); }
    }
}

DI void xa_unit(Frame& F, int b, int hx, int qb) {
    const int lane = F.lane, r32 = lane & 31, hi = lane >> 5, wid = F.wave, tid = F.tid;
    LAS char* lds = (LAS char*)F.lds;
    const int qw0 = qb * 256 + wid * 32;
    const bf16* Q = (const bf16*)(F.ws + WS_QX) + (size_t)(b * SEQ + qw0 + r32) * DM + hx * 256 + hi * 8;
    const bf16* KV = (const bf16*)(F.ws + WS_KVMEM) + (size_t)(b * MEML) * 2048 + hx * 256;
    bf16x8 qr[16];
#pragma unroll
    for (int d0 = 0; d0 < 16; ++d0) qr[d0] = *(const bf16x8*)(Q + d0 * 16);
    __syncthreads();
#pragma unroll 4
    for (int j = 0; j < 16; ++j) { const int i = tid + 512 * j, c = i & 31, key = i >> 5;
        *(LAS u32x4*)(lds + (key >> 6) * 32768 + c * 1024 + (key & 63) * 16) = *(const u32x4*)(KV + (size_t)key * 2048 + 8 * c); }
    __syncthreads();
    f32x16 sc[8];
#pragma unroll
    for (int t = 0; t < 8; ++t)
#pragma unroll
        for (int r = 0; r < 16; ++r) sc[t][r] = 0.f;
#pragma unroll
    for (int kt = 0; kt < 4; ++kt)
#pragma unroll
        for (int d0 = 0; d0 < 16; ++d0) { const LAS char* kp = lds + kt * 32768 + (2 * d0 + hi) * 1024 + r32 * 16;
            sc[2 * kt] = MFMA32(*(const LAS bf16x8*)kp, qr[d0], sc[2 * kt]); sc[2 * kt + 1] = MFMA32(*(const LAS bf16x8*)(kp + 512), qr[d0], sc[2 * kt + 1]); }
    float mx = -3.0e38f;
#pragma unroll
    for (int t = 0; t < 8; ++t)
#pragma unroll
        for (int r = 0; r < 16; ++r) mx = fmaxf(mx, sc[t][r]);
    { const auto rr = __builtin_amdgcn_permlane32_swap(__float_as_uint(mx), __float_as_uint(mx), false, false); mx = fmaxf(__uint_as_float(rr[0]), __uint_as_float(rr[1])); }
    float l = 0.f; u32x4 pa[16];
#pragma unroll
    for (int t = 0; t < 8; ++t)
#pragma unroll
        for (int r2 = 0; r2 < 8; ++r2) { const float e0 = fexp2(sc[t][2 * r2] - mx), e1 = fexp2(sc[t][2 * r2 + 1] - mx); l += e0 + e1; pa[2 * t + (r2 >> 2)][r2 & 3] = cvtpk(e0, e1); }
    { const auto rr = __builtin_amdgcn_permlane32_swap(__float_as_uint(l), __float_as_uint(l), false, false); l = __uint_as_float(rr[0]) + __uint_as_float(rr[1]); }
    LAS float* wsf = (LAS float*)(lds + XTRA_OFF) + wid * 32;
    if (hi == 0) wsf[r32] = 1.0f / l;
    __syncthreads();
#pragma unroll 4
    for (int j = 0; j < 16; ++j) { const int i = tid + 512 * j, c = i & 31, key = i >> 5;
        *(LAS u32x4*)(lds + (key >> 6) * 32768 + (c >> 2) * 4096 + ((key & 63) >> 4) * 1024 + (key & 15) * 64 + (c & 3) * 16) = *(const u32x4*)(KV + (size_t)key * 2048 + 1024 + 8 * c); }
    __syncthreads();
    f32x16 o[8];
#pragma unroll
    for (int t = 0; t < 8; ++t)
#pragma unroll
        for (int r = 0; r < 16; ++r) o[t][r] = 0.f;
    const LAS char* vp0 = lds + ((lane >> 4) & 1) * 32 + (lane & 3) * 8 + (4 * hi + ((lane & 15) >> 2)) * 64;
#pragma unroll
    for (int vt = 0; vt < 4; ++vt)
#pragma unroll
        for (int ks = 0; ks < 4; ++ks) { const bf16x8 pf = __builtin_bit_cast(bf16x8, pa[4 * vt + ks]);
#pragma unroll
            for (int d0 = 0; d0 < 8; ++d0) { const s16x4 lo = vtr(vp0 + vt * 32768 + d0 * 4096 + ks * 1024), hh = vtr(vp0 + vt * 32768 + d0 * 4096 + ks * 1024 + 512);
                o[d0] = MFMA32(pf, ((bf16x8){lo[0], lo[1], lo[2], lo[3], hh[0], hh[1], hh[2], hh[3]}), o[d0]); } }
    bf16* O = (bf16*)(F.ws + WS_OX) + (size_t)(b * SEQ + qw0) * DM + hx * 256 + r32;
#pragma unroll
    for (int r = 0; r < 16; ++r) { const int rw = crow(r, hi); const float il = wsf[rw];
#pragma unroll
        for (int d0 = 0; d0 < 8; ++d0) O[(size_t)rw * DM + d0 * 32] = (bf16)(cvtpk(o[d0][r] * il, 0.f) & 0xffffu); }
}

DI void route_a(Frame& F, int tb) {
    const int lane = F.lane, wid = F.wave, tid = F.tid, tg = wid >> 2, kq = wid & 3, hi = lane >> 5, e31 = lane & 31;
    LAS char* lds = (LAS char*)F.lds;
    const float* wr = inp(F, I_WROUTER); const float* gm = inp(F, I_GMOE); const bf16* x2 = (const bf16*)(F.ws + WS_XN3U);
    unsigned char* sm = F.ws + WS_SMALL;
    constexpr int RP = 2064, WM_OFF = 32 * RP;
    const int tok = tb * 64 + tg * 32 + e31;
    const bf16* xr = x2 + (size_t)tok * DM + kq * 256 + 8 * hi;
    u32x4 xa[16];
#pragma unroll
    for (int kb = 0; kb < 16; ++kb) xa[kb] = *(const u32x4*)(xr + 16 * kb);
    __syncthreads();
    { f32x4 w0[8], w1[8]; const float g0 = gm[2 * tid], g1 = gm[2 * tid + 1];
#pragma unroll
      for (int q = 0; q < 8; ++q) { w0[q] = *(const f32x4*)(wr + (size_t)(2 * tid) * 32 + 4 * q); w1[q] = *(const f32x4*)(wr + (size_t)(2 * tid + 1) * 32 + 4 * q); }
#pragma unroll
      for (int q = 0; q < 8; ++q)
#pragma unroll
          for (int c = 0; c < 4; ++c) { const float a0 = w0[q][c] * g0, a1 = w1[q][c] * g1; const unsigned H = cvtpk(a0, a1), M = cvtpk(a0 - bflo(H), a1 - bfhi(H));
              *(LAS unsigned*)(lds + (4 * q + c) * RP + 4 * tid) = H; *(LAS unsigned*)(lds + WM_OFF + (4 * q + c) * RP + 4 * tid) = M; } }
    __syncthreads();
    f32x16 acc;
#pragma unroll
    for (int r = 0; r < 16; ++r) acc[r] = 0.f;
    float ss = 0.f;
    const LAS char* WH = lds + e31 * RP + (kq * 256 + 8 * hi) * 2;
#pragma unroll
    for (int kb = 0; kb < 16; ++kb) { const u32x4 v = xa[kb];
        ss += (bflo(v.x) * bflo(v.x) + bfhi(v.x) * bfhi(v.x)) + (bflo(v.y) * bflo(v.y) + bfhi(v.y) * bfhi(v.y)) + (bflo(v.z) * bflo(v.z) + bfhi(v.z) * bfhi(v.z)) + (bflo(v.w) * bflo(v.w) + bfhi(v.w) * bfhi(v.w));
        const bf16x8 xf = __builtin_bit_cast(bf16x8, v);
        acc = MFMA32(xf, *(const LAS bf16x8*)(WH + kb * 32), acc); acc = MFMA32(xf, *(const LAS bf16x8*)(WH + WM_OFF + kb * 32), acc); }
    ss += __shfl_xor(ss, 32);
    __syncthreads();
    LAS float* PL = (LAS float*)lds;
    LAS float* SSP = (LAS float*)(lds + 32768);
    LAS float* LG = (LAS float*)(lds + 36864);
    LAS int* SEL = (LAS int*)(lds + 49152);
#pragma unroll
    for (int r = 0; r < 16; ++r) PL[(kq * 64 + tg * 32 + crow(r, hi)) * 32 + e31] = acc[r];
    if (hi == 0) SSP[kq * 64 + tg * 32 + e31] = ss;
    __syncthreads();
#pragma unroll
    for (int j = 0; j < 4; ++j) { const int idx = tid + 512 * j, tl = idx >> 5, e = idx & 31;
        const float rstd = 1.0f / sqrtf(((SSP[tl] + SSP[64 + tl]) + (SSP[128 + tl] + SSP[192 + tl])) * (1.f / DM) + NORM_EPS);
        LG[tl * 33 + e] = rstd * ((PL[tl * 32 + e] + PL[(64 + tl) * 32 + e]) + (PL[(128 + tl) * 32 + e] + PL[(192 + tl) * 32 + e])) + inp(F, I_BROUTER)[e];
        if (e == 0) ((float*)(sm + SM_RSTD3))[tb * 64 + tl] = rstd; }
    __syncthreads();
    if (tid < 64) {
        int sel[4]; float val[4];
        float lgv[32];
#pragma unroll
        for (int e = 0; e < 32; ++e) lgv[e] = LG[tid * 33 + e];
#pragma unroll
        for (int k = 0; k < 4; ++k) { float best = -3.0e38f; int bi = 0;
#pragma unroll
            for (int e = 0; e < 32; ++e) { const float v = lgv[e]; bool taken = false;
#pragma unroll
                for (int k2 = 0; k2 < 4; ++k2) if (k2 < k) taken = taken || (sel[k2] == e);
                if (!taken && v > best) { best = v; bi = e; } }
            sel[k] = bi; val[k] = best; }
        float ex[4], sum = 0.f;
#pragma unroll
        for (int k = 0; k < 4; ++k) { ex[k] = fexp2((val[k] - val[0]) * LOG2E); sum += ex[k]; }
        const float inv = 1.0f / sum; const int tk = tb * 64 + tid;
#pragma unroll
        for (int k = 0; k < 4; ++k) { ((int*)(sm + SM_TOPE))[tk * 4 + k] = sel[k]; ((float*)(sm + SM_GATE))[tk * 4 + k] = ex[k] * inv; SEL[tid * 4 + k] = sel[k]; }
    }
    __syncthreads();
    LAS int* WC = (LAS int*)(lds + 51200);
    int e_my = 0, rank_w = 0;
    if (tid < 256) { e_my = SEL[tid]; const unsigned long long lt = (1ull << lane) - 1ull;
        for (int ex = 0; ex < 32; ++ex) { const unsigned long long m = __ballot(e_my == ex); if (e_my == ex) rank_w = __popcll(m & lt); if (lane == ex) WC[wid * 32 + ex] = __popcll(m); } }
    __syncthreads();
    if (tid < 256) { int rank = rank_w; for (int w = 0; w < wid; ++w) rank += WC[w * 32 + e_my]; ((int*)(sm + SM_LRANK))[(tb * 64 + (tid >> 2)) * 4 + (tid & 3)] = rank; }
    else if (tid < 288) { const int e = tid - 256; ((int*)(sm + SM_CNT))[tb * 32 + e] = (WC[e] + WC[32 + e]) + (WC[64 + e] + WC[96 + e]); }
}

DI void route_b(Frame& F, int tb) {
    const int lane = F.lane, wid = F.wave, tid = F.tid;
    LAS int* L = (LAS int*)F.lds;
    unsigned char* sm = F.ws + WS_SMALL;
    const int* CNT = (const int*)(sm + SM_CNT);
    u32x4 xv[8][2];
#pragma unroll
    for (int j = 0; j < 8; ++j) { const u32x4* sp = (const u32x4*)((const bf16*)(F.ws + WS_XN3U) + (size_t)(tb * 64 + wid * 8 + j) * DM) + 2 * lane; xv[j][0] = sp[0]; xv[j][1] = sp[1]; }
    int cv[16];
    { const int e = tid & 31, seg = tid >> 5;
#pragma unroll
      for (int w = 0; w < 16; ++w) cv[w] = CNT[(seg * 16 + w) * 32 + e]; }
    const int tok_ = tb * 64 + ((tid & 255) >> 2), a_ = tok_ * 4 + (tid & 3);
    const int e_a = ((const int*)(sm + SM_TOPE))[a_], lr_a = ((const int*)(sm + SM_LRANK))[a_]; const float rs_a = ((const float*)(sm + SM_RSTD3))[tok_], gt_a = ((const float*)(sm + SM_GATE))[a_];
    f32x4 gm[4];
#pragma unroll
    for (int k = 0; k < 4; ++k) gm[k] = *((const f32x4*)inp(F, I_GMOE) + 4 * lane + k);
    __syncthreads();
    { const int e = tid & 31, seg = tid >> 5; int t = 0, p = 0;
#pragma unroll
      for (int w = 0; w < 16; ++w) { t += cv[w]; p += (seg * 16 + w < tb) ? cv[w] : 0; }
      L[seg * 32 + e] = t; L[512 + seg * 32 + e] = p; }
    __syncthreads();
    if (tid < 32) { int t = 0, p = 0;
#pragma unroll
        for (int s_ = 0; s_ < 16; ++s_) { t += L[s_ * 32 + tid]; p += L[512 + s_ * 32 + tid]; }
        L[1024 + tid] = t; L[1056 + tid] = p;
        const int v = ((t + 255) >> 8) << 8; int incl = v;
#pragma unroll
        for (int d = 1; d < 32; d <<= 1) { const int u = __shfl_up(incl, d); if (tid >= d) incl += u; }
        L[1088 + tid] = incl - v; if (tid == 31) L[1120] = incl >> 8; }
    __syncthreads();
    if (tid < 256) { const int row = L[1088 + e_a] + L[1056 + e_a] + lr_a;
        ((int*)(sm + SM_AROW))[a_] = row; ((float*)(sm + SM_RSCALE))[row] = rs_a; ((float*)(sm + SM_RGATE))[row] = gt_a; L[1152 + tid] = row; }
    if (tb == 0 && tid >= 256 && tid < 288) { const int e = tid - 256, nb = (L[1024 + e] + 255) >> 8, b0 = L[1088 + e] >> 8; int* BLKE = (int*)(sm + SM_BLKE);
        for (int i = 0; i < nb; ++i) BLKE[b0 + i] = e; if (e == 0) BLKE[MAXBLK] = L[1120]; }
    __syncthreads();
    unsigned char* XG = F.ws + WS_XG;
#pragma unroll
    for (int j = 0; j < 8; ++j) { const u32x4 v0 = xv[j][0], v1 = xv[j][1]; u32x4 o;
        o.x = cvt4_fp8(bflo(v0.x) * gm[0][0], bfhi(v0.x) * gm[0][1], bflo(v0.y) * gm[0][2], bfhi(v0.y) * gm[0][3]); o.y = cvt4_fp8(bflo(v0.z) * gm[1][0], bfhi(v0.z) * gm[1][1], bflo(v0.w) * gm[1][2], bfhi(v0.w) * gm[1][3]);
        o.z = cvt4_fp8(bflo(v1.x) * gm[2][0], bfhi(v1.x) * gm[2][1], bflo(v1.y) * gm[2][2], bfhi(v1.y) * gm[2][3]); o.w = cvt4_fp8(bflo(v1.z) * gm[3][0], bfhi(v1.z) * gm[3][1], bflo(v1.w) * gm[3][2], bfhi(v1.w) * gm[3][3]);
#pragma unroll
        for (int k = 0; k < 4; ++k) *((u32x4*)(XG + (size_t)L[1152 + (wid * 8 + j) * 4 + k] * DM) + lane) = o; }
}

#ifdef CF_NT
#define CF_LD(p) __builtin_nontemporal_load(p)
#define CF_ST(p, v) __builtin_nontemporal_store((v), (p))
#else
#define CF_LD(p) (*(p))
#define CF_ST(p, v) (*(p) = (v))
#endif
DI void combine_final(Frame& F) {
    const int gw = F.bid * NWAVES + F.wave, NGW = F.G * NWAVES, lane = F.lane;
    const bf16* x2 = (const bf16*)(F.ws + WS_XN3U); const bf16* Y = (const bf16*)(F.ws + WS_YROWS); const int* AROW = (const int*)(F.ws + WS_SMALL + SM_AROW);
    const f32x4* gf = (const f32x4*)inp(F, I_GFINAL) + lane;
    for (int base = gw; base < T; base += 8 * NGW) {
        int ar[8][4];
#pragma unroll
        for (int i = 0; i < 8; ++i) { const int tk = base + i * NGW, tkc = tk < T ? tk : base;
#pragma unroll
            for (int k = 0; k < 4; ++k) ar[i][k] = AROW[tkc * 4 + k]; }
        u32x2 xb[2][4], yb[2][4][4];
#define CF_LOAD(i_, s_) do { const int tk_ = base + (i_) * NGW; const u32x2* xr_ = (const u32x2*)(x2 + (size_t)tk_ * DM) + lane; \
        _Pragma("unroll") for (int j = 0; j < 4; ++j) xb[s_][j] = CF_LD(xr_ + 64 * j); \
        _Pragma("unroll") for (int k = 0; k < 4; ++k) { const u32x2* yr_ = (const u32x2*)(Y + (size_t)ar[i_][k] * DM) + lane; _Pragma("unroll") for (int j = 0; j < 4; ++j) yb[s_][k][j] = CF_LD(yr_ + 64 * j); } } while (0)
        CF_LOAD(0, 0);
#pragma unroll
        for (int i = 0; i < 8; ++i) { const int tok = base + i * NGW; if (tok >= T) break;
            if (i + 1 < 8 && tok + NGW < T) CF_LOAD(i + 1, (i + 1) & 1);
            f32x4 v[4];
#pragma unroll
            for (int j = 0; j < 4; ++j) { const u32x2 w = xb[i & 1][j]; v[j] = (f32x4){bflo(w.x), bfhi(w.x), bflo(w.y), bfhi(w.y)}; }
#pragma unroll
            for (int k = 0; k < 4; ++k)
#pragma unroll
                for (int j = 0; j < 4; ++j) { const u32x2 w = yb[i & 1][k][j]; v[j] += (f32x4){bflo(w.x), bfhi(w.x), bflo(w.y), bfhi(w.y)}; }
            float s = 0.f;
#pragma unroll
            for (int j = 0; j < 4; ++j) s += (v[j][0] * v[j][0] + v[j][1] * v[j][1]) + (v[j][2] * v[j][2] + v[j][3] * v[j][3]);
            const float rstd = 1.0f / sqrtf(wave_sum(s) * (1.f / DM) + NORM_EPS);
            f32x4* o = (f32x4*)(F.out + (size_t)tok * DM) + lane;
#pragma unroll
            for (int j = 0; j < 4; ++j) CF_ST(o + 64 * j, v[j] * rstd * gf[64 * j]);
        }
#undef CF_LOAD
    }
}

constexpr int NPHASE = 14;
#ifndef WGM_P1
#define WGM_P1 2
#endif
#ifndef STAG
#define STAG 0
#endif
#ifndef STAGX
#define STAGX 0
#endif
#ifndef CONV_SPLIT
#define CONV_SPLIT 0
#endif
#ifndef WGM_MID
#define WGM_MID 8
#endif
#ifndef WGM_MOE
#define WGM_MOE 4
#endif
__global__ void __launch_bounds__(NWAVES * 64, 2) mega_fwd(Args args) {
    extern __shared__ __attribute__((aligned(16))) unsigned char lds_raw[];
    Frame F;
    F.lds = (LAS unsigned char*)lds_raw; F.ws = args.ws; F.out = args.out;
    F.tid = threadIdx.x; F.lane = F.tid & 63; F.wave = __builtin_amdgcn_readfirstlane(F.tid >> 6); F.G = gridDim.x; F.bid = blockIdx.x;
    F.kp = (kptr_t)__builtin_amdgcn_kernarg_segment_ptr();
    if (F.tid < 64) ((LAS unsigned*)(F.lds + LDSCTL_OFF))[F.tid] = 0u;
    __syncthreads();
    const int lo = args.ph_lo, hi = args.ph_hi;
    XcdBarrier bar; bar.bar = (unsigned*)(F.ws + WS_CTL) + CW_BAR; bar.x = 0; bar.st = nullptr;
    if (hi - lo > 1) bar = xcd_barrier_post((unsigned*)(F.ws + WS_CTL) + CW_BAR, (volatile LAS unsigned*)(F.lds + LDSCTL_OFF) + 8);
#ifndef PHASE_MASK
#define PHASE_MASK 0xFFFF
#endif
#define IN(k) (((PHASE_MASK >> (k)) & 1) && lo <= (k) && (k) < hi)
#ifndef PROBE_MASK
#define PROBE_MASK 0
#endif
#define REP(k) (((PROBE_MASK >> (k)) & 1) ? 2 : 1)
#define LAUNDER() do { GAS unsigned char* w_ = (GAS unsigned char*)F.ws; GAS float* o_ = (GAS float*)F.out; asm volatile("" : "+s"(F.kp), "+s"(w_), "+s"(o_), "+v"(F.tid), "+s"(F.bid), "+s"(F.G)); \
    F.ws = (unsigned char*)w_; F.out = (float*)o_; F.lane = F.tid & 63; F.wave = __builtin_amdgcn_readfirstlane(F.tid >> 6); ws = F.ws; } while (0)
#define PHASE(k, ...) do { if (IN(k)) { __VA_ARGS__ if (REP(k) == 2) { xcd_barrier(bar); LAUNDER(); __VA_ARGS__ } } } while (0)
#ifdef DOUBLE_BAR
#define SEAM(k) do { if (IN(k) && IN((k) + 1)) { xcd_barrier(bar); xcd_barrier(bar); } LAUNDER(); } while (0)
#else
#define SEAM(k) do { if (IN(k) && IN((k) + 1)) xcd_barrier(bar); LAUNDER(); } while (0)
#endif
#ifndef FASTM_OFF
#define FASTM() ((hi - lo > 1) && bar.st[2] != 0u)
#else
#define FASTM() (false && bar.st[2] != 0u)
#endif
#define BCOORD() const bool fastm = FASTM(); \
    const int vb = __builtin_amdgcn_readfirstlane(fastm ? (int)bar.x : (F.bid & 7)), vr = __builtin_amdgcn_readfirstlane(fastm ? (int)bar.st[3] : (F.bid >> 3)), \
              vnr = __builtin_amdgcn_readfirstlane(fastm ? (int)bar.st[0] : ((F.G + 7 - (F.bid & 7)) >> 3))
#ifndef NO_GROUP_SEAMS
#define SEAMG(k) do { if (IN(k) && IN((k) + 1)) { if (FASTM() && bar.st[0] == 32u && WGM_MID == 8) xcd_group_barrier(bar, (int)(bar.st[3] & 7u), 4u); else if (FASTM()) xcd_local_barrier(bar); else xcd_barrier(bar); } LAUNDER(); } while (0)
#else
#define SEAMG(k) SEAML(k)
#endif
#define SEAML(k) do { if (IN(k) && IN((k) + 1)) { if (FASTM()) xcd_local_barrier(bar); else xcd_barrier(bar); } LAUNDER(); } while (0)
    unsigned char* ws = F.ws;
    LAS unsigned char* ring = F.lds + RING_OFF;

#ifndef NO_WARM
#define WARM(off_, bytes_) do { if (FASTM()) { const unsigned rk_ = bar.st[3]; LAS unsigned* dm_ = (LAS unsigned*)(F.lds + XTRA_OFF + 6144 + F.wave * 256); \
        for (unsigned o_ = (rk_ * 512u + (unsigned)F.tid) * 128u; o_ < (unsigned)(bytes_); o_ += 32u * 512u * 128u) __builtin_amdgcn_global_load_lds((const unsigned*)(ws + (off_) + o_), dm_, 4, 0, 0); } } while (0)
#else
#define WARM(off_, bytes_) do {} while (0)
#endif
    PHASE(0, { p0_prologue(F); }); SEAM(0);

    PHASE(1, {
        BCOORD();
        const bool conv_first = ((fastm ? (int)bar.x : F.bid) & 1) != 0;
        const int lightidx = (F.G == 256 && vnr == 32 && vr >= 24) ? vb * 8 + vr - 24 : -1;
        const int scl = STAGX ? ((vb >> 1) & 3) * STAGX : (vr & 3) * STAG;
        const int cut = conv_first ? 22 + (lightidx >= 0 ? 8 : 0) - scl : scl;
        if (cut > 0) { p0_experts(F, F.bid * NWAVES + F.wave, F.G * NWAVES, lightidx, 0, cut); __syncthreads(); }
        pg8::SchedB S{(const bf16*)(ws + WS_XN1), (const bf16*)(ws + WS_WIN), NPROJ / 256, (const bf16*)(ws + WS_MEMN), (const bf16*)(ws + WS_WCKV), 2048 / 256, vb, vr, vnr, 1024, WGM_P1};
        Epi1 E{(bf16*)(ws + WS_PROJ), (bf16*)(ws + WS_KVMEM)};
        pg8::gemm_phase(ring, 1024, S, E);
        p0_experts(F, F.bid * NWAVES + F.wave, F.G * NWAVES, lightidx, cut);
    }); SEAML(1);

    PHASE(2, {
        BCOORD();
        for (int u = vr; u < 64 + 24; u += vnr) {
            if (u < 64) sb_unit(F, vb, u & 7, u >> 3);
            else { const int q = u - 64; rt_unit(F, vb, q / 3, q % 3); }
        }
    }); SEAML(2);

    PHASE(3, { BCOORD(); for (int u = vr; u < 32; u += vnr) ro_unit(F, vb, u >> 2, u & 3); WARM(WS_WSBO, 1 * MB); WARM(WS_WRETO, 2 * MB); }); SEAML(3);

    PHASE(4, {
        BCOORD();
        { pg8::SchedB S{(const bf16*)(ws + WS_YSB), (const bf16*)(ws + WS_WSBO), 4, nullptr, nullptr, 0, vb, vr, vnr, 512, WGM_MID};
          Epi5a E{(const bf16*)(ws + WS_PROJ), (bf16*)(ws + WS_TMP)}; pg8::gemm_phase(ring, 512, S, E); }
        { pg8::SchedB S{(const bf16*)(ws + WS_YRET), (const bf16*)(ws + WS_WRETO), 4, nullptr, nullptr, 0, vb, vr, vnr, 1024, WGM_MID};
          Epi5b E{(const bf16*)(ws + WS_PROJ), (const bf16*)(ws + WS_TMP), (bf16*)(ws + WS_MERGED)}; pg8::gemm_phase(ring, 1024, S, E); }
        WARM(WS_WMIX, 2 * MB);
    }); SEAMG(4);

    PHASE(5, {
        BCOORD();
        pg8::SchedB S{(const bf16*)(ws + WS_MERGED), (const bf16*)(ws + WS_WMIX), 4, nullptr, nullptr, 0, vb, vr, vnr, 1024, WGM_MID};
        EpiRes<true> E{inp(F, I_X), (bf16*)(ws + WS_XN2U), (float*)(ws + WS_SLOTS)}; pg8::gemm_phase(ring, 1024, S, E);
        WARM(WS_WCQ, 2 * MB); WARM(WS_KVMEM + (size_t)vb * MB, 1 * MB);
    }); SEAMG(5);

    PHASE(6, {
        BCOORD();
        pg8::SchedB S{(const bf16*)(ws + WS_XN2U), (const bf16*)(ws + WS_WCQ), 4, nullptr, nullptr, 0, vb, vr, vnr, 1024, WGM_MID};
        Epi7 E{(const float*)(ws + WS_SLOTS), (bf16*)(ws + WS_QX)}; pg8::gemm_phase(ring, 1024, S, E);
    }); LAUNDER();

    PHASE(7, { BCOORD(); for (int u = vr; u < 32; u += vnr) { int pml_, pn_; pg8::bmap(u, 4, WGM_MID, pml_, pn_); xa_unit(F, vb, pn_, pml_); } WARM(WS_WCO, 2 * MB); }); SEAMG(7);

    PHASE(8, {
        BCOORD();
        pg8::SchedB S{(const bf16*)(ws + WS_OX), (const bf16*)(ws + WS_WCO), 4, nullptr, nullptr, 0, vb, vr, vnr, 1024, WGM_MID};
        EpiRes<false> E{(const void*)(ws + WS_XN2U), (bf16*)(ws + WS_XN3U), nullptr}; pg8::gemm_phase(ring, 1024, S, E);
    }); SEAMG(8);

    PHASE(9, { BCOORD(); for (int u = vr; u < 32; u += vnr) { int pml_, pn_; pg8::bmap(u, 4, WGM_MID, pml_, pn_); route_a(F, vb * 32 + 4 * pml_ + pn_); } }); SEAM(9);
    PHASE(10, { for (int tb = F.bid; tb < T / 64; tb += F.G) route_b(F, tb); }); SEAM(10);

#define MOE_LOCAL() (FASTM() && bar.st[0] == 32u && __hip_atomic_load((const int*)(ws + WS_SMALL + SM_BLKE) + MAXBLK, RLX_AGENT) >= 128)
#define MOE_SCHED(A_, W_, ES_, NN_, WG_, TAG_) \
        const int* BLKE = (const int*)(ws + WS_SMALL + SM_BLKE); const int nblk = __builtin_amdgcn_readfirstlane(__hip_atomic_load(BLKE + MAXBLK, RLX_AGENT)); \
        const bool loc = FASTM() && bar.st[0] == 32u && nblk >= 128; const int x_ = (int)bar.x;     \
        const int lo = loc ? (nblk * x_) >> 3 : 0, nbx = loc ? ((nblk * (x_ + 1)) >> 3) - lo : nblk, rk = loc ? ((__builtin_amdgcn_readfirstlane((int)bar.st[3]) + ((TAG_) ? 16 : 0)) & 31) : F.bid, nrk = loc ? 32 : F.G;     \
        pg8::SchedMoEx S{(A_), (W_), (ES_), BLKE, loc ? (unsigned*)(ws + WS_CTL) + CW_DONE : nullptr, lo, nbx, rk, nrk, 1024, (NN_), (WG_), (TAG_)}
    PHASE(11, {
        MOE_SCHED(ws + WS_XG, ws + WS_WE1, (size_t)2048 * 1024, 8, 4, 0);
        Epi12 E{(const float*)(ws + WS_SMALL + SM_RSCALE), inp(F, I_BE1), ws + WS_ACT}; pg8::gemm_phase(ring, 1024, S, E);
    });
    do { if (IN(11) && IN(12) && !(__builtin_amdgcn_readfirstlane((int)MOE_LOCAL()) != 0)) xcd_barrier(bar); LAUNDER(); } while (0);

    PHASE(12, {
        MOE_SCHED(ws + WS_ACT, ws + WS_WE2, (size_t)1024 * 1024, 4, 8, 1);
        Epi13 E{(const float*)(ws + WS_SMALL + SM_RGATE), inp(F, I_BE2), (bf16*)(ws + WS_YROWS)}; pg8::gemm_phase(ring, 1024, S, E);
    }); SEAM(12);

    PHASE(13, { combine_final(F); });
#undef IN
#undef SEAM
}

#if MK_DEBUG
DI unsigned hsh(unsigned x) { x ^= x >> 16; x *= 0x7feb352du; x ^= x >> 15; x *= 0x846ca68bu; x ^= x >> 16; return x; }
DI void chk_report(unsigned char* ws, int phase, float got, float ref, float atol) {
    float e = fabsf(got - ref) / (fabsf(ref) + atol); if (!(e == e)) e = 1.0e9f; if (e > 1.0e9f) e = 1.0e9f;
    atomicMax((unsigned*)(ws + WS_CTL) + CW_CHK + phase, __float_as_uint(e));
}
DI float dbg_bf(const bf16* p, size_t i) { return bf2f(p[i]); }
DI float dbg_f8(const unsigned char* p, size_t i) { const unsigned b = p[i]; const int e = (b >> 3) & 15, m = b & 7; const float v = e ? (1.0f + m * 0.125f) * exp2f((float)(e - 7)) : m * 0.125f * 0.015625f; return (b & 128) ? -v : v; }
DI float dbg_sigm(float x) { return 1.0f / (1.0f + expf(-x)); }
DI float dbg_rope(const float* rope, int pos, int i, bool sn) { return rope[(sn ? SEQ * 32 : 0) + pos * 32 + i]; }
#define PRJ(row_, col_) bf2f(PROJ[proj_off((size_t)(row_), (col_))])
DI float dbg_rot(const bf16* row, const float* rope, int pos, int d) {
    const int i = d & 31; const float x1 = bf2f(row[i]), x2 = bf2f(row[32 + i]); const float c = dbg_rope(rope, pos, i, false), s = dbg_rope(rope, pos, i, true);
    return d < 32 ? x1 * c - x2 * s : x1 * s + x2 * c;
}
__global__ void __launch_bounds__(64) dbg_kernel(Args a, int phase) {
    const unsigned sid = blockIdx.x * 64 + threadIdx.x; unsigned char* ws = a.ws;
    const unsigned r0 = hsh(sid * 4 + 1 + phase * 7919), r1 = hsh(sid * 4 + 2 + phase * 104729), r2 = hsh(sid * 4 + 3 + phase * 31), r3 = hsh(sid * 4 + 4 + phase * 17);
    const float* rope = (const float*)(ws + WS_ROPE);
    const bf16* PROJ = (const bf16*)(ws + WS_PROJ);
    if (phase == 0) {
        const int which = sid % 12;
        if (which == 7 || which == 8) {   } else if (which < 9) {
            const float* W; const bf16* WT; int K, N; int e = 0;
            switch (which) { case 0: W = a.in[I_WIN]; WT = (const bf16*)(ws + WS_WIN); K = 1024; N = NPROJ; break; case 1: W = a.in[I_WSBO]; WT = (const bf16*)(ws + WS_WSBO); K = 512; N = 1024; break;
                case 2: W = a.in[I_WRETO]; WT = (const bf16*)(ws + WS_WRETO); K = 1024; N = 1024; break; case 3: W = a.in[I_WMIX]; WT = (const bf16*)(ws + WS_WMIX); K = 1024; N = 1024; break;
                case 4: W = a.in[I_WCQ]; WT = (const bf16*)(ws + WS_WCQ); K = 1024; N = 1024; break; case 5: W = a.in[I_WCKV]; WT = (const bf16*)(ws + WS_WCKV); K = 1024; N = 2048; break;
                case 6: W = a.in[I_WCO]; WT = (const bf16*)(ws + WS_WCO); K = 1024; N = 1024; break;
                case 7: e = r2 % 32; W = a.in[I_WE1] + (size_t)e * 1024 * 2048; WT = (const bf16*)(ws + WS_WE1 + (size_t)e * 2048 * 1024); K = 1024; N = 2048; break;
                default: e = r2 % 32; W = a.in[I_WE2] + (size_t)e * 1024 * 1024; WT = (const bf16*)(ws + WS_WE2 + (size_t)e * 1024 * 1024); K = 1024; N = 1024; break; }
            const int k = r0 % K, n = r1 % N; int nr = n; if (which == 7) nr = n < 1024 ? 256 * (n >> 7) + (n & 127) : 256 * ((n - 1024) >> 7) + 128 + ((n - 1024) & 127);
            if (which >= 7) chk_report(ws, 0, dbg_f8((const unsigned char*)WT, (size_t)nr * K + k), W[(size_t)k * N + n] * 64.0f, 0.5f);
            else { const float ref = bf2f((bf16)(cvtpk(W[(size_t)k * N + n], 0.f) & 0xffffu)); chk_report(ws, 0, dbg_bf(WT, (size_t)nr * K + k), ref, 1e-6f); }
        } else if (which < 11) {
            const bool isx = which == 9; const int row = isx ? r0 % T : r0 % (BATCH * MEML), col = r1 % DM;
            const float* xr = (isx ? a.in[I_X] : a.in[I_MEM]) + (size_t)row * DM; double ss = 0; for (int k = 0; k < DM; ++k) ss += (double)xr[k] * xr[k];
            const float ref = xr[col] * (float)(1.0 / sqrt(ss / DM + 1e-5)) * (isx ? a.in[I_GMIX] : a.in[I_GMEM])[col];
            chk_report(ws, 0, dbg_bf((const bf16*)(ws + (isx ? WS_XN1 : WS_MEMN)), (size_t)row * DM + col), ref, 0.5f);
        } else { const int pos = r0 % SEQ, i = r1 % 32; const double inv = exp2(-(double)i * 13.287712379549449 / 32.0); const float angf = (float)pos * (float)inv; double an = (double)angf; an -= 6.283185307179586 * rint(an / 6.283185307179586);
            const float rev = (float)(an / 6.283185307179586); chk_report(ws, 0, dbg_rope(rope, pos, i, false), __builtin_amdgcn_cosf(rev), 0.5f); chk_report(ws, 0, dbg_rope(rope, pos, i, true), __builtin_amdgcn_sinf(rev), 0.5f); }
    } else if (phase == 1) {
        if (sid % 3 == 2) {
            const int e = r2 % 32; const bool w1 = (sid & 4) != 0; const int K = 1024, N = w1 ? 2048 : 1024; const float* W = (w1 ? a.in[I_WE1] : a.in[I_WE2]) + (size_t)e * K * N; const unsigned char* WT = ws + (w1 ? WS_WE1 : WS_WE2) + (size_t)e * N * K;
            const int k = r0 % K, n = r1 % N; int nr = n; if (w1) nr = n < 1024 ? 256 * (n >> 7) + (n & 127) : 256 * ((n - 1024) >> 7) + 128 + ((n - 1024) & 127);
            chk_report(ws, 1, dbg_f8(WT, (size_t)nr * K + k), W[(size_t)k * N + n] * 64.0f, 0.5f);
        } else if (sid & 1) { const int row = r0 % T, col = r1 % NPROJ; const bf16* xr = (const bf16*)(ws + WS_XN1) + (size_t)row * DM; const float* W = a.in[I_WIN]; double s = 0; for (int k = 0; k < DM; ++k) s += (double)bf2f(xr[k]) * W[(size_t)k * NPROJ + col];
            const float sc = col < 512 ? SBQ_SCALE : ((col >= C_RK && col < C_RV) ? 0.125f : 1.0f); chk_report(ws, 1, PRJ(row, col), (float)s * sc, sc); }
        else { const int row = r0 % (BATCH * MEML), col = r1 % 2048; const bf16* xr = (const bf16*)(ws + WS_MEMN) + (size_t)row * DM; const float* W = a.in[I_WCKV]; double s = 0; for (int k = 0; k < DM; ++k) s += (double)bf2f(xr[k]) * W[(size_t)k * 2048 + col];
            chk_report(ws, 1, dbg_bf((const bf16*)(ws + WS_KVMEM), (size_t)row * 2048 + col), (float)s, 1.0f); }
    } else if (phase == 2) {
        if (sid & 1) {
            const int b = r0 % BATCH, h = r1 % 8, t = (sid & 2) ? r2 % SEQ : r2 % 300, d = r3 % 64; const size_t rb = (size_t)b * SEQ; const bf16* qrow = PROJ + proj_off(rb + t, C_SBQ + h * 64);
            double o = 0, between = 0;
            for (int s = t - 1; s >= 0; --s) { const bf16* krow = PROJ + proj_off(rb + s, C_SBK + h * 64); double zl = 0; for (int k = 0; k < 64; ++k) zl += (double)bf2f(qrow[k]) * bf2f(krow[k]);
                const double z = zl / 1.4426950408889634; const double lsp = z > 0 ? z + log1p(exp(-z)) : log1p(exp(z));
                const double w = exp(z - lsp + between); between -= lsp; o += w * PRJ(rb + s, C_SBV + h * 64 + d); if (between < -200.0) break; }
            chk_report(ws, 2, dbg_bf((const bf16*)(ws + WS_YSB), (size_t)(b * SEQ + t) * 512 + h * 64 + d), (float)o, 0.5f);
        } else {
            const int b = r0 % BATCH, h = r1 % 8, g = r2 % 3, dk = r3 % 64, dv = (r3 >> 8) % 128; const double gam = 1.0 - exp2(-5.0 - h); double s = 0;
            for (int p = 0; p < 512; ++p) { const int pos = g * 512 + p; const size_t rw = (size_t)(b * SEQ + pos); s += pow(gam, 511 - p) * dbg_rot(PROJ + proj_off(rw, C_RK + h * 64), rope, pos, dk) * PRJ(rw, C_RV + h * 128 + dv); }
            chk_report(ws, 2, ((const float*)(ws + WS_GTOT))[(size_t)((b * 8 + h) * 4 + g) * 8192 + dk * 128 + dv], (float)s, 0.5f);
        }
    } else if (phase == 3) {
        const int b = r0 % BATCH, h = r1 % 8, t = (sid & 1) ? r2 % SEQ : r2 % 200; const double gam = 1.0 - exp2(-5.0 - h); const size_t rb = (size_t)b * SEQ;
        float q[64];
#pragma unroll
        for (int d = 0; d < 64; ++d) q[d] = dbg_rot(PROJ + proj_off(rb + t, C_RQ + h * 64), rope, t, d);
        float o[128];
#pragma unroll
        for (int e = 0; e < 128; ++e) o[e] = 0.f;
        for (int s = 0; s <= t; ++s) { const bf16* krow = PROJ + proj_off(rb + s, C_RK + h * 64); const bf16* vrow = PROJ + proj_off(rb + s, C_RV + h * 128); float dot = 0.f;
#pragma unroll
            for (int d = 0; d < 64; ++d) dot += q[d] * dbg_rot(krow, rope, s, d);
            const float w = dot * (float)pow(gam, t - s);
#pragma unroll
            for (int e = 0; e < 128; ++e) o[e] += w * bf2f(vrow[e]); }
        float mu = 0.f;
#pragma unroll
        for (int e = 0; e < 128; ++e) mu += o[e];
        mu *= (1.f / 128.f); float var = 0.f;
#pragma unroll
        for (int e = 0; e < 128; ++e) var += (o[e] - mu) * (o[e] - mu);
        const float rstd = 1.0f / sqrtf(var * (1.f / 128.f) + 1e-5f);
#pragma unroll
        for (int e = 0; e < 128; ++e) { const float gv = PRJ(rb + t, C_RG + h * 128 + e); chk_report(ws, 3, dbg_bf((const bf16*)(ws + WS_YRET), (size_t)(b * SEQ + t) * DM + h * 128 + e), gv * dbg_sigm(gv) * (o[e] - mu) * rstd, 1.0f); }
    } else if (phase == 4) {
        const int row = r0 % T, col = r1 % DM; const bf16* ys = (const bf16*)(ws + WS_YSB) + (size_t)row * 512; const bf16* yr = (const bf16*)(ws + WS_YRET) + (size_t)row * DM; double s1 = 0, s2 = 0;
        for (int k = 0; k < 512; ++k) s1 += (double)bf2f(ys[k]) * a.in[I_WSBO][(size_t)k * DM + col]; for (int k = 0; k < DM; ++k) s2 += (double)bf2f(yr[k]) * a.in[I_WRETO][(size_t)k * DM + col];
        const float ref = dbg_sigm(PRJ(row, C_GSB + col)) * (float)s1 + dbg_sigm(PRJ(row, C_GRET + col)) * (float)s2;
        chk_report(ws, 4, dbg_bf((const bf16*)(ws + WS_MERGED), (size_t)row * DM + col), ref, 0.5f);
    } else if (phase == 5 || phase == 8) {
        const bool p5 = phase == 5; const int row = r0 % T, col = r1 % DM; const bf16* ar = (const bf16*)(ws + (p5 ? WS_MERGED : WS_OX)) + (size_t)row * DM; const float* W = p5 ? a.in[I_WMIX] : a.in[I_WCO];
        double s = 0; for (int k = 0; k < DM; ++k) s += (double)bf2f(ar[k]) * W[(size_t)k * DM + col];
        const float xi = p5 ? a.in[I_X][(size_t)row * DM + col] : dbg_bf((const bf16*)(ws + WS_XN2U), (size_t)row * DM + col); const float ref = xi + (float)s; const float got = dbg_bf((const bf16*)(ws + (p5 ? WS_XN2U : WS_XN3U)), (size_t)row * DM + col);
        chk_report(ws, phase, got, ref, 1.0f);
        if (p5) { const bf16* xr = (const bf16*)(ws + WS_XN2U) + (size_t)row * DM; double ss = 0; for (int k = 0; k < DM; ++k) ss += (double)bf2f(xr[k]) * bf2f(xr[k]); float sl = 0; for (int k = 0; k < 16; ++k) sl += ((const float*)(ws + WS_SLOTS))[(size_t)row * 16 + k]; chk_report(ws, 5, sl, (float)ss, 100.0f); }
    } else if (phase == 6) {
        const int row = r0 % T, col = r1 % DM; const bf16* ar = (const bf16*)(ws + WS_XN2U) + (size_t)row * DM; double s = 0, ss = 0; for (int k = 0; k < DM; ++k) { const double x = bf2f(ar[k]); s += x * a.in[I_GXATTN][k] * a.in[I_WCQ][(size_t)k * DM + col]; ss += x * x; }
        chk_report(ws, 6, dbg_bf((const bf16*)(ws + WS_QX), (size_t)row * DM + col), (float)(s / sqrt(ss / DM + 1e-5)) * XQ_SCALE, XQ_SCALE);
    } else if (phase == 7) {
        const int b = r0 % BATCH, t = r1 % SEQ, hx = r2 % 4, d = r3 % 256; const bf16* qrow = (const bf16*)(ws + WS_QX) + (size_t)(b * SEQ + t) * DM + hx * 256; const bf16* KV = (const bf16*)(ws + WS_KVMEM) + (size_t)(b * MEML) * 2048;
        double mx = -1e30; for (int m = 0; m < MEML; ++m) { double z = 0; for (int k = 0; k < 256; ++k) z += (double)bf2f(qrow[k]) * bf2f(KV[(size_t)m * 2048 + hx * 256 + k]); if (z > mx) mx = z; }
        double l = 0, o = 0; for (int m = 0; m < MEML; ++m) { double z = 0; for (int k = 0; k < 256; ++k) z += (double)bf2f(qrow[k]) * bf2f(KV[(size_t)m * 2048 + hx * 256 + k]); const double p = exp2(z - mx); l += p; o += p * bf2f(KV[(size_t)m * 2048 + 1024 + hx * 256 + d]); }
        chk_report(ws, 7, dbg_bf((const bf16*)(ws + WS_OX), (size_t)(b * SEQ + t) * DM + hx * 256 + d), (float)(o / l), 0.1f);
    } else if (phase == 9) {
        const int tok = r0 % T; const bf16* xr = (const bf16*)(ws + WS_XN3U) + (size_t)tok * DM; double ss = 0; for (int k = 0; k < DM; ++k) ss += (double)bf2f(xr[k]) * bf2f(xr[k]); const double rstd = 1.0 / sqrt(ss / DM + 1e-5);
        chk_report(ws, 9, ((const float*)(ws + WS_SMALL + SM_RSTD3))[tok], (float)rstd, 1e-3f);
        double v0 = -1e30, v1 = -1e30, v2 = -1e30, v3 = -1e30, v4 = -1e30; int i0 = -1, i1 = -1, i2 = -1, i3 = -1;
        for (int e = 0; e < 32; ++e) { double s = 0; for (int k = 0; k < DM; ++k) s += (double)bf2f(xr[k]) * a.in[I_GMOE][k] * a.in[I_WROUTER][k * 32 + e]; s = s * rstd + a.in[I_BROUTER][e];
            if (s > v0) { v4 = v3; v3 = v2; i3 = i2; v2 = v1; i2 = i1; v1 = v0; i1 = i0; v0 = s; i0 = e; } else if (s > v1) { v4 = v3; v3 = v2; i3 = i2; v2 = v1; i2 = i1; v1 = s; i1 = e; }
            else if (s > v2) { v4 = v3; v3 = v2; i3 = i2; v2 = s; i2 = e; } else if (s > v3) { v4 = v3; v3 = s; i3 = e; } else if (s > v4) v4 = s; }
        const int* te = (const int*)(ws + WS_SMALL + SM_TOPE) + tok * 4; const float* tg = (const float*)(ws + WS_SMALL + SM_GATE) + tok * 4;
        const bool close = (v0 - v1 < 1e-4) || (v1 - v2 < 1e-4) || (v2 - v3 < 1e-4) || (v3 - v4 < 1e-4);
        if (!close) { chk_report(ws, 9, (te[0] == i0 && te[1] == i1 && te[2] == i2 && te[3] == i3) ? 0.f : 1.f, 0.f, 1.0f);
            const double e1 = exp(v1 - v0), e2 = exp(v2 - v0), e3 = exp(v3 - v0), sm = 1.0 + e1 + e2 + e3; chk_report(ws, 9, tg[0], (float)(1.0 / sm), 0.01f); chk_report(ws, 9, tg[3], (float)(e3 / sm), 0.01f); }
    } else if (phase == 10) {
        const int tok = r0 % T, k = r1 % 4, col = r2 % DM; const int row = ((const int*)(ws + WS_SMALL + SM_AROW))[tok * 4 + k], e = ((const int*)(ws + WS_SMALL + SM_TOPE))[tok * 4 + k]; const int* BLKE = (const int*)(ws + WS_SMALL + SM_BLKE);
        const bool okr = row >= 0 && row < BLKE[MAXBLK] * 256; chk_report(ws, 10, okr ? 0.f : 1.f, 0.f, 1.0f);
        if (okr) { chk_report(ws, 10, BLKE[row >> 8] == e ? 0.f : 1.f, 0.f, 1.0f); chk_report(ws, 10, dbg_f8(ws + WS_XG, (size_t)row * DM + col), dbg_bf((const bf16*)(ws + WS_XN3U), (size_t)tok * DM + col) * a.in[I_GMOE][col], 0.5f);
            chk_report(ws, 10, ((const float*)(ws + WS_SMALL + SM_RSCALE))[row], ((const float*)(ws + WS_SMALL + SM_RSTD3))[tok], 1e-6f); chk_report(ws, 10, ((const float*)(ws + WS_SMALL + SM_RGATE))[row], ((const float*)(ws + WS_SMALL + SM_GATE))[tok * 4 + k], 1e-6f);
 }
    } else if (phase == 11) {
        const int tok = r0 % T, k = r1 % 4, col = r2 % DFF; const int row = ((const int*)(ws + WS_SMALL + SM_AROW))[tok * 4 + k], e = ((const int*)(ws + WS_SMALL + SM_TOPE))[tok * 4 + k];
        const unsigned char* xr = ws + WS_XG + (size_t)row * DM; const unsigned char* W = ws + WS_WE1 + (size_t)e * 2048 * 1024; const int rg = 256 * (col >> 7) + (col & 127), rl = rg + 128; double sg = 0, sl = 0;
        for (int kk = 0; kk < DM; ++kk) { const double x = dbg_f8(xr, kk); sg += x * dbg_f8(W, (size_t)rg * 1024 + kk); sl += x * dbg_f8(W, (size_t)rl * 1024 + kk); }
        sg *= (1.0 / 64.0); sl *= (1.0 / 64.0);
        const float rs = ((const float*)(ws + WS_SMALL + SM_RSTD3))[tok]; float gl = (float)sg * rs + a.in[I_BE1][e * 2048 + col], li = (float)sl * rs + a.in[I_BE1][e * 2048 + 1024 + col]; gl = fminf(gl, 7.f); li = fminf(fmaxf(li, -7.f), 7.f);
        chk_report(ws, 11, dbg_f8(ws + WS_ACT, (size_t)row * DFF + col), gl * dbg_sigm(1.702f * gl) * (li + 1.0f), 0.5f);
    } else if (phase == 12) {
        const int tok = r0 % T, k = r1 % 4, col = r2 % DM; const int row = ((const int*)(ws + WS_SMALL + SM_AROW))[tok * 4 + k], e = ((const int*)(ws + WS_SMALL + SM_TOPE))[tok * 4 + k];
        const unsigned char* ar = ws + WS_ACT + (size_t)row * DFF; const unsigned char* W = ws + WS_WE2 + (size_t)e * 1024 * 1024; double s = 0; for (int kk = 0; kk < DFF; ++kk) s += (double)dbg_f8(ar, kk) * dbg_f8(W, (size_t)col * 1024 + kk);
        s *= (1.0 / 64.0);
        chk_report(ws, 12, dbg_bf((const bf16*)(ws + WS_YROWS), (size_t)row * DM + col), ((float)s + a.in[I_BE2][e * 1024 + col]) * ((const float*)(ws + WS_SMALL + SM_GATE))[tok * 4 + k], 0.1f);
    }
}
__global__ void dbg_rows_a(Args a) { const int i = blockIdx.x * 256 + threadIdx.x; if (i < T * 4) atomicAdd((int*)(a.ws + WS_E + 64 * MB) + ((const int*)(a.ws + WS_SMALL + SM_AROW))[i], 1); }
__global__ void dbg_rows_b(Args a) { const int i = blockIdx.x * 256 + threadIdx.x; if (i < PROWS) { const int c = ((const int*)(a.ws + WS_E + 64 * MB))[i]; if (c > 1) atomicMax((unsigned*)(a.ws + WS_CTL) + CW_CHK + 10, __float_as_uint(100.0f + c)); } }
__global__ void dbg_verdict(Args a) {
    const unsigned* chk = (const unsigned*)(a.ws + WS_CTL) + CW_CHK; int code = 0;
    for (int p = 0; p < NPHASE; ++p) if (code == 0 && __uint_as_float(chk[p]) > 0.08f) code = p + 1;
    if (code) { const float sc = 1.0f + (float)code; for (size_t i = (size_t)blockIdx.x * 256 + threadIdx.x; i < (size_t)T * DM; i += (size_t)gridDim.x * 256) a.out[i] *= sc; }
}
static void dbg_check(int p, const Args& a, hipStream_t stream) {
    if (p == 13) { hipLaunchKernelGGL(dbg_verdict, dim3(1024), dim3(256), 0, stream, a); return; }
    if (p == 10) { (void)hipMemsetAsync(a.ws + WS_E + 64 * MB, 0, (size_t)PROWS * 4, stream); hipLaunchKernelGGL(dbg_rows_a, dim3(T * 4 / 256), dim3(256), 0, stream, a); hipLaunchKernelGGL(dbg_rows_b, dim3(PROWS / 256), dim3(256), 0, stream, a); }
    hipLaunchKernelGGL(dbg_kernel, dim3(p == 3 ? 2 : 16), dim3(64), 0, stream, a, p);
}
#endif

extern "C" void kernel_launch(void* const* d_in, const int* in_sizes, int n_in, void* d_out, int out_size, void* d_ws, size_t ws_size, hipStream_t stream) {
    static int grid = 0;
    if (grid == 0) {
        if (n_in != 20 || in_sizes[0] != T * DM || out_size != T * DM || ws_size < WS_END) { fprintf(stderr, "kernel_launch: unexpected problem shape (n_in %d, in0 %d, out %d, ws %zu < %zu)\n", n_in, n_in > 0 ? in_sizes[0] : -1, out_size, ws_size, (size_t)WS_END); grid = -1; return; }
        int dev = 0, cus = 0;
        if (hipGetDevice(&dev) != hipSuccess || hipDeviceGetAttribute(&cus, hipDeviceAttributeMultiprocessorCount, dev) != hipSuccess) { grid = -1; return; }
        if (hipFuncSetAttribute((const void*)mega_fwd, hipFuncAttributeMaxDynamicSharedMemorySize, LDS_BYTES) != hipSuccess) { fprintf(stderr, "kernel_launch: hipFuncSetAttribute failed\n"); grid = -1; return; }
        grid = cus;
    }
    if (grid < 0) return;
    (void)hipMemsetAsync((char*)d_ws + WS_CTL, 0, CTL_BYTES, stream);
    Args a{};
    for (int i = 0; i < 20; ++i) a.in[i] = (const float*)d_in[i];
    a.out = (float*)d_out; a.ws = (unsigned char*)d_ws;
#if MK_DEBUG
    for (int p = 0; p < NPHASE; ++p) { a.ph_lo = p; a.ph_hi = p + 1; hipLaunchKernelGGL(mega_fwd, dim3(grid), dim3(NWAVES * 64), LDS_BYTES, stream, a); dbg_check(p, a, stream); }
#else
    a.ph_lo = 0; a.ph_hi = NPHASE;
    hipLaunchKernelGGL(mega_fwd, dim3(grid), dim3(NWAVES * 64), LDS_BYTES, stream, a);
#endif
}
```
